# Optimizing an MI355X kernel written in HIP

```python
import jax
import jax.numpy as jnp
from jax import lax
import numpy as np

D_MODEL = 4096
BATCH = 4
SEQ = 2048
DEPTH = 1
DEC_BATCH = 128
DEC_SEQ = 8
PAST_LEN = 16384
PAGE_SIZE = 128

GLA_WIDTH = D_MODEL // 2
GLA_HEADS = 4
GLA_DK = GLA_WIDTH // 2 // GLA_HEADS
GLA_DV = GLA_WIDTH // GLA_HEADS
GLA_QK = GLA_HEADS * GLA_DK
GLA_GATE_RANK = 16
GLA_TAU = 16.0
GLA_CHUNK = 64
RWKV_WIDTH = D_MODEL // 2
RWKV_HEAD = 64
RWKV_HEADS = RWKV_WIDTH // RWKV_HEAD
RWKV_W_LORA = 96
RWKV_A_LORA = 96
RWKV_G_LORA = 256
RWKV_SIZES = (RWKV_WIDTH, RWKV_W_LORA, RWKV_WIDTH, RWKV_WIDTH, RWKV_A_LORA, RWKV_G_LORA)
RWKV_COLS = sum(RWKV_SIZES)
RWKV_SPLITS = tuple(int(s) for s in np.cumsum(RWKV_SIZES)[:-1])
GN_EPS = 64e-5
IN_SIZES = (GLA_QK, GLA_QK, GLA_WIDTH, GLA_GATE_RANK, GLA_WIDTH, RWKV_COLS, D_MODEL, D_MODEL)
IN_TOTAL = sum(IN_SIZES)
IN_SPLITS = tuple(int(s) for s in np.cumsum(IN_SIZES)[:-1])
D_FF = 11008
CONV_W = 3
P_DIM = 256
EPS = 1e-6

kernel_name = 'hybrid_gla_rwkv7_decoder_step'


def rmsnorm(x, gain):
    xf = x.astype(jnp.float32)
    y = xf * lax.rsqrt(jnp.mean(xf * xf, axis=-1, keepdims=True) + EPS)
    return (y * gain.astype(jnp.float32)).astype(x.dtype)


def gla_chunked(q, k, v, log_a, s0):
    B, L, H, _ = q.shape
    c = min(GLA_CHUNK, L)
    n = -(-L // c)
    pad = n * c - L

    def blocks(t):
        t = jnp.pad(t, ((0, 0), (0, pad), (0, 0), (0, 0)))
        return t.reshape(B, n, c, H, t.shape[-1]).transpose(1, 0, 3, 2, 4)

    causal = jnp.tril(jnp.ones((c, c), dtype=bool))

    def step(S, blk):
        qb, kb, vb, ab = blk
        b = jnp.cumsum(ab, axis=2)
        b_end = b[:, :, -1:, :]
        qd = qb * jnp.exp(b)
        kd = kb * jnp.exp(-b)
        att = jnp.where(causal, jnp.einsum('bhtd,bhsd->bhts', qd, kd), 0.0)
        o = jnp.einsum('bhts,bhsv->bhtv', att, vb) + jnp.einsum('bhtd,bhdv->bhtv', qd, S)
        S = S * jnp.exp(b_end[:, :, 0, :, None]) + jnp.einsum('bhsd,bhsv->bhdv', kb * jnp.exp(b_end - b), vb)
        return S, o

    S, o = lax.scan(step, s0.astype(jnp.float32), (blocks(q), blocks(k), blocks(v), blocks(log_a)))
    o = o.transpose(1, 0, 3, 2, 4).reshape(B, n * c, H, -1)[:, :L]
    return o, S


def rwkv7_scan(r, w, k, v, kk, a, s0):
    def step(S, inp):
        r_t, w_t, k_t, v_t, kk_t, a_t = inp
        sa = jnp.einsum('bhvk,bhk->bhv', S, -kk_t)
        S = (S * w_t[:, :, None, :] + sa[..., None] * (kk_t * a_t)[:, :, None, :]
             + v_t[..., None] * k_t[:, :, None, :])
        return S, jnp.einsum('bhvk,bhk->bhv', S, r_t)

    xs = tuple(jnp.swapaxes(t, 0, 1) for t in (r, w, k, v, kk, a))
    S, o = lax.scan(step, s0.astype(jnp.float32), xs)
    return jnp.swapaxes(o, 0, 1), S


def layer(x, p, s_gla, s_rwkv, s_shift, s_conv,
          w_in, w_alpha2, b_alpha, gla_norm, w_branch_a,
          mu_shift, w0, w_decay2, a0, w_iclr2, w_gate2, k_k, k_a, r_k, ln_x_w, ln_x_b, w_branch_b,
          w_out, g_pre_mix, g_post_mix, g_pre_ffn, g_post_ffn,
          w_up, conv_w, conv_b, w_down, g_pe, w_pe_gate, w_pe):
    B, L, _ = x.shape
    f32 = jnp.float32
    h = rmsnorm(x, g_pre_mix)
    proj = h @ w_in
    q, k, v, za, zg, zr, gate_a, gate_b = jnp.split(proj, IN_SPLITS, axis=-1)

    q = q.reshape(B, L, GLA_HEADS, GLA_DK).astype(f32) * (GLA_DK ** -0.5)
    k = k.reshape(B, L, GLA_HEADS, GLA_DK).astype(f32)
    v = v.reshape(B, L, GLA_HEADS, GLA_DV).astype(f32)
    log_a = (jax.nn.log_sigmoid((za @ w_alpha2 + b_alpha).astype(f32)) / GLA_TAU).reshape(B, L, GLA_HEADS, GLA_DK)
    o_a, s_gla_new = gla_chunked(q, k, v, log_a, s_gla)
    o_a = o_a * lax.rsqrt(jnp.mean(o_a * o_a, axis=-1, keepdims=True) + EPS) * gla_norm.astype(f32)
    o_a = o_a.reshape(B, L, GLA_WIDTH).astype(x.dtype) * jax.nn.silu(zg)
    y_a = o_a @ w_branch_a

    prev = jnp.concatenate([s_shift[:, None, :].astype(zr.dtype), zr[:, :-1]], axis=1)
    zs = zr + (prev - zr) * mu_shift
    new_shift = zr[:, -1]
    r, xw, kr, vr, xa, xg = jnp.split(zs, RWKV_SPLITS, axis=-1)
    w_log = -jax.nn.softplus(-(w0 + jnp.tanh(xw) @ w_decay2).astype(f32)) - 0.5
    decay = jnp.exp(-jnp.exp(w_log))
    a = jax.nn.sigmoid((a0 + xa @ w_iclr2).astype(f32))
    g = jax.nn.sigmoid(xg) @ w_gate2
    kr = kr.astype(f32)

    def heads(t):
        return t.reshape(B, L, RWKV_HEADS, RWKV_HEAD)

    kk = heads(kr * k_k.astype(f32))
    kk = kk / jnp.maximum(jnp.sqrt(jnp.sum(kk * kk, axis=-1, keepdims=True)), 1e-12)
    kr = kr * (1.0 + (a - 1.0) * k_a.astype(f32))
    rh, kh, vh = heads(r.astype(f32)), heads(kr), heads(vr.astype(f32))
    o_b, s_rwkv_new = rwkv7_scan(rh, heads(decay), kh, vh, kk, heads(a), s_rwkv)
    mu = jnp.mean(o_b, axis=-1, keepdims=True)
    var = jnp.mean(jnp.square(o_b - mu), axis=-1, keepdims=True)
    o_b = ((o_b - mu) * lax.rsqrt(var + GN_EPS)).reshape(B, L, RWKV_WIDTH) * ln_x_w + ln_x_b
    bonus = jnp.sum(rh * kh * r_k.astype(f32), axis=-1, keepdims=True) * vh
    o_b = o_b + bonus.reshape(B, L, RWKV_WIDTH)
    y_b = (o_b.astype(x.dtype) * g) @ w_branch_b

    mixed = jax.nn.sigmoid(gate_a) * y_a + jax.nn.sigmoid(gate_b) * y_b
    x = x + rmsnorm(mixed @ w_out, g_post_mix)

    hf = rmsnorm(x, g_pre_ffn)
    up_g, up_v = jnp.split(hf @ w_up, 2, axis=-1)
    gpad = jnp.concatenate([s_conv.astype(up_g.dtype), up_g], axis=1)
    conv = conv_b + gpad[:, 0:L] * conv_w[0]
    for j in range(1, CONV_W):
        conv = conv + gpad[:, j:j + L] * conv_w[j]
    new_conv = gpad[:, L:]
    f = (jax.nn.gelu(conv) * up_v) @ w_down
    x = x + rmsnorm(f, g_post_ffn)

    x = x + jax.nn.sigmoid(rmsnorm(x, g_pe) @ w_pe_gate) * (p.astype(x.dtype) @ w_pe)
    return x, s_gla_new, s_rwkv_new, new_shift, new_conv


def setup_inputs(seed: int = 0) -> dict:
    key = jax.random.key(seed)
    ks = iter(jax.random.split(key, 48))
    f32 = jnp.float32

    def nrm(shape, scale):
        return jax.random.normal(next(ks), shape, f32) * scale

    def unif(shape, lo, hi):
        return jax.random.uniform(next(ks), shape, f32, lo, hi)

    def gain(n):
        return 1.0 + nrm((DEPTH, n), 0.02)

    return {
        'x_prompt': nrm((BATCH, SEQ, D_MODEL), 1.0),
        'x_sample': nrm((DEC_BATCH, DEC_SEQ, D_MODEL), 1.0),
        'state_gla': nrm((DEPTH, DEC_BATCH, GLA_HEADS, GLA_DK, GLA_DV), 0.5),
        'state_rwkv': nrm((DEPTH, DEC_BATCH, RWKV_HEADS, RWKV_HEAD, RWKV_HEAD), 0.3),
        'state_shift': nrm((DEPTH, DEC_BATCH, RWKV_COLS), 1.0),
        'state_ffn_conv': nrm((DEPTH, DEC_BATCH, CONV_W - 1, D_FF), 1.0),
        'p_prompt': nrm((DEPTH, BATCH, SEQ, P_DIM), 1.0),
        'p_sample': nrm((DEPTH, DEC_BATCH, DEC_SEQ, P_DIM), 1.0),
        'w_in': nrm((DEPTH, D_MODEL, IN_TOTAL), D_MODEL ** -0.5),
        'w_alpha2': nrm((DEPTH, GLA_GATE_RANK, GLA_QK), GLA_GATE_RANK ** -0.5),
        'b_alpha': unif((DEPTH, GLA_QK), -1.0, 4.0),
        'gla_norm': gain(GLA_DV),
        'w_branch_a': nrm((DEPTH, GLA_WIDTH, D_MODEL), GLA_WIDTH ** -0.5),
        'mu_shift': unif((DEPTH, RWKV_COLS), 0.0, 1.0),
        'w0': unif((DEPTH, RWKV_WIDTH), -4.0, 1.0),
        'w_decay2': nrm((DEPTH, RWKV_W_LORA, RWKV_WIDTH), 0.1),
        'a0': nrm((DEPTH, RWKV_WIDTH), 0.1),
        'w_iclr2': nrm((DEPTH, RWKV_A_LORA, RWKV_WIDTH), RWKV_A_LORA ** -0.5),
        'w_gate2': nrm((DEPTH, RWKV_G_LORA, RWKV_WIDTH), RWKV_G_LORA ** -0.5),
        'k_k': 0.85 + nrm((DEPTH, RWKV_WIDTH), 0.02),
        'k_a': gain(RWKV_WIDTH),
        'r_k': nrm((DEPTH, RWKV_HEADS, RWKV_HEAD), 0.1),
        'ln_x_w': gain(RWKV_WIDTH),
        'ln_x_b': nrm((DEPTH, RWKV_WIDTH), 0.02),
        'w_branch_b': nrm((DEPTH, RWKV_WIDTH, D_MODEL), RWKV_WIDTH ** -0.5),
        'w_out': nrm((DEPTH, D_MODEL, D_MODEL), D_MODEL ** -0.5),
        'g_pre_mix': gain(D_MODEL),
        'g_post_mix': gain(D_MODEL),
        'g_pre_ffn': gain(D_MODEL),
        'g_post_ffn': gain(D_MODEL),
        'w_up': nrm((DEPTH, D_MODEL, 2 * D_FF), D_MODEL ** -0.5),
        'conv_w': nrm((DEPTH, CONV_W, D_FF), CONV_W ** -0.5),
        'conv_b': nrm((DEPTH, D_FF), 0.02),
        'w_down': nrm((DEPTH, D_FF, D_MODEL), D_FF ** -0.5),
        'g_pe': gain(D_MODEL),
        'w_pe_gate': nrm((DEPTH, D_MODEL, D_MODEL), D_MODEL ** -0.5),
        'w_pe': nrm((DEPTH, P_DIM, D_MODEL), P_DIM ** -0.5),
    }


def reference(x_prompt, x_sample, state_gla, state_rwkv, state_shift, state_ffn_conv, p_prompt, p_sample,
              w_in, w_alpha2, b_alpha, gla_norm, w_branch_a,
              mu_shift, w0, w_decay2, a0, w_iclr2, w_gate2, k_k, k_a, r_k, ln_x_w, ln_x_b, w_branch_b,
              w_out, g_pre_mix, g_post_mix, g_pre_ffn, g_post_ffn,
              w_up, conv_w, conv_b, w_down, g_pe, w_pe_gate, w_pe):
    params = (w_in, w_alpha2, b_alpha, gla_norm, w_branch_a,
              mu_shift, w0, w_decay2, a0, w_iclr2, w_gate2, k_k, k_a, r_k, ln_x_w, ln_x_b, w_branch_b,
              w_out, g_pre_mix, g_post_mix, g_pre_ffn, g_post_ffn,
              w_up, conv_w, conv_b, w_down, g_pe, w_pe_gate, w_pe)
    yp, ys = x_prompt, x_sample
    gla_p, rwkv_p, shift_p, conv_p = [], [], [], []
    gla_s, rwkv_s, shift_s, conv_s = [], [], [], []
    for i in range(DEPTH):
        lp = tuple(t[i] for t in params)
        z_gla = jnp.zeros((BATCH, GLA_HEADS, GLA_DK, GLA_DV), jnp.float32)
        z_rwkv = jnp.zeros((BATCH, RWKV_HEADS, RWKV_HEAD, RWKV_HEAD), jnp.float32)
        z_shift = jnp.zeros((BATCH, RWKV_COLS), x_prompt.dtype)
        z_conv = jnp.zeros((BATCH, CONV_W - 1, D_FF), x_prompt.dtype)
        yp, sg, sr, ss, sc = layer(yp, p_prompt[i], z_gla, z_rwkv, z_shift, z_conv, *lp)
        gla_p.append(sg); rwkv_p.append(sr); shift_p.append(ss); conv_p.append(sc)
        ys, sg, sr, ss, sc = layer(ys, p_sample[i], state_gla[i], state_rwkv[i], state_shift[i],
                                   state_ffn_conv[i], *lp)
        gla_s.append(sg); rwkv_s.append(sr); shift_s.append(ss); conv_s.append(sc)
    return (yp, ys,
            jnp.stack(gla_p), jnp.stack(rwkv_p), jnp.stack(shift_p), jnp.stack(conv_p),
            jnp.stack(gla_s), jnp.stack(rwkv_s), jnp.stack(shift_s), jnp.stack(conv_s))
```

```cpp
#include <hip/hip_runtime.h>
#include <cstdio>
#include <cstdint>
#ifndef MK_ONE_LAUNCH
#define MK_ONE_LAUNCH 1
#endif
namespace pg8 {
#define PG8_LAS __attribute__((address_space(3)))
typedef unsigned short bf16_t;
typedef short bf16x8 __attribute__((ext_vector_type(8)));
typedef float f32x4 __attribute__((ext_vector_type(4)));
typedef unsigned u32x4 __attribute__((ext_vector_type(4)));
constexpr int BM = 256, BK = 64, HALF = 128, HTB = HALF * BK * 2  , STAGE_BYTES = 8 * HTB, NXCD = 8, WGM = 8;

__host__ __device__ __forceinline__ int lds_byte(int r, int c) { const int st = (r >> 4) * 2 + (c >> 5), rr = r & 15, cc = c & 31, ob = rr * 64 + cc * 2; return st * 1024 + (ob ^ (((ob >> 9) & 1) << 5)); }
__host__ __device__ __forceinline__ void stage_rc(int b, int& R, int& C) { const int st = b / 1024, sb = b % 1024, swz = sb ^ (((sb >> 9) & 1) << 5); R = (st >> 1) * 16 + swz / 64; C = (st & 1) * 32 + (swz % 64) / 2; }
__host__ __device__ __forceinline__ int perm32(int rho) { const int n = rho >> 4, i = rho & 15; return 8 * (i >> 2) + 4 * n + (i & 3); }

struct Unit { int pm, pn, k0, nt, part; };
struct Gemm { const bf16_t* A; const bf16_t* Bt; int M, N, K; const bf16_t* A2; const bf16_t* Bt2; };

struct StaticOrder {
    int nM, nN, nwg, G, c, ntk, lim;
    __host__ __device__ __forceinline__ void init(int M, int N, int K, int G_, int c_) { nM = M / BM; nN = N / BM; nwg = nM * nN; G = G_; c = c_; ntk = K / BK; lim = nwg; }
    __host__ __device__ __forceinline__ bool next(int i, Unit& u) const { const long L = (long)i * G + c; if (L >= lim) return false; tile(L, u); return true; }
    __host__ __device__ __forceinline__ bool tile(long L, Unit& u) const {
        int wgid = (int)L; { const int q = nwg / NXCD, r = nwg % NXCD, xcd = wgid % NXCD, off = wgid / NXCD; wgid = (xcd < r ? xcd * (q + 1) : r * (q + 1) + (xcd - r) * q) + off; }
        const int nig = WGM * nN, gid = wgid / nig, fm = gid * WGM, gsz = (nM - fm) < WGM ? (nM - fm) : WGM;
        u.pm = fm + ((wgid % nig) % gsz); u.pn = (wgid % nig) / gsz; u.k0 = 0; u.nt = ntk; u.part = 0; return true;
    }
    __device__ __forceinline__ void a_ready(const Unit&) const {}
    __device__ __forceinline__ void done(const Unit&) const {}
};

struct SplitOrder {
    StaticOrder full; int G, c, rounds, R, parts, pm0, nN, ntk; bool split;
    __host__ __device__ __forceinline__ void init(int M, int N, int K, int G_, int c_) {
        const int nM = M / BM; nN = N / BM; G = G_; c = c_; ntk = K / BK; const int U = nM * nN; rounds = U / G; R = U - rounds * G;
        const int pr = R > 0 ? G / R : 1;
        split = R > 0 && (G % R) == 0 && (R % nN) == 0 && ((rounds * G) % nN) == 0 && pr <= 4 && (ntk / 2) >= pr && (G % NXCD) == 0 && (NXCD % pr) == 0 && (NXCD / pr) * (G / NXCD) == R;
        parts = split ? pr : 1; pm0 = split ? (rounds * G) / nN : nM; full.init(pm0 * BM, N, K, G, c);
    }
    __host__ __device__ __forceinline__ bool next(int i, Unit& u) const {
        Unit f; const bool okf = full.next(i, f);
        const int x = c % NXCD, idx = c / NXCD, npx = G / NXCD, p = x % parts, grp = x / parts, tile = grp * npx + idx;
        const int pairs = ntk / 2, q = pairs / parts, rem = pairs % parts;
        const bool isp = split && i == rounds;
        u.pm = isp ? pm0 + tile / nN : f.pm; u.pn = isp ? tile % nN : f.pn; u.part = isp ? p : 0;
        u.nt = isp ? 2 * (q + (p < rem ? 1 : 0)) : ntk; u.k0 = isp ? 2 * BK * (p * q + (p < rem ? p : rem)) : 0;
        return isp || ((!split || i < rounds) && okf);
    }
    __device__ __forceinline__ void a_ready(const Unit&) const {}
    __device__ __forceinline__ void done(const Unit&) const {}
};

struct ChainOrder {
    StaticOrder full;
    __host__ __device__ __forceinline__ void init(int M, int N, int K, int G_, int c_) { full.init(M, N, K, G_, c_); }
    __host__ __device__ __forceinline__ bool next(int i, Unit& u) const { const bool ok = full.next(i >> 1, u); u.part = i & 1; return ok; }
    __device__ __forceinline__ void a_ready(const Unit&) const {}
    __device__ __forceinline__ void done(const Unit&) const {}
};
__device__ __forceinline__ unsigned cvt_pk_bf16(float lo, float hi) { unsigned r; asm volatile("v_cvt_pk_bf16_f32 %0, %1, %2" : "=v"(r) : "v"(lo), "v"(hi)); return r; }
typedef float f32x2 __attribute__((ext_vector_type(2)));
template <class F> struct EpiRow8 {
    static constexpr bool PERM = true, AFTER_DRAIN = false, CHAIN = false;
    F f;
    __device__ __forceinline__ void operator()(const f32x4 (&acc)[2][2][4][2], const Unit& u, int wr, int wc, int fr, int fq) const {
        const int row0 = u.pm * BM + wr * 64 + fr, col0 = u.pn * BM + wc * 32 + 8 * fq;
#pragma unroll
        for (int ai = 0; ai < 2; ++ai)
#pragma unroll
            for (int m = 0; m < 4; ++m) {
#pragma unroll
                for (int bj = 0; bj < 2; ++bj) f(row0 + ai * HALF + m * 16, col0 + bj * HALF, acc[ai][bj][m][0], acc[ai][bj][m][1], u.part);
            }
    }
};

template <class F> struct EpiRow8Chain {
    static constexpr bool PERM = true, AFTER_DRAIN = false, CHAIN = true;
    F f;
    __device__ __forceinline__ void mid(f32x4 (&acc)[2][2][4][2], const Unit& u, int wr, int wc, int fr, int fq) const {
        const int row0 = u.pm * BM + wr * 64 + fr, col0 = u.pn * BM + wc * 32 + 8 * fq;
#pragma unroll
        for (int ai = 0; ai < 2; ++ai)
#pragma unroll
            for (int m = 0; m < 4; ++m) {
#pragma unroll
                for (int bj = 0; bj < 2; ++bj) f.mid(row0 + ai * HALF + m * 16, col0 + bj * HALF, acc[ai][bj][m][0], acc[ai][bj][m][1]);
            }
    }
    __device__ __forceinline__ void operator()(const f32x4 (&acc)[2][2][4][2], const Unit& u, int wr, int wc, int fr, int fq) const {
        const int row0 = u.pm * BM + wr * 64 + fr, col0 = u.pn * BM + wc * 32 + 8 * fq;
#pragma unroll
        for (int ai = 0; ai < 2; ++ai)
#pragma unroll
            for (int m = 0; m < 4; ++m) {
#pragma unroll
                for (int bj = 0; bj < 2; ++bj) f(row0 + ai * HALF + m * 16, col0 + bj * HALF, acc[ai][bj][m][0], acc[ai][bj][m][1], u.part);
            }
    }
};
template <class Epi, class Sched, bool ALIGN_EPI = false, bool SP2 = false>
__device__ __forceinline__ void gemm_phase(PG8_LAS unsigned char* lds, const Gemm g, const Sched& S, const Epi& E) {
    const int tid = threadIdx.x, wid = __builtin_amdgcn_readfirstlane(tid >> 6), lane = tid & 63, wr = wid >> 2, wc = wid & 3, fr = lane & 15, fq = lane >> 4;
    const int K = g.K;
    unsigned voffA[2], voffB[2];
#pragma unroll
    for (int i = 0; i < 2; ++i) { int R, C; stage_rc(tid * 16 + i * 8192, R, C); const int Rb = Epi::PERM ? ((R & ~31) + perm32(R & 31)) : R;
        voffA[i] = (unsigned)(R * K + C) * 2u; voffB[i] = (unsigned)(Rb * K + C) * 2u; }
    const size_t kstep = (size_t)(BK * 2);
    const size_t hstep = (size_t)HALF * K * 2;
    const size_t tstep = 2 * hstep;
    const unsigned ldsw = (unsigned)wid * 1024u;
    const int aoff = lds_byte(wr * 64 + fr, fq * 8), boff = lds_byte(wc * 32 + fr, fq * 8);
#define PG8_SA(b, h) (((b) * 2 + (h)) * HTB)
#define PG8_SB(b, h) ((4 + (b) * 2 + (h)) * HTB)
#define PG8_STAGE(bufoff, gbase, voff) do { _Pragma("unroll") for (int _i = 0; _i < 2; ++_i) \
        __builtin_amdgcn_global_load_lds((const unsigned*)((const char*)(gbase) + (voff)[_i]), (PG8_LAS unsigned*)(lds + (bufoff) + ldsw + _i * 8192), 16, 0, 0); } while (0)
#define PG8_LDA(dst, b, h) do { _Pragma("unroll") for (int m = 0; m < 4; ++m) _Pragma("unroll") for (int k = 0; k < 2; ++k) dst[m][k] = *(const PG8_LAS bf16x8*)(lds + PG8_SA(b, h) + aoff + m * 2048 + k * 1024); } while (0)
#define PG8_LDB(dst, b, h) do { _Pragma("unroll") for (int n = 0; n < 2; ++n) _Pragma("unroll") for (int k = 0; k < 2; ++k) dst[n][k] = *(const PG8_LAS bf16x8*)(lds + PG8_SB(b, h) + boff + n * 2048 + k * 1024); } while (0)
#define PG8_MMA(ai, bj, At, Bt) do { __builtin_amdgcn_s_setprio(1); _Pragma("unroll") for (int m = 0; m < 4; ++m) _Pragma("unroll") for (int n = 0; n < 2; ++n) _Pragma("unroll") for (int k = 0; k < 2; ++k) \
        acc[ai][bj][m][n] = __builtin_amdgcn_mfma_f32_16x16x32_bf16(Bt[n][k], At[m][k], acc[ai][bj][m][n], 0, 0, 0); __builtin_amdgcn_s_setprio(0); } while (0)
#define PG8_WAIT_V(n) asm volatile("s_waitcnt vmcnt(" #n ")" ::: "memory")
#define PG8_WAIT_L(n) asm volatile("s_waitcnt lgkmcnt(" #n ")" ::: "memory")
#define PG8_BAR __builtin_amdgcn_s_barrier()
#define PG8_SCHED __builtin_amdgcn_sched_barrier(0)
    Unit cur, nxt; int ui = 0;
    if (!S.next(0, cur)) return;
    f32x4 acc[2][2][4][2];
#pragma unroll
    for (int a = 0; a < 2; ++a)
#pragma unroll
        for (int b = 0; b < 2; ++b)
#pragma unroll
            for (int m = 0; m < 4; ++m)
#pragma unroll
                for (int n = 0; n < 2; ++n) acc[a][b][m][n] = (f32x4){0.f, 0.f, 0.f, 0.f};
    bf16x8 At[4][2], B0[2][2], B1[2][2];
    const char* cA = (const char*)((Epi::CHAIN && cur.part) ? g.A2 : g.A) + (size_t)cur.pm * tstep + (size_t)cur.k0 * 2; const char* cB = (const char*)((Epi::CHAIN && cur.part) ? g.Bt2 : g.Bt) + (size_t)cur.pn * tstep + (size_t)cur.k0 * 2;
    S.a_ready(cur);
    if constexpr (SP2) {
        PG8_STAGE(PG8_SB(0, 0), cB, voffB); PG8_STAGE(PG8_SB(0, 1), cB + hstep, voffB); PG8_STAGE(PG8_SA(0, 0), cA, voffA); PG8_STAGE(PG8_SA(0, 1), cA + hstep, voffA);
        if (wr == 1) PG8_BAR;
        PG8_WAIT_V(2); PG8_BAR;
        PG8_STAGE(PG8_SB(1, 0), cB + kstep, voffB); PG8_STAGE(PG8_SA(1, 0), cA + kstep, voffA); PG8_STAGE(PG8_SB(1, 1), cB + hstep + kstep, voffB);
        PG8_WAIT_V(6); PG8_BAR;
    } else {
        PG8_STAGE(PG8_SB(0, 0), cB, voffB); PG8_STAGE(PG8_SA(0, 0), cA, voffA); PG8_STAGE(PG8_SB(0, 1), cB + hstep, voffB); PG8_STAGE(PG8_SA(0, 1), cA + hstep, voffA);
        if (wr == 1) PG8_BAR;
        PG8_WAIT_V(4); PG8_BAR;
        PG8_STAGE(PG8_SB(1, 0), cB + kstep, voffB); PG8_STAGE(PG8_SA(1, 0), cA + kstep, voffA); PG8_STAGE(PG8_SB(1, 1), cB + hstep + kstep, voffB);
        PG8_WAIT_V(6); PG8_BAR;
    }
    for (;;) {
        const bool has_next = S.next(ui + 1, nxt);
        const char* nA = has_next ? (const char*)((Epi::CHAIN && nxt.part) ? g.A2 : g.A) + (size_t)nxt.pm * tstep + (size_t)nxt.k0 * 2 : cA; const char* nB = has_next ? (const char*)((Epi::CHAIN && nxt.part) ? g.Bt2 : g.Bt) + (size_t)nxt.pn * tstep + (size_t)nxt.k0 * 2 : cB;
        const int nt = cur.nt;
        for (int t = 0; t < nt; t += 2) {
            const bool last = (t == nt - 2);
            const char* a1 = cA + (size_t)(t + 1) * kstep;
            const char* a2 = last ? nA : cA + (size_t)(t + 2) * kstep; const char* b2 = last ? nB : cB + (size_t)(t + 2) * kstep;
            const char* a3 = a2 + kstep; const char* b3 = b2 + kstep;
            if (last && has_next) S.a_ready(nxt);
            if constexpr (SP2) {
            PG8_LDB(B0, 0, 0); PG8_LDB(B1, 0, 1); PG8_SCHED; PG8_LDA(At, 0, 0); PG8_STAGE(PG8_SA(1, 1), a1 + hstep, voffA);
            PG8_WAIT_V(8); PG8_WAIT_L(0); PG8_BAR; PG8_MMA(0, 0, At, B0); PG8_MMA(0, 1, At, B1); PG8_BAR; PG8_SCHED;
            PG8_LDA(At, 0, 1); PG8_STAGE(PG8_SB(0, 0), b2, voffB); PG8_STAGE(PG8_SB(0, 1), b2 + hstep, voffB); PG8_STAGE(PG8_SA(0, 0), a2, voffA);
            PG8_WAIT_V(8); PG8_WAIT_L(0); PG8_BAR; PG8_MMA(1, 0, At, B0); PG8_MMA(1, 1, At, B1); PG8_BAR; PG8_SCHED;
            PG8_LDB(B0, 1, 0); PG8_LDB(B1, 1, 1); PG8_SCHED; PG8_LDA(At, 1, 0); PG8_STAGE(PG8_SA(0, 1), a2 + hstep, voffA);
            PG8_WAIT_V(8); PG8_WAIT_L(0); PG8_BAR; PG8_MMA(0, 0, At, B0); PG8_MMA(0, 1, At, B1); PG8_BAR; PG8_SCHED;
            PG8_LDA(At, 1, 1); PG8_STAGE(PG8_SB(1, 0), b3, voffB); PG8_STAGE(PG8_SB(1, 1), b3 + hstep, voffB); PG8_STAGE(PG8_SA(1, 0), a3, voffA);
            PG8_WAIT_V(8); PG8_WAIT_L(0); PG8_BAR; PG8_MMA(1, 0, At, B0); PG8_MMA(1, 1, At, B1); PG8_BAR; PG8_SCHED;
            } else {
            PG8_LDB(B0, 0, 0); PG8_SCHED; PG8_LDA(At, 0, 0); PG8_STAGE(PG8_SA(1, 1), a1 + hstep, voffA);
            PG8_WAIT_L(8); PG8_BAR; PG8_WAIT_L(0); PG8_MMA(0, 0, At, B0); PG8_BAR; PG8_SCHED;
            PG8_LDB(B1, 0, 1); PG8_STAGE(PG8_SB(0, 0), b2, voffB);
            PG8_BAR; PG8_WAIT_L(0); PG8_MMA(0, 1, At, B1); PG8_BAR;
            PG8_LDA(At, 0, 1); PG8_STAGE(PG8_SA(0, 0), a2, voffA);
            PG8_BAR; PG8_WAIT_L(0); PG8_MMA(1, 0, At, B0); PG8_BAR; PG8_SCHED;
            PG8_STAGE(PG8_SB(0, 1), b2 + hstep, voffB);
            PG8_WAIT_V(6); PG8_BAR; PG8_MMA(1, 1, At, B1); PG8_BAR;
            PG8_LDB(B0, 1, 0); PG8_SCHED; PG8_LDA(At, 1, 0); PG8_STAGE(PG8_SA(0, 1), a2 + hstep, voffA);
            PG8_WAIT_L(8); PG8_BAR; PG8_WAIT_L(0); PG8_MMA(0, 0, At, B0); PG8_BAR; PG8_SCHED;
            PG8_LDB(B1, 1, 1); PG8_STAGE(PG8_SB(1, 0), b3, voffB);
            PG8_BAR; PG8_WAIT_L(0); PG8_MMA(0, 1, At, B1); PG8_BAR;
            PG8_LDA(At, 1, 1); PG8_STAGE(PG8_SA(1, 0), a3, voffA);
            PG8_BAR; PG8_WAIT_L(0); PG8_MMA(1, 0, At, B0); PG8_BAR; PG8_SCHED;
            PG8_STAGE(PG8_SB(1, 1), b3 + hstep, voffB);
            PG8_WAIT_V(6); PG8_BAR; PG8_MMA(1, 1, At, B1); PG8_BAR;
            }
        }
        if constexpr (ALIGN_EPI) { if (wr == 0) PG8_BAR; }
        const bool mid_unit = Epi::CHAIN && cur.part == 0;
        if constexpr (Epi::CHAIN) { if (mid_unit) E.mid(acc, cur, wr, wc, fr, fq); else { E(acc, cur, wr, wc, fr, fq); S.done(cur); } }
        else if constexpr (!Epi::AFTER_DRAIN) { E(acc, cur, wr, wc, fr, fq); S.done(cur); }
        if (!has_next) break;
        if (!mid_unit)
#pragma unroll
        for (int a = 0; a < 2; ++a)
#pragma unroll
            for (int b = 0; b < 2; ++b)
#pragma unroll
                for (int m = 0; m < 4; ++m)
#pragma unroll
                    for (int n = 0; n < 2; ++n) acc[a][b][m][n] = (f32x4){0.f, 0.f, 0.f, 0.f};
        cur = nxt; cA = nA; cB = nB; ++ui;
        if constexpr (ALIGN_EPI) { if (wr == 1) PG8_BAR; }
    }
    PG8_WAIT_V(0);
    if constexpr (!ALIGN_EPI) { if (wr == 0) PG8_BAR; }
    PG8_BAR;
    if constexpr (Epi::AFTER_DRAIN) { E.fused(acc, cur, wr, wc, fr, fq, lds, wid, lane); S.done(cur); }
#undef PG8_SA
#undef PG8_SB
#undef PG8_STAGE
#undef PG8_LDA
#undef PG8_LDB
#undef PG8_MMA
#undef PG8_WAIT_V
#undef PG8_WAIT_L
#undef PG8_BAR
#undef PG8_SCHED
}

template <class F>
__device__ __forceinline__ void gemm_quarter(PG8_LAS unsigned char* lds, const bf16_t* A, const bf16_t* Bt, int K, int qm, int qn, const F& f) {
    const int tid = threadIdx.x, wid = __builtin_amdgcn_readfirstlane(tid >> 6), lane = tid & 63, wr = wid >> 2, wc = wid & 3, fr = lane & 15, fq = lane >> 4;
    unsigned voffA[2], voffB[2];
#pragma unroll
    for (int i = 0; i < 2; ++i) { int R, C; stage_rc(tid * 16 + i * 8192, R, C); const int Rb = (R & ~31) + perm32(R & 31);
        voffA[i] = (unsigned)(R * K + C) * 2u; voffB[i] = (unsigned)(Rb * K + C) * 2u; }
    const size_t kstep = (size_t)(BK * 2);
    const unsigned ldsw = (unsigned)wid * 1024u;
    const int aoff = lds_byte(wr * 64 + fr, fq * 8), boff = lds_byte(wc * 32 + fr, fq * 8);
    const char* cA = (const char*)A + (size_t)qm * HALF * K * 2; const char* cB = (const char*)Bt + (size_t)qn * HALF * K * 2;
    const int nt = K / BK;
#define PG8_QSTAGE(slot, t_) do { const size_t go_ = (size_t)(t_) * kstep; _Pragma("unroll") for (int _i = 0; _i < 2; ++_i) { \
        __builtin_amdgcn_global_load_lds((const unsigned*)(cA + go_ + voffA[_i]), (PG8_LAS unsigned*)(lds + (slot) * HTB + ldsw + _i * 8192), 16, 0, 0); \
        __builtin_amdgcn_global_load_lds((const unsigned*)(cB + go_ + voffB[_i]), (PG8_LAS unsigned*)(lds + (4 + (slot)) * HTB + ldsw + _i * 8192), 16, 0, 0); } } while (0)
    f32x4 acc[4][2];
#pragma unroll
    for (int m = 0; m < 4; ++m)
#pragma unroll
        for (int n = 0; n < 2; ++n) acc[m][n] = (f32x4){0.f, 0.f, 0.f, 0.f};
    bf16x8 At[4][2], Bq[2][2];
    PG8_QSTAGE(0, 0); PG8_QSTAGE(1, 1); PG8_QSTAGE(2, 2);
    for (int t = 0; t < nt; t += 4) {
#pragma unroll
        for (int sl = 0; sl < 4; ++sl) {
            asm volatile("s_waitcnt vmcnt(8)" ::: "memory"); __builtin_amdgcn_s_barrier();
            { const int tn = t + sl + 3; PG8_QSTAGE((sl + 3) & 3, tn < nt ? tn : tn - nt); }
#pragma unroll
            for (int m = 0; m < 4; ++m)
#pragma unroll
                for (int k = 0; k < 2; ++k) At[m][k] = *(const PG8_LAS bf16x8*)(lds + sl * HTB + aoff + m * 2048 + k * 1024);
#pragma unroll
            for (int n = 0; n < 2; ++n)
#pragma unroll
                for (int k = 0; k < 2; ++k) Bq[n][k] = *(const PG8_LAS bf16x8*)(lds + (4 + sl) * HTB + boff + n * 2048 + k * 1024);
            asm volatile("s_waitcnt lgkmcnt(0)" ::: "memory");
            __builtin_amdgcn_s_setprio(1);
#pragma unroll
            for (int m = 0; m < 4; ++m)
#pragma unroll
                for (int n = 0; n < 2; ++n)
#pragma unroll
                    for (int k = 0; k < 2; ++k) acc[m][n] = __builtin_amdgcn_mfma_f32_16x16x32_bf16(Bq[n][k], At[m][k], acc[m][n], 0, 0, 0);
            __builtin_amdgcn_s_setprio(0);
            __builtin_amdgcn_sched_barrier(0);
        }
    }
    asm volatile("s_waitcnt vmcnt(0)" ::: "memory"); __builtin_amdgcn_s_barrier();
#undef PG8_QSTAGE
    const int row0 = qm * HALF + wr * 64 + fr, col0 = qn * HALF + wc * 32 + 8 * fq;
#pragma unroll
    for (int m = 0; m < 4; ++m) f(row0 + m * 16, col0, acc[m][0], acc[m][1], 0);
}
}

#ifndef PG8_SP2
#define PG8_SP2 true
#endif
#ifndef PG8_ALIGN
#define PG8_ALIGN true
#endif

constexpr int NWAVES = 8, NT = 512;
constexpr int TP = 8192, TS = 1024, T = TP + TS, D = 4096;
constexpr int SEQ = 2048, DSEQ = 8, NB = 4, NDB = 128;
constexpr int NPROJ = 20992;
constexpr int CQ = 0, CK = 1024, CV = 2048, CZG = 4096, CR = 6144, CKR = 8192, CVR = 10240, CXG = 12288, CSM = 12544, CGA = 12800, CGB = 16896;
constexpr int ZRC = 6592;
constexpr int DFF = 11008, NUP = 2 * DFF;
constexpr int NL1 = 5120;
constexpr int SCAN_REC = 896;
constexpr int SCAN_LREC = 1408;
constexpr size_t O_Y = 0, O_GLA_P = 37748736, O_RWKV_P = 39845888, O_SHIFT_P = 40370176, O_CONV_P = 40396544,
                 O_GLA_S = 40484608, O_RWKV_S = 107593472, O_SHIFT_S = 124370688, O_CONV_S = 125214464, O_END = 128032512;
constexpr size_t MiB = 1u << 20;
constexpr size_t WS_CTL = 0, CTL_ZERO_BYTES = 1 * MiB;
constexpr size_t WS_WT_IN = 1 * MiB, WS_WT_UP = 165 * MiB, WS_WT_DOWN = 337 * MiB, WS_WT_OUT = 423 * MiB, WS_WT_PEG = 455 * MiB, WS_WT_BRA = 487 * MiB,
                 WS_WT_BRB = 503 * MiB, WS_WT_PE = 519 * MiB, WS_WL1 = 521 * MiB, WS_WG = 524 * MiB, WS_H = 525 * MiB, WS_PROJ = 597 * MiB,
                 WS_SCAN = 984 * MiB, WS_G = 1380 * MiB, WS_LA = 1416 * MiB, WS_AL1 = 1452 * MiB, WS_AG = 1457 * MiB, WS_PB = 1462 * MiB,
                 WS_BONUS = 1467 * MiB, WS_END = 1469 * MiB;
constexpr size_t WS_QD = WS_H, WS_KDDT = WS_H + 16 * MiB, WS_VT = WS_H + 32 * MiB, WS_ATT = WS_H + 64 * MiB, WS_EB = WS_H + 68 * MiB;
constexpr size_t WS_RW1 = WS_WT_IN, WS_RW2 = WS_SCAN + 256 * MiB;
static_assert((size_t)NB * 32 * (SEQ / 16) * 7168 <= 164 * MiB && WS_RW2 + (size_t)NB * 32 * (SEQ / 16) * 6656 <= WS_G && (size_t)T * 32 * SCAN_REC <= 256 * MiB, "chunk operand arrays");
constexpr size_t WS_PP = WS_SCAN + 200 * MiB;
constexpr int CW_QUEUE = 64;
constexpr int CW_BAR = 4096;

constexpr int RING_BYTES = 131072, MISC_OFF = RING_BYTES + 320, LDS_BYTES = 147456;

#define LAS __attribute__((address_space(3)))
typedef unsigned short bf16;
typedef unsigned v4u __attribute__((ext_vector_type(4)));
typedef unsigned v2u __attribute__((ext_vector_type(2)));
typedef float f32x4 __attribute__((ext_vector_type(4)));
#define LDS_WAIT() asm volatile("s_waitcnt lgkmcnt(0)" ::: "memory")
#define VM_WAIT() asm volatile("s_waitcnt vmcnt(0)" ::: "memory")
#define WG_BAR() do { asm volatile("s_waitcnt lgkmcnt(0)" ::: "memory"); __builtin_amdgcn_s_barrier(); asm volatile("" ::: "memory"); } while (0)
__device__ __forceinline__ unsigned f2bf(float f) { unsigned u = __builtin_bit_cast(unsigned, f); return (u + 0x7fffu + ((u >> 16) & 1u)) >> 16; }
typedef __bf16 hw_bf2 __attribute__((ext_vector_type(2)));
typedef float hw_f2 __attribute__((ext_vector_type(2)));
__device__ __forceinline__ unsigned pk2(float lo, float hi) { const hw_f2 v = {lo, hi}; return __builtin_bit_cast(unsigned, __builtin_convertvector(v, hw_bf2)); }
__device__ __forceinline__ float bf2f(unsigned b) { return __builtin_bit_cast(float, b << 16); }
__device__ __forceinline__ float bflo(unsigned w) { return __builtin_bit_cast(float, w << 16); }
__device__ __forceinline__ float bfhi(unsigned w) { return __builtin_bit_cast(float, w & 0xffff0000u); }
__device__ __forceinline__ float sigmoidf_(float x) { return __builtin_amdgcn_rcpf(1.0f + __builtin_amdgcn_exp2f(x * -1.4426950408889634f)); }
__device__ __forceinline__ float softplusf_(float x) { return fmaxf(x, 0.f) + 0.6931471805599453f * __builtin_amdgcn_logf(1.0f + __builtin_amdgcn_exp2f(fabsf(x) * -1.4426950408889634f)); }
__device__ __forceinline__ float wave_sum(float v) {
#pragma unroll
    for (int o = 1; o < 64; o <<= 1) v += __shfl_xor(v, o);
    return v;
}

#define XB_TMO      128
#define XB_XCNT(j)  (256  + 64 * (j))
#define XB_XSUB(j)  (1280 + 64 * (j))
#define XB_XGEN(j)  (2304 + 64 * (j))
#define XB_TOP      3328
#define XB_TOPGEN   3392
#define XCD_BAR_WORDS 3456
#define XB_SPIN_CAP (1u << 23)
__device__ __forceinline__ unsigned xb_ld(unsigned* p)              { return __hip_atomic_load(p, __ATOMIC_RELAXED, __HIP_MEMORY_SCOPE_AGENT); }
__device__ __forceinline__ unsigned xb_add(unsigned* p, unsigned v) { return __hip_atomic_fetch_add(p, v, __ATOMIC_RELAXED, __HIP_MEMORY_SCOPE_AGENT); }
__device__ __forceinline__ unsigned xb_xcc_id() { return (unsigned)__builtin_amdgcn_s_getreg((3 << 11) | 20) & 0xFu; }
#define XB_SPIN(cond, bar) do { unsigned _sp = 0; while (cond) { __builtin_amdgcn_s_sleep(1); \
    if ((++_sp & 255u) == 0u) { if (xb_ld(&(bar)[XB_TMO])) break; if (_sp > XB_SPIN_CAP) { atomicAdd(&(bar)[XB_TMO], 1u); break; } } } } while (0)
struct XcdBarrier { unsigned* bar; unsigned x; volatile LAS unsigned* st; };
__device__ __forceinline__ XcdBarrier xcd_barrier_post(unsigned* bar, volatile LAS unsigned* st) {
    XcdBarrier b; b.bar = bar; b.x = xb_xcc_id(); b.st = st;
    if (threadIdx.x == 0) (void)xb_add(&bar[XB_XCNT(b.x)], 1u);
    return b;
}
__device__ __forceinline__ void xcd_barrier_complete(unsigned* bar, unsigned x, unsigned& nloc, unsigned& nx) {
    const unsigned G = gridDim.x * gridDim.y * gridDim.z;
    unsigned sum, cnt, mine, sp = 0u;
    for (;;) {
        sum = 0u; cnt = 0u; mine = 0u;
#pragma unroll
        for (unsigned j = 0; j < 16; ++j) { const unsigned c = xb_ld(&bar[XB_XCNT(j)]); sum += c; cnt += (c > 0u) ? 1u : 0u; mine = (j == x) ? c : mine; }
        if (sum == G) break;
        __builtin_amdgcn_s_sleep(1);
        if ((++sp & 255u) == 0u) { if (xb_ld(&bar[XB_TMO])) break; if (sp > XB_SPIN_CAP) { atomicAdd(&bar[XB_TMO], 1u); break; } }
    }
    nloc = mine > 0u ? mine : 1u; nx = cnt > 0u ? cnt : 1u;
}
__device__ __forceinline__ void xcd_barrier(const XcdBarrier& b) {
    asm volatile("s_waitcnt vmcnt(0)" ::: "memory");
    __syncthreads();
    if (threadIdx.x == 0) {
        unsigned* bar = b.bar;
        __builtin_amdgcn_s_waitcnt(0);
        unsigned nloc = b.st[0], nx = b.st[1];
        if (nloc == 0u) { xcd_barrier_complete(bar, b.x, nloc, nx); b.st[0] = nloc; b.st[1] = nx; }
        const unsigned old = xb_add(&bar[XB_XSUB(b.x)], 1u);
        const unsigned gen = old / nloc;
        if (old + 1u == (gen + 1u) * nloc) {
            __builtin_amdgcn_fence(__ATOMIC_RELEASE, "agent");
            asm volatile("s_waitcnt vmcnt(0)" ::: "memory");
            const unsigned og = xb_add(&bar[XB_TOP], 1u);
            const unsigned tg = og / nx;
            if (og + 1u == (tg + 1u) * nx) xb_add(&bar[XB_TOPGEN], 1u);
            else XB_SPIN(xb_ld(&bar[XB_TOPGEN]) == tg, bar);
            __builtin_amdgcn_fence(__ATOMIC_ACQUIRE, "agent");
            xb_add(&bar[XB_XGEN(b.x)], 1u);
            asm volatile("s_waitcnt vmcnt(0)" ::: "memory");
        } else {
            XB_SPIN(xb_ld(&bar[XB_XGEN(b.x)]) == gen, bar);
            __builtin_amdgcn_fence(__ATOMIC_ACQUIRE, "agent");
            asm volatile("s_waitcnt vmcnt(0)" ::: "memory");
        }
    }
    __syncthreads();
}

struct Args { const float* in[37]; float* out; unsigned char* ws; int ph_lo, ph_hi; };
typedef __attribute__((address_space(4))) const Args KArgs;
struct Frame { LAS unsigned char* lds; int tid, lane, wave, vcu, G, gw, NGW; };
enum { I_XP = 0, I_XS, I_SGLA, I_SRWKV, I_SSHIFT, I_SCONV, I_PP, I_PS, I_WIN, I_WALPHA2, I_BALPHA, I_GLANORM, I_WBRA, I_MU, I_W0, I_WDECAY2, I_A0, I_WICLR2,
       I_WGATE2, I_KK, I_KA, I_RK, I_LNXW, I_LNXB, I_WBRB, I_WOUT, I_GPREMIX, I_GPOSTMIX, I_GPREFFN, I_GPOSTFFN, I_WUP, I_CONVW, I_CONVB, I_WDOWN, I_GPE, I_WPEG, I_WPE };

struct SeqPos { int b, t, L; bool prm; };
__device__ __forceinline__ SeqPos seqpos(int m) { SeqPos s; s.prm = m < TP; if (s.prm) { s.b = m >> 11; s.t = m & 2047; s.L = SEQ; } else { s.b = (m - TP) >> 3; s.t = (m - TP) & 7; s.L = DSEQ; } return s; }
__device__ __forceinline__ const float* xrow(KArgs& a, int m) { return m < TP ? a.in[I_XP] + (size_t)m * D : a.in[I_XS] + (size_t)(m - TP) * D; }

__host__ __device__ __forceinline__ int win_src16(int g) {
    const int n = g * 16;
    if (n < 4096) return n;
    if (n < 6144) return 4112 + (n - 4096);
    if (n < 8192) return 6160 + (n - 6144);
    if (n < 10240) return 8304 + (n - 8192);
    if (n < 12288) return 10352 + (n - 10240);
    if (n < 12544) return 12496 + (n - 12288);
    if (n < 12560) return 4096;
    if (n < 12656) return 8208 + (n - 12560);
    if (n < 12752) return 12400 + (n - 12656);
    if (n < 12800) return -1;
    if (n < 16896) return 12752 + (n - 12800);
    return 16848 + (n - 16896);
}
__host__ __device__ __forceinline__ int zr_col(int oz) {
    if (oz < 2048) return CR + oz;
    if (oz < 2144) return CSM + 16 + (oz - 2048);
    if (oz < 4192) return CKR + (oz - 2144);
    if (oz < 6240) return CVR + (oz - 4192);
    if (oz < 6336) return CSM + 112 + (oz - 6240);
    return CXG + (oz - 6336);
}

struct TrDesc { const float* W; bf16* WT; int K, Nsrc, nblk, item; bool map; };
__device__ __forceinline__ void tr_load(const TrDesc& d, float (&tv)[32], int lane) {
    const int kb = d.item / d.nblk, nb = d.item - kb * d.nblk, k0 = 64 * kb, n0 = 32 * nb, nl = lane & 31;
    int sc = n0 + nl;
    if (d.map) { const int s = win_src16((n0 + nl) >> 4); sc = s < 0 ? -1 : s + (nl & 15); }
    const float* wp = d.W + (size_t)(k0 + (lane >> 5)) * d.Nsrc + (sc >= 0 ? sc : 0);
#pragma unroll
    for (int i = 0; i < 32; ++i) tv[i] = __builtin_nontemporal_load(wp + (size_t)(2 * i) * d.Nsrc);
}
__device__ __forceinline__ void tr_finish(const TrDesc& d, const float (&tv)[32], LAS float* scr, int lane) {
    const int kb = d.item / d.nblk, nb = d.item - kb * d.nblk, k0 = 64 * kb, n0 = 32 * nb, nl = lane & 31;
    bool pad = false;
    if (d.map) pad = win_src16((n0 + nl) >> 4) < 0;
#pragma unroll
    for (int i = 0; i < 32; ++i) scr[(2 * i + (lane >> 5)) * 33 + nl] = pad ? 0.f : tv[i];
    LDS_WAIT(); asm volatile("" ::: "memory");
    const int c = lane & 7;
#pragma unroll
    for (int j = 0; j < 4; ++j) { const int n = (lane >> 3) + 8 * j; const LAS float* s = scr + (8 * c) * 33 + n;
        v4u o; o.x = pk2(s[0 * 33], s[1 * 33]); o.y = pk2(s[2 * 33], s[3 * 33]); o.z = pk2(s[4 * 33], s[5 * 33]); o.w = pk2(s[6 * 33], s[7 * 33]);
        *(v4u*)(d.WT + (size_t)(n0 + n) * d.K + k0 + 8 * c) = o; }
    LDS_WAIT(); asm volatile("" ::: "memory");
}
__device__ __forceinline__ void rms_row_bf16(const float* xr_, const float* gain, bf16* orow, int lane) {
    const f32x4* xr = (const f32x4*)xr_ + lane; f32x4 v[16]; float ss = 0.f;
#pragma unroll
    for (int j = 0; j < 16; ++j) { v[j] = xr[64 * j]; ss += (v[j].x * v[j].x + v[j].y * v[j].y) + (v[j].z * v[j].z + v[j].w * v[j].w); }
    const float rs = __builtin_amdgcn_rsqf(wave_sum(ss) * (1.f / D) + 1e-6f);
    const f32x4* gr = (const f32x4*)gain + lane; v2u* o = (v2u*)orow + lane;
#pragma unroll
    for (int j = 0; j < 16; ++j) { const f32x4 g = gr[64 * j]; v2u w; w.x = pk2(v[j].x * rs * g.x, v[j].y * rs * g.y); w.y = pk2(v[j].z * rs * g.z, v[j].w * rs * g.w); o[64 * j] = w; }
}
__device__ __forceinline__ void sandwich_row(const float* srow, const bf16* brow, const float* slabrow, size_t slab_stride, int nslab, const float* xi, const float* g1, float* xo, const float* g2, bf16* ho, int lane) {
    f32x4 v[16]; float ss = 0.f;
    if (brow) { const v2u* br = (const v2u*)brow + lane;
#pragma unroll
        for (int j = 0; j < 16; ++j) { const v2u x = br[64 * j]; v[j] = (f32x4){bflo(x.x), bfhi(x.x), bflo(x.y), bfhi(x.y)}; } }
    else { const f32x4* sr = (const f32x4*)srow + lane;
#pragma unroll
        for (int j = 0; j < 16; ++j) v[j] = sr[64 * j]; }
    for (int p = 0; p < nslab; ++p) { const f32x4* pr = (const f32x4*)(slabrow + (size_t)p * slab_stride) + lane;
#pragma unroll
        for (int j = 0; j < 16; ++j) v[j] += pr[64 * j]; }
#pragma unroll
    for (int j = 0; j < 16; ++j) { ss += (v[j].x * v[j].x + v[j].y * v[j].y) + (v[j].z * v[j].z + v[j].w * v[j].w); }
    const float rs = __builtin_amdgcn_rsqf(wave_sum(ss) * (1.f / D) + 1e-6f);
    const f32x4* xr = (const f32x4*)xi + lane; const f32x4* gr = (const f32x4*)g1 + lane; f32x4* xw = (f32x4*)xo + lane; float s2 = 0.f;
#pragma unroll
    for (int j = 0; j < 16; ++j) { const f32x4 x = xr[64 * j], g = gr[64 * j]; v[j] = x + v[j] * rs * g; xw[64 * j] = v[j]; s2 += (v[j].x * v[j].x + v[j].y * v[j].y) + (v[j].z * v[j].z + v[j].w * v[j].w); }
    const float r2 = __builtin_amdgcn_rsqf(wave_sum(s2) * (1.f / D) + 1e-6f);
    const f32x4* g2r = (const f32x4*)g2 + lane; v2u* o = (v2u*)ho + lane;
#pragma unroll
    for (int j = 0; j < 16; ++j) { const f32x4 g = g2r[64 * j]; v2u w; w.x = pk2(v[j].x * r2 * g.x, v[j].y * r2 * g.y); w.y = pk2(v[j].z * r2 * g.z, v[j].w * r2 * g.w); o[64 * j] = w; }
}

struct FStoreBf16 { bf16* O; int ld;
    __device__ __forceinline__ void operator()(int row, int col, f32x4 v0, f32x4 v1, int) const {
        v4u w; w.x = pg8::cvt_pk_bf16(v0[0], v0[1]); w.y = pg8::cvt_pk_bf16(v0[2], v0[3]); w.z = pg8::cvt_pk_bf16(v1[0], v1[1]); w.w = pg8::cvt_pk_bf16(v1[2], v1[3]);
        __builtin_nontemporal_store(w, (v4u*)(O + (size_t)row * ld + col)); } };
struct FStoreF32Split { float* O; int ld; float* slab; int row0; size_t slab_stride; bf16* Ob;
    __device__ __forceinline__ void operator()(int row, int col, f32x4 v0, f32x4 v1, int part) const {
        if (row < row0) { v4u w; w.x = pg8::cvt_pk_bf16(v0[0], v0[1]); w.y = pg8::cvt_pk_bf16(v0[2], v0[3]); w.z = pg8::cvt_pk_bf16(v1[0], v1[1]); w.w = pg8::cvt_pk_bf16(v1[2], v1[3]); *(v4u*)(Ob + (size_t)row * ld + col) = w; return; }
        float* p = part == 0 ? O + (size_t)row * ld + col : slab + (size_t)(part - 1) * slab_stride + (size_t)(row - row0) * ld + col; *(f32x4*)p = v0; *(f32x4*)(p + 4) = v1; } };
struct FStoreF32 { float* O; int ld;
    __device__ __forceinline__ void operator()(int row, int col, f32x4 v0, f32x4 v1, int) const { float* p = O + (size_t)row * ld + col; *(f32x4*)p = v0; *(f32x4*)(p + 4) = v1; } };
struct FBrA { const bf16* proj; float* tmp;
    __device__ __forceinline__ void operator()(int row, int col, f32x4 v0, f32x4 v1, int) const {
        const v4u g = *(const v4u*)(proj + (size_t)row * NPROJ + CGA + col);
        f32x4 s0 = {sigmoidf_(bflo(g.x)), sigmoidf_(bfhi(g.x)), sigmoidf_(bflo(g.y)), sigmoidf_(bfhi(g.y))}, s1 = {sigmoidf_(bflo(g.z)), sigmoidf_(bfhi(g.z)), sigmoidf_(bflo(g.w)), sigmoidf_(bfhi(g.w))};
        float* p = tmp + (size_t)row * D + col; *(f32x4*)p = s0 * v0; *(f32x4*)(p + 4) = s1 * v1; } };
struct FBrB { const bf16* proj; const float* tmp; bf16* mixed;
    __device__ __forceinline__ void operator()(int row, int col, f32x4 v0, f32x4 v1, int) const {
        const v4u g = *(const v4u*)(proj + (size_t)row * NPROJ + CGB + col);
        f32x4 s0 = {sigmoidf_(bflo(g.x)), sigmoidf_(bfhi(g.x)), sigmoidf_(bflo(g.y)), sigmoidf_(bfhi(g.y))}, s1 = {sigmoidf_(bflo(g.z)), sigmoidf_(bfhi(g.z)), sigmoidf_(bflo(g.w)), sigmoidf_(bfhi(g.w))};
        const float* p = tmp + (size_t)row * D + col; const f32x4 a0 = *(const f32x4*)p + s0 * v0, a1 = *(const f32x4*)(p + 4) + s1 * v1;
        v4u w; w.x = pg8::cvt_pk_bf16(a0[0], a0[1]); w.y = pg8::cvt_pk_bf16(a0[2], a0[3]); w.z = pg8::cvt_pk_bf16(a1[0], a1[1]); w.w = pg8::cvt_pk_bf16(a1[2], a1[3]);
        *(v4u*)(mixed + (size_t)row * D + col) = w; } };
struct FPeg { float* y; const bf16* pp;
    __device__ __forceinline__ void operator()(int row, int col, f32x4 v0, f32x4 v1, int) const {
        const v4u g = *(const v4u*)(pp + (size_t)row * D + col); float* p = y + (size_t)row * D + col;
        const f32x4 p0 = {bflo(g.x), bfhi(g.x), bflo(g.y), bfhi(g.y)}, p1 = {bflo(g.z), bfhi(g.z), bflo(g.w), bfhi(g.w)};
        f32x4 s0 = {sigmoidf_(v0[0]), sigmoidf_(v0[1]), sigmoidf_(v0[2]), sigmoidf_(v0[3])}, s1 = {sigmoidf_(v1[0]), sigmoidf_(v1[1]), sigmoidf_(v1[2]), sigmoidf_(v1[3])};
        *(f32x4*)p = *(const f32x4*)p + s0 * p0; *(f32x4*)(p + 4) = *(const f32x4*)(p + 4) + s1 * p1; } };

template <class F> __device__ __forceinline__ void run_gemm(Frame& F_, const bf16* A, const bf16* Bt, int M, int N, int K, const F& f) {
    pg8::Gemm g{A, Bt, M, N, K, nullptr, nullptr}; pg8::StaticOrder S; S.init(M, N, K, F_.G, (int)blockIdx.x);
    pg8::EpiRow8<F> E{f};
    pg8::gemm_phase<pg8::EpiRow8<F>, pg8::StaticOrder, PG8_ALIGN, PG8_SP2>(F_.lds, g, S, E);
}

struct FBranch { const bf16* proj; bf16* mixed;
    __device__ __forceinline__ void mid(int row, int col, f32x4& v0, f32x4& v1) const {
        const v4u ga = *(const v4u*)(proj + (size_t)row * NPROJ + CGA + col), gb = *(const v4u*)(proj + (size_t)row * NPROJ + CGB + col);
        const float a[8] = {bflo(ga.x), bfhi(ga.x), bflo(ga.y), bfhi(ga.y), bflo(ga.z), bfhi(ga.z), bflo(ga.w), bfhi(ga.w)}, b[8] = {bflo(gb.x), bfhi(gb.x), bflo(gb.y), bfhi(gb.y), bflo(gb.z), bfhi(gb.z), bflo(gb.w), bfhi(gb.w)};
#pragma unroll
        for (int e = 0; e < 4; ++e) { v0[e] *= (1.0f + __expf(-b[e])) * __builtin_amdgcn_rcpf(1.0f + __expf(-a[e])); v1[e] *= (1.0f + __expf(-b[4 + e])) * __builtin_amdgcn_rcpf(1.0f + __expf(-a[4 + e])); } }
    __device__ __forceinline__ void operator()(int row, int col, f32x4 v0, f32x4 v1, int) const {
        const v4u g = *(const v4u*)(proj + (size_t)row * NPROJ + CGB + col);
        const f32x4 s0 = {sigmoidf_(bflo(g.x)), sigmoidf_(bfhi(g.x)), sigmoidf_(bflo(g.y)), sigmoidf_(bfhi(g.y))}, s1 = {sigmoidf_(bflo(g.z)), sigmoidf_(bfhi(g.z)), sigmoidf_(bflo(g.w)), sigmoidf_(bfhi(g.w))};
        const f32x4 a0 = s0 * v0, a1 = s1 * v1;
        v4u w; w.x = pg8::cvt_pk_bf16(a0[0], a0[1]); w.y = pg8::cvt_pk_bf16(a0[2], a0[3]); w.z = pg8::cvt_pk_bf16(a1[0], a1[1]); w.w = pg8::cvt_pk_bf16(a1[2], a1[3]);
        *(v4u*)(mixed + (size_t)row * D + col) = w; } };
template <class F> __device__ __forceinline__ void run_gemm_chain(Frame& F_, const bf16* A, const bf16* Bt, const bf16* A2, const bf16* Bt2, int M, int N, int K, const F& f) {
    pg8::Gemm g{A, Bt, M, N, K, A2, Bt2}; pg8::ChainOrder S; S.init(M, N, K, F_.G, (int)blockIdx.x);
    pg8::EpiRow8Chain<F> E{f};
    pg8::gemm_phase<pg8::EpiRow8Chain<F>, pg8::ChainOrder, PG8_ALIGN, PG8_SP2>(F_.lds, g, S, E);
}
template <class F> __device__ __forceinline__ void run_gemm_lim(Frame& F_, const bf16* A, const bf16* Bt, int M, int N, int K, const F& f, int lim) {
    pg8::Gemm g{A, Bt, M, N, K, nullptr, nullptr}; pg8::StaticOrder S; S.init(M, N, K, F_.G, (int)blockIdx.x); S.lim = lim;
    pg8::EpiRow8<F> E{f};
    pg8::gemm_phase<pg8::EpiRow8<F>, pg8::StaticOrder, PG8_ALIGN, PG8_SP2>(F_.lds, g, S, E);
}
template <class F> __device__ __forceinline__ void run_gemm_gc(Frame& F_, const bf16* A, const bf16* Bt, int M, int N, int K, const F& f, int G, int c) {
    pg8::Gemm g{A, Bt, M, N, K, nullptr, nullptr}; pg8::StaticOrder S; S.init(M, N, K, G, c);
    pg8::EpiRow8<F> E{f};
    pg8::gemm_phase<pg8::EpiRow8<F>, pg8::StaticOrder, PG8_ALIGN, PG8_SP2>(F_.lds, g, S, E);
}
template <class F> __device__ __forceinline__ void run_gemm_split(Frame& F_, const bf16* A, const bf16* Bt, int M, int N, int K, const F& f) {
    pg8::Gemm g{A, Bt, M, N, K, nullptr, nullptr}; pg8::SplitOrder S; S.init(M, N, K, F_.G, (int)blockIdx.x);
    pg8::EpiRow8<F> E{f};
    pg8::gemm_phase<pg8::EpiRow8<F>, pg8::SplitOrder, PG8_ALIGN, PG8_SP2>(F_.lds, g, S, E);
}

typedef float f32x2 __attribute__((ext_vector_type(2)));
__device__ __forceinline__ float dpp_f(float x, int ctrl_sel) {
    const int v = __builtin_bit_cast(int, x); int r;
    if (ctrl_sel == 0) r = __builtin_amdgcn_update_dpp(v, v, 0xB1, 0xF, 0xF, false);
    else if (ctrl_sel == 1) r = __builtin_amdgcn_update_dpp(v, v, 0x4E, 0xF, 0xF, false);
    else r = __builtin_amdgcn_update_dpp(v, v, 0x141, 0xF, 0xF, false);
    return __builtin_bit_cast(float, r);
}
__device__ __forceinline__ float sum8(float x) {
    float a, b, c;
    asm volatile("s_nop 1\n\tv_add_f32_dpp %0, %1, %1 quad_perm:[1,0,3,2] row_mask:0xf bank_mask:0xf" : "=v"(a) : "v"(x));
    asm volatile("s_nop 1\n\tv_add_f32_dpp %0, %1, %1 quad_perm:[2,3,0,1] row_mask:0xf bank_mask:0xf" : "=v"(b) : "v"(a));
    asm volatile("s_nop 1\n\tv_add_f32_dpp %0, %1, %1 row_half_mirror row_mask:0xf bank_mask:0xf" : "=v"(c) : "v"(b));
    return c;
}
template <int HEADS>
__device__ __forceinline__ void rwkv_unit(Frame& F, const unsigned char* scan, int m0, int L, int h, const float* S0, float* Sout, float* OB) {
    constexpr int TB = 16, RB = SCAN_LREC, RG = SCAN_REC, PCS = RG / 16, NPC = (TB * PCS + 511) / 512;
    LAS unsigned char* buf = F.lds;
    const int tid = F.tid, v = tid >> 3, j = tid & 7;
    f32x2 S[4];
    if (S0) { const f32x4 a = *(const f32x4*)(S0 + v * 64 + 8 * j), b = *(const f32x4*)(S0 + v * 64 + 8 * j + 4); S[0] = (f32x2){a.x, a.y}; S[1] = (f32x2){a.z, a.w}; S[2] = (f32x2){b.x, b.y}; S[3] = (f32x2){b.z, b.w}; }
    else {
#pragma unroll
        for (int i = 0; i < 4; ++i) S[i] = (f32x2){0.f, 0.f}; }
    const int nst = L < TB ? L : TB, nblk = HEADS ? HEADS : L / nst, nch = nst * PCS;
    constexpr int DUMMY = 2 * TB * RB;
    int goff[NPC], lo0[NPC], lo1[NPC]; bool cv[NPC];
#pragma unroll
    for (int i = 0; i < NPC; ++i) { const int c = tid + 512 * i; const bool valid = c < nch; const int cc = valid ? c : 0, st = cc / PCS, p = cc - st * PCS; goff[i] = st * 32 * RG + p * 16;
        const int lo = st * RB + (p < 16 ? p * 16 : (p < 48 ? 256 + (p - 16) * 32 : 1280 + (p - 48) * 16)); cv[i] = p >= 16 && p < 48;
        lo0[i] = valid ? lo : -1; lo1[i] = (valid && cv[i]) ? lo + 16 : -1; }
    const unsigned char* gsrc = scan + ((size_t)m0 * 32 + h) * RG;
    const size_t bstep = HEADS ? (size_t)RG : (size_t)nst * 32 * RG;
#define RW_PUT(bo_, i_) do { const v4u x_ = pre[i_]; const f32x4 c0_ = {bflo(x_.x), bfhi(x_.x), bflo(x_.y), bfhi(x_.y)}, c1_ = {bflo(x_.z), bfhi(x_.z), bflo(x_.w), bfhi(x_.w)}; \
        *(LAS v4u*)(buf + (lo0[i_] >= 0 ? (bo_) + lo0[i_] : DUMMY)) = cv[i_] ? __builtin_bit_cast(v4u, c0_) : x_; *(LAS f32x4*)(buf + (lo1[i_] >= 0 ? (bo_) + lo1[i_] : DUMMY + 16)) = c1_; } while (0)
    LAS float* obuf = (LAS float*)(buf + DUMMY + 64); float* obg = OB + (size_t)m0 * 2048 + h * 64;
    v4u pre[NPC], prf[NPC];
    __syncthreads();
#pragma unroll
    for (int i = 0; i < NPC; ++i) pre[i] = *(const v4u*)(gsrc + goff[i]);
#pragma unroll
    for (int i = 0; i < NPC; ++i) RW_PUT(0, i);
    { const unsigned char* g1 = gsrc + (nblk > 1 ? bstep : 0);
#pragma unroll
      for (int i = 0; i < NPC; ++i) prf[i] = *(const v4u*)(g1 + goff[i]); }
    WG_BAR();
#define RW_LD(dst, rec_) do { const LAS unsigned char* r_ = (rec_); dst[0] = *(const LAS f32x4*)(r_); dst[1] = *(const LAS f32x4*)(r_ + 16); dst[2] = *(const LAS f32x4*)(r_ + 256); dst[3] = *(const LAS f32x4*)(r_ + 272); \
            dst[4] = *(const LAS f32x4*)(r_ + 512); dst[5] = *(const LAS f32x4*)(r_ + 528); dst[6] = *(const LAS f32x4*)(r_ + 768); dst[7] = *(const LAS f32x4*)(r_ + 784); dst[8] = *(const LAS f32x4*)(r_ + 1024); dst[9] = *(const LAS f32x4*)(r_ + 1040); } while (0)
    auto do_block = [&](int blk, v4u (&ld)[NPC], v4u (&use)[NPC]) {
        { const int b2 = blk + 2 < nblk ? blk + 2 : nblk - 1; const unsigned char* g2 = gsrc + (size_t)b2 * bstep;
#pragma unroll
          for (int i = 0; i < NPC; ++i) ld[i] = *(const v4u*)(g2 + goff[i]); }
        f32x4 na = {0.f, 0.f, 0.f, 0.f}, nb = na;
        if (HEADS) { const float* sn = S0 + (size_t)(blk + 1 < nblk ? blk + 1 : blk) * 4096 + v * 64 + 8 * j; na = *(const f32x4*)sn; nb = *(const f32x4*)(sn + 4); }
        const LAS unsigned char* cb = buf + (blk & 1) * (TB * RB) + 32 * j;
        f32x4 X[10], Y[10]; unsigned xv, yv;
        RW_LD(X, cb); xv = *(const LAS bf16*)(cb - 32 * j + 1280 + 2 * v);
#pragma unroll 2
        for (int s = 0; s < nst; ++s) {
            const LAS unsigned char* rn = cb + (s + 1 < nst ? s + 1 : s) * RB;
            yv = *(const LAS bf16*)(rn - 32 * j + 1280 + 2 * v); RW_LD(Y, rn);
            const float vv = bf2f(xv);
            const f32x2 W[4] = {{X[0].x, X[0].y}, {X[0].z, X[0].w}, {X[1].x, X[1].y}, {X[1].z, X[1].w}}, R[4] = {{X[2].x, X[2].y}, {X[2].z, X[2].w}, {X[3].x, X[3].y}, {X[3].z, X[3].w}}, K[4] = {{X[4].x, X[4].y}, {X[4].z, X[4].w}, {X[5].x, X[5].y}, {X[5].z, X[5].w}},
                        N[4] = {{X[6].x, X[6].y}, {X[6].z, X[6].w}, {X[7].x, X[7].y}, {X[7].z, X[7].w}}, A[4] = {{X[8].x, X[8].y}, {X[8].z, X[8].w}, {X[9].x, X[9].y}, {X[9].z, X[9].w}};
            f32x2 p = (S[0] * N[0] + S[1] * N[1]) + (S[2] * N[2] + S[3] * N[3]);
            const float sa = sum8(p.x + p.y);
            const f32x2 sa2 = {sa, sa}, vv2 = {vv, vv};
#pragma unroll
            for (int i = 0; i < 4; ++i) S[i] = S[i] * W[i] + sa2 * A[i] + vv2 * K[i];
            f32x2 q = (S[0] * R[0] + S[1] * R[1]) + (S[2] * R[2] + S[3] * R[3]);
            const float o = sum8(q.x + q.y);
            obuf[(blk & 1) * (TB * 64) + s * 64 + v] = o;
#pragma unroll
            for (int i = 0; i < 10; ++i) X[i] = Y[i];
            xv = yv;
        }
        if (HEADS) { float* so = Sout + (size_t)blk * 4096 + v * 64 + 8 * j; *(f32x4*)so = (f32x4){S[0].x, S[0].y, S[1].x, S[1].y}; *(f32x4*)(so + 4) = (f32x4){S[2].x, S[2].y, S[3].x, S[3].y};
            S[0] = (f32x2){na.x, na.y}; S[1] = (f32x2){na.z, na.w}; S[2] = (f32x2){nb.x, nb.y}; S[3] = (f32x2){nb.z, nb.w}; }
        { const int nbo = ((blk + 1) & 1) * (TB * RB);
#pragma unroll
          for (int i = 0; i < NPC; ++i) asm volatile("" : "+v"(use[i]));
#pragma unroll
          for (int i = 0; i < NPC; ++i) { pre[i] = use[i]; RW_PUT(nbo, i); } }
        WG_BAR();
        if (tid < nst * 16) { const int s = tid >> 4, c4 = (tid & 15) * 4; *(f32x4*)(obg + (HEADS ? (size_t)s * 2048 + blk * 64 : (size_t)(blk * nst + s) * 2048) + c4) = *(const LAS f32x4*)(obuf + (blk & 1) * (TB * 64) + s * 64 + c4); }
    };
    v4u prg[NPC];
    for (int blk = 0; blk < nblk; blk += 2) {
        do_block(blk, prg, prf);
        if (blk + 1 < nblk) do_block(blk + 1, prf, prg);
    }
#undef RW_LD
    if (!HEADS) { f32x4 a = {S[0].x, S[0].y, S[1].x, S[1].y}, b = {S[2].x, S[2].y, S[3].x, S[3].y};
        *(f32x4*)(Sout + v * 64 + 8 * j) = a; *(f32x4*)(Sout + v * 64 + 8 * j + 4) = b; }
#undef RW_PUT
}

typedef short bf16x8v __attribute__((ext_vector_type(8)));
constexpr int RW_C = 16, RW_NCH = SEQ / RW_C, RW_A1 = 7168, RW_A2 = 6656, RW_LSTR = 72;
__device__ __forceinline__ void rwkv_prep_unit(LAS unsigned char* wl, int lane, const unsigned char* scan, int m_base, int h, unsigned char* a1, unsigned char* a2) {
    LAS bf16* rowA = (LAS bf16*)wl; LAS bf16* rowR = rowA + 16 * RW_LSTR; LAS bf16* rowB = rowR + 16 * RW_LSTR; LAS bf16* rowK = rowB + 16 * RW_LSTR; LAS float* Ns = (LAS float*)(wl + 9216);
    const int key = lane, r16 = lane & 15, q = lane >> 4;
    const unsigned char* rec0 = scan + ((size_t)m_base * 32 + h) * SCAN_REC;
    float wv[16]; unsigned rr[16], kx[16], nn[16], aa[16], vx[16];
#pragma unroll
    for (int t = 0; t < 16; ++t) { const unsigned char* rec = rec0 + (size_t)t * 32 * SCAN_REC; wv[t] = *(const float*)(rec + 4 * key); rr[t] = *(const bf16*)(rec + 256 + 2 * key); kx[t] = *(const bf16*)(rec + 384 + 2 * key);
        nn[t] = *(const bf16*)(rec + 512 + 2 * key); aa[t] = *(const bf16*)(rec + 640 + 2 * key); vx[t] = *(const bf16*)(rec + 768 + 2 * key); }
    float cum[16]; float run = 0.f;
#pragma unroll
    for (int t = 0; t < 16; ++t) { const float cprev = run; run += __builtin_amdgcn_logf(wv[t]); cum[t] = run;
        const float g = __builtin_amdgcn_exp2f(run), gi = __builtin_amdgcn_exp2f(-run), gp = __builtin_amdgcn_exp2f(cprev);
        const unsigned ar = pk2(bf2f(nn[t]) * gp, bf2f(rr[t]) * g), bk = pk2(bf2f(aa[t]) * gi, bf2f(kx[t]) * gi);
        rowA[t * RW_LSTR + key] = (bf16)ar; rowR[t * RW_LSTR + key] = (bf16)(ar >> 16); rowB[t * RW_LSTR + key] = (bf16)bk; rowK[t * RW_LSTR + key] = (bf16)(bk >> 16); }
    {
        unsigned bgp[8], kgp[8], vp[8];
#pragma unroll
        for (int j = 0; j < 8; ++j) { const float e0 = __builtin_amdgcn_exp2f(run - cum[2 * j]), e1 = __builtin_amdgcn_exp2f(run - cum[2 * j + 1]);
            bgp[j] = pk2(bf2f(aa[2 * j]) * e0, bf2f(aa[2 * j + 1]) * e1); kgp[j] = pk2(bf2f(kx[2 * j]) * e0, bf2f(kx[2 * j + 1]) * e1); vp[j] = vx[2 * j] | (vx[2 * j + 1] << 16); }
        unsigned char* sb = a2 + (key >> 4) * 1024 + (key & 15) * 16;
#pragma unroll
        for (int kq = 0; kq < 4; ++kq) { v4u o; o.x = bgp[2 * kq]; o.y = bgp[2 * kq + 1]; o.z = kgp[2 * kq]; o.w = kgp[2 * kq + 1]; *(v4u*)(sb + kq * 256) = o; }
        *(float*)(a2 + 4096 + 4 * key) = __builtin_amdgcn_exp2f(run);
        v4u o0, o1; o0.x = vp[0]; o0.y = vp[1]; o0.z = vp[2]; o0.w = vp[3]; o1.x = vp[4]; o1.y = vp[5]; o1.z = vp[6]; o1.w = vp[7];
        *(v4u*)(a2 + 4352 + key * 32) = o0; *(v4u*)(a2 + 4352 + key * 32 + 16) = o1; }
    LDS_WAIT(); asm volatile("" ::: "memory");
    f32x4 nab = {0.f, 0.f, 0.f, 0.f}, mbr = nab, nak = nab, mkr = nab;
#pragma unroll
    for (int m = 0; m < 2; ++m) { const int o = r16 * RW_LSTR + 32 * m + 8 * q;
        const bf16x8v fb = *(const LAS bf16x8v*)(rowB + o), fk = *(const LAS bf16x8v*)(rowK + o), fa = *(const LAS bf16x8v*)(rowA + o), fr = *(const LAS bf16x8v*)(rowR + o);
        nab = __builtin_amdgcn_mfma_f32_16x16x32_bf16(fb, fa, nab, 0, 0, 0); mbr = __builtin_amdgcn_mfma_f32_16x16x32_bf16(fb, fr, mbr, 0, 0, 0);
        nak = __builtin_amdgcn_mfma_f32_16x16x32_bf16(fk, fa, nak, 0, 0, 0); mkr = __builtin_amdgcn_mfma_f32_16x16x32_bf16(fk, fr, mkr, 0, 0, 0); }
    {   const int t = r16, s0 = 4 * q; v4u fn, fm;
        fn.x = 0u; fn.y = 0u; fn.z = pk2(s0 < t ? nak[0] : 0.f, s0 + 1 < t ? nak[1] : 0.f); fn.w = pk2(s0 + 2 < t ? nak[2] : 0.f, s0 + 3 < t ? nak[3] : 0.f);
        fm.x = pk2(s0 <= t ? mbr[0] : 0.f, s0 + 1 <= t ? mbr[1] : 0.f); fm.y = pk2(s0 + 2 <= t ? mbr[2] : 0.f, s0 + 3 <= t ? mbr[3] : 0.f);
        fm.z = pk2(s0 <= t ? mkr[0] : 0.f, s0 + 1 <= t ? mkr[1] : 0.f); fm.w = pk2(s0 + 2 <= t ? mkr[2] : 0.f, s0 + 3 <= t ? mkr[3] : 0.f);
        *(v4u*)(a1 + 4096 + lane * 16) = fn; *(v4u*)(a1 + 6144 + lane * 16) = fm;
#pragma unroll
        for (int i = 0; i < 4; ++i) Ns[(s0 + i) * 16 + t] = (s0 + i < t) ? nab[i] : 0.f; }
#pragma unroll
    for (int m = 0; m < 2; ++m) { const int o = r16 * RW_LSTR + 32 * m + 4 * q;
        const v2u alo = *(const LAS v2u*)(rowA + o), ahi = *(const LAS v2u*)(rowA + o + 16), rlo = *(const LAS v2u*)(rowR + o), rhi = *(const LAS v2u*)(rowR + o + 16);
        v4u fa, fr; fa.x = alo.x; fa.y = alo.y; fa.z = ahi.x; fa.w = ahi.y; fr.x = rlo.x; fr.y = rlo.y; fr.z = rhi.x; fr.w = rhi.y;
        *(v4u*)(a1 + m * 1024 + lane * 16) = fa; *(v4u*)(a1 + 2048 + m * 1024 + lane * 16) = fr; }
    LDS_WAIT(); asm volatile("" ::: "memory");
    float x[16];
#pragma unroll
    for (int s_ = 15; s_ >= 0; --s_) { float acc = (s_ == r16) ? 1.f : 0.f;
        const f32x4 n0 = *(const LAS f32x4*)(Ns + s_ * 16), n1 = *(const LAS f32x4*)(Ns + s_ * 16 + 4), n2 = *(const LAS f32x4*)(Ns + s_ * 16 + 8), n3 = *(const LAS f32x4*)(Ns + s_ * 16 + 12);
        const float nr[16] = {n0.x, n0.y, n0.z, n0.w, n1.x, n1.y, n1.z, n1.w, n2.x, n2.y, n2.z, n2.w, n3.x, n3.y, n3.z, n3.w};
#pragma unroll
        for (int sp = s_ + 1; sp < 16; ++sp) acc += nr[sp] * x[sp];
        x[s_] = acc; }
    {   const float x0 = q == 0 ? x[0] : q == 1 ? x[4] : q == 2 ? x[8] : x[12], x1 = q == 0 ? x[1] : q == 1 ? x[5] : q == 2 ? x[9] : x[13];
        const float x2 = q == 0 ? x[2] : q == 1 ? x[6] : q == 2 ? x[10] : x[14], x3 = q == 0 ? x[3] : q == 1 ? x[7] : q == 2 ? x[11] : x[15];
        v4u fx; fx.x = pk2(x0, x1); fx.y = pk2(x2, x3); fx.z = 0u; fx.w = 0u; *(v4u*)(a1 + 5120 + lane * 16) = fx; }
    LDS_WAIT(); asm volatile("" ::: "memory");
}
struct RwSet { v4u fa0, fa1, fr0, fr1, fn, fx, fm, fs0, fs1, fs2, fs3; f32x4 g0, g1, g2, g3; v2u vt; };
__device__ __forceinline__ void rw_load(RwSet& S, const unsigned char* arr1, const unsigned char* arr2, size_t uc, int lane, int ws) {
    const unsigned char* p1 = arr1 + uc * RW_A1 + lane * 16; const unsigned char* p2 = arr2 + uc * RW_A2; const int r16 = lane & 15, q = lane >> 4;
    S.fa0 = *(const v4u*)p1; S.fa1 = *(const v4u*)(p1 + 1024); S.fr0 = *(const v4u*)(p1 + 2048); S.fr1 = *(const v4u*)(p1 + 3072); S.fn = *(const v4u*)(p1 + 4096); S.fx = *(const v4u*)(p1 + 5120); S.fm = *(const v4u*)(p1 + 6144);
    S.fs0 = *(const v4u*)(p2 + lane * 16); S.fs1 = *(const v4u*)(p2 + 1024 + lane * 16); S.fs2 = *(const v4u*)(p2 + 2048 + lane * 16); S.fs3 = *(const v4u*)(p2 + 3072 + lane * 16);
    const unsigned char* gp = p2 + 4096 + 16 * q; S.g0 = *(const f32x4*)gp; S.g1 = *(const f32x4*)(gp + 64); S.g2 = *(const f32x4*)(gp + 128); S.g3 = *(const f32x4*)(gp + 192);
    S.vt = *(const v2u*)(p2 + 4352 + (16 * ws + r16) * 32 + 8 * q);
}
__device__ __forceinline__ bf16x8v rw_bc(unsigned a, unsigned b, unsigned c, unsigned d) { v4u t; t.x = a; t.y = b; t.z = c; t.w = d; return __builtin_bit_cast(bf16x8v, t); }
typedef __bf16 rw_bf2 __attribute__((ext_vector_type(2)));
__device__ __forceinline__ unsigned cvt_pk_bf16(float lo, float hi) { const pg8::f32x2 v = {lo, hi}; return __builtin_bit_cast(unsigned, __builtin_convertvector(v, rw_bf2)); }
__device__ __forceinline__ void rw_step(const RwSet& S, f32x4 (&H)[4], float* ob) {
    const bf16x8v hb0 = rw_bc(cvt_pk_bf16(H[0][0], H[0][1]), cvt_pk_bf16(H[0][2], H[0][3]), cvt_pk_bf16(H[1][0], H[1][1]), cvt_pk_bf16(H[1][2], H[1][3]));
    const bf16x8v hb1 = rw_bc(cvt_pk_bf16(H[2][0], H[2][1]), cvt_pk_bf16(H[2][2], H[2][3]), cvt_pk_bf16(H[3][0], H[3][1]), cvt_pk_bf16(H[3][2], H[3][3]));
    const f32x4 z = {0.f, 0.f, 0.f, 0.f};
    f32x4 Y = __builtin_amdgcn_mfma_f32_16x16x32_bf16(__builtin_bit_cast(bf16x8v, S.fa0), hb0, z, 0, 0, 0);
    Y = __builtin_amdgcn_mfma_f32_16x16x32_bf16(__builtin_bit_cast(bf16x8v, S.fa1), hb1, Y, 0, 0, 0);
    Y = __builtin_amdgcn_mfma_f32_16x16x32_bf16(__builtin_bit_cast(bf16x8v, S.fn), rw_bc(0u, 0u, S.vt.x, S.vt.y), Y, 0, 0, 0);
    const f32x4 U = __builtin_amdgcn_mfma_f32_16x16x32_bf16(__builtin_bit_cast(bf16x8v, S.fx), rw_bc(cvt_pk_bf16(Y[0], Y[1]), cvt_pk_bf16(Y[2], Y[3]), 0u, 0u), z, 0, 0, 0);
    const bf16x8v ub = rw_bc(cvt_pk_bf16(U[0], U[1]), cvt_pk_bf16(U[2], U[3]), S.vt.x, S.vt.y);
    f32x4 O = __builtin_amdgcn_mfma_f32_16x16x32_bf16(__builtin_bit_cast(bf16x8v, S.fr0), hb0, z, 0, 0, 0);
    O = __builtin_amdgcn_mfma_f32_16x16x32_bf16(__builtin_bit_cast(bf16x8v, S.fr1), hb1, O, 0, 0, 0);
    O = __builtin_amdgcn_mfma_f32_16x16x32_bf16(__builtin_bit_cast(bf16x8v, S.fm), ub, O, 0, 0, 0);
    H[0] = __builtin_amdgcn_mfma_f32_16x16x32_bf16(__builtin_bit_cast(bf16x8v, S.fs0), ub, H[0] * S.g0, 0, 0, 0);
    H[1] = __builtin_amdgcn_mfma_f32_16x16x32_bf16(__builtin_bit_cast(bf16x8v, S.fs1), ub, H[1] * S.g1, 0, 0, 0);
    H[2] = __builtin_amdgcn_mfma_f32_16x16x32_bf16(__builtin_bit_cast(bf16x8v, S.fs2), ub, H[2] * S.g2, 0, 0, 0);
    H[3] = __builtin_amdgcn_mfma_f32_16x16x32_bf16(__builtin_bit_cast(bf16x8v, S.fs3), ub, H[3] * S.g3, 0, 0, 0);
    ob[0] = O[0]; ob[2048] = O[1]; ob[4096] = O[2]; ob[6144] = O[3];
}
__device__ __forceinline__ void rwkv_chunk_scan(int lane, int ws, const unsigned char* arr1, const unsigned char* arr2, int bh, float* Sout, float* OB) {
    const int r16 = lane & 15, q = lane >> 4, b = bh >> 5, h = bh & 31;
    f32x4 H[4];
#pragma unroll
    for (int i = 0; i < 4; ++i) H[i] = (f32x4){0.f, 0.f, 0.f, 0.f};
    const size_t uc0 = (size_t)bh * RW_NCH;
    float* ob = OB + (size_t)(b * SEQ + 4 * q) * 2048 + h * 64 + 16 * ws + r16;
    RwSet A, B, C; rw_load(A, arr1, arr2, uc0, lane, ws); rw_load(B, arr1, arr2, uc0 + 1, lane, ws);
    static_assert(RW_NCH % 3 == 2, "loop below: groups of three chunks, then two");
    for (int c = 0; c < RW_NCH - 2; c += 3) {
        rw_load(C, arr1, arr2, uc0 + c + 2, lane, ws);
        rw_step(A, H, ob + (size_t)c * 16 * 2048);
        rw_load(A, arr1, arr2, uc0 + c + 3, lane, ws);
        rw_step(B, H, ob + (size_t)(c + 1) * 16 * 2048);
        rw_load(B, arr1, arr2, uc0 + c + 4, lane, ws);
        rw_step(C, H, ob + (size_t)(c + 2) * 16 * 2048);
    }
    rw_step(A, H, ob + (size_t)(RW_NCH - 2) * 16 * 2048);
    rw_step(B, H, ob + (size_t)(RW_NCH - 1) * 16 * 2048);
#pragma unroll
    for (int kt = 0; kt < 4; ++kt) *(f32x4*)(Sout + (16 * ws + r16) * 64 + 16 * kt + 4 * q) = H[kt];
}

__device__ __forceinline__ bf16x8v ldfrag(const bf16* p) { return *(const bf16x8v*)p; }
__device__ __forceinline__ void gla_prep_unit(Frame& F, const bf16* proj, const bf16* L1, const float* b_alpha, bf16* QD, bf16* KDDT, bf16* VT, bf16* ATT, float* EB, int ci, int h) {
    constexpr int LS = 264, VLS = 520;
    LAS bf16* qd_s = (LAS bf16*)F.lds; LAS bf16* kd_s = qd_s + 64 * LS; LAS bf16* kdd_s = kd_s + 64 * LS; LAS float* tot = (LAS float*)(kdd_s + 64 * LS);
    LAS bf16* v_s = (LAS bf16*)F.lds;
    int tid_ = F.tid; asm volatile("" : "+v"(tid_));
    const int tid = tid_, lane = tid & 63, w = F.wave, dg = tid & 31, ts = tid >> 5, m0 = (ci >> 5) * SEQ + (ci & 31) * 64, u = ci * 4 + h;
    v4u l1v[4], qv[4], kv[4], vv[8];
#pragma unroll
    for (int i = 0; i < 4; ++i) { const size_t m = (size_t)(m0 + 4 * ts + i); l1v[i] = *(const v4u*)(L1 + m * NL1 + h * 256 + 8 * dg);
        qv[i] = *(const v4u*)(proj + m * NPROJ + CQ + h * 256 + 8 * dg); kv[i] = *(const v4u*)(proj + m * NPROJ + CK + h * 256 + 8 * dg); }
    float ba[8]; { const f32x4 b0 = *(const f32x4*)(b_alpha + h * 256 + 8 * dg), b1 = *(const f32x4*)(b_alpha + h * 256 + 8 * dg + 4); ba[0] = b0.x; ba[1] = b0.y; ba[2] = b0.z; ba[3] = b0.w; ba[4] = b1.x; ba[5] = b1.y; ba[6] = b1.z; ba[7] = b1.w; }
    __syncthreads();
    float bt[4][8];
    { float run[8];
#pragma unroll
      for (int e = 0; e < 8; ++e) run[e] = 0.f;
#pragma unroll
      for (int i = 0; i < 4; ++i) { const unsigned xw[4] = {l1v[i].x, l1v[i].y, l1v[i].z, l1v[i].w};
#pragma unroll
          for (int e = 0; e < 8; ++e) { const float x = ((e & 1) ? bfhi(xw[e >> 1]) : bflo(xw[e >> 1])) + ba[e]; run[e] += -(fmaxf(-x, 0.f) + __logf(1.0f + __expf(-fabsf(x)))) * 0.0625f; bt[i][e] = run[e]; }
          __builtin_amdgcn_sched_barrier(0); }
      *(LAS f32x4*)(tot + ts * 256 + 8 * dg) = (f32x4){run[0], run[1], run[2], run[3]}; *(LAS f32x4*)(tot + ts * 256 + 8 * dg + 4) = (f32x4){run[4], run[5], run[6], run[7]}; }
    WG_BAR();
    float off[8], be[8];
#pragma unroll
    for (int e = 0; e < 8; ++e) { off[e] = 0.f; be[e] = 0.f; }
#pragma unroll
    for (int s = 0; s < 16; ++s) { const f32x4 a = *(const LAS f32x4*)(tot + s * 256 + 8 * dg), b = *(const LAS f32x4*)(tot + s * 256 + 8 * dg + 4); const float t8[8] = {a.x, a.y, a.z, a.w, b.x, b.y, b.z, b.w}; const bool pre = s < ts;
#pragma unroll
        for (int e = 0; e < 8; ++e) { be[e] += t8[e]; off[e] += pre ? t8[e] : 0.f; } }
    if (ts == 0) { *(f32x4*)(EB + (size_t)u * 256 + 8 * dg) = (f32x4){__expf(be[0]), __expf(be[1]), __expf(be[2]), __expf(be[3])}; *(f32x4*)(EB + (size_t)u * 256 + 8 * dg + 4) = (f32x4){__expf(be[4]), __expf(be[5]), __expf(be[6]), __expf(be[7])}; }
#pragma unroll
    for (int i = 0; i < 4; ++i) { const int t = 4 * ts + i; const unsigned qw[4] = {qv[i].x, qv[i].y, qv[i].z, qv[i].w}, kw[4] = {kv[i].x, kv[i].y, kv[i].z, kv[i].w};
        float qd[8], kd[8], kdd[8];
#pragma unroll
        for (int e = 0; e < 8; ++e) { const float b = bt[i][e] + off[e], q = (e & 1) ? bfhi(qw[e >> 1]) : bflo(qw[e >> 1]), k = (e & 1) ? bfhi(kw[e >> 1]) : bflo(kw[e >> 1]);
            qd[e] = q * 0.0625f * __expf(b); kd[e] = k * __expf(-b); kdd[e] = k * __expf(be[e] - b); }
        v4u oq, ok, okk; oq.x = pk2(qd[0], qd[1]); oq.y = pk2(qd[2], qd[3]); oq.z = pk2(qd[4], qd[5]); oq.w = pk2(qd[6], qd[7]);
        ok.x = pk2(kd[0], kd[1]); ok.y = pk2(kd[2], kd[3]); ok.z = pk2(kd[4], kd[5]); ok.w = pk2(kd[6], kd[7]);
        okk.x = pk2(kdd[0], kdd[1]); okk.y = pk2(kdd[2], kdd[3]); okk.z = pk2(kdd[4], kdd[5]); okk.w = pk2(kdd[6], kdd[7]);
        *(v4u*)(QD + (size_t)(m0 + t) * 1024 + h * 256 + 8 * dg) = oq;
        *(LAS v4u*)(qd_s + t * LS + 8 * dg) = oq; *(LAS v4u*)(kd_s + t * LS + 8 * dg) = ok; *(LAS v4u*)(kdd_s + t * LS + 8 * dg) = okk;
        __builtin_amdgcn_sched_barrier(0); }
    WG_BAR();
#pragma unroll
    for (int i = 0; i < 8; ++i) { const int p = tid + 512 * i; vv[i] = *(const v4u*)(proj + (size_t)(m0 + (p >> 6)) * NPROJ + CV + h * 512 + 8 * (p & 63)); }
    {
        const int d = tid & 255, half = tid >> 8; unsigned kp[16];
#pragma unroll
        for (int i = 0; i < 32; ++i) { const unsigned x = kdd_s[(32 * half + i) * LS + d]; if (i & 1) kp[i >> 1] |= x << 16; else kp[i >> 1] = x; }
        v4u* kd4 = (v4u*)(KDDT + ((size_t)u * 256 + d) * 64 + 32 * half);
#pragma unroll
        for (int i = 0; i < 4; ++i) { v4u o; o.x = kp[4 * i]; o.y = kp[4 * i + 1]; o.z = kp[4 * i + 2]; o.w = kp[4 * i + 3]; kd4[i] = o; } }
    {
        const int tt = w >> 1, r = lane & 15, q = lane >> 4;
#pragma unroll
        for (int si = 0; si < 2; ++si) { const int st = 2 * (w & 1) + si; f32x4 acc = {0.f, 0.f, 0.f, 0.f};
            if (st <= tt) {
#pragma unroll
                for (int ks = 0; ks < 8; ++ks) { const bf16x8v a = *(const LAS bf16x8v*)(kd_s + (16 * st + r) * LS + ks * 32 + 8 * q), b = *(const LAS bf16x8v*)(qd_s + (16 * tt + r) * LS + ks * 32 + 8 * q);
                    acc = __builtin_amdgcn_mfma_f32_16x16x32_bf16(a, b, acc, 0, 0, 0); }
            }
            const int t = 16 * tt + r, s0 = 16 * st + 4 * q; v2u o;
            o.x = pk2(t >= s0 ? acc[0] : 0.f, t >= s0 + 1 ? acc[1] : 0.f); o.y = pk2(t >= s0 + 2 ? acc[2] : 0.f, t >= s0 + 3 ? acc[3] : 0.f);
            *(v2u*)(ATT + ((size_t)u * 64 + t) * 64 + s0) = o; }
    }
    WG_BAR();
#pragma unroll
    for (int i = 0; i < 8; ++i) { const int p = tid + 512 * i; *(LAS v4u*)(v_s + (p >> 6) * VLS + 8 * (p & 63)) = vv[i]; }
    WG_BAR();
    {
        unsigned vp[32];
#pragma unroll
        for (int t = 0; t < 64; ++t) { const unsigned x = v_s[t * VLS + tid]; if (t & 1) vp[t >> 1] |= x << 16; else vp[t >> 1] = x; }
        v4u* v4 = (v4u*)(VT + ((size_t)u * 512 + tid) * 64);
#pragma unroll
        for (int i = 0; i < 8; ++i) { v4u o; o.x = vp[4 * i]; o.y = vp[4 * i + 1]; o.z = vp[4 * i + 2]; o.w = vp[4 * i + 3]; v4[i] = o; }
    }
}
__device__ __forceinline__ void gla_prompt_unit(Frame& F, const bf16* QD, const bf16* KDDT, const bf16* VT, const bf16* ATT, const float* EB, float* OA, float* gla_p, int b, int h, int vs) {
    constexpr int LS = 264, PS = 72;
    constexpr int O_QD = 64 * LS * 2, O_KD = O_QD + 64 * LS * 2, O_VT = O_KD + 256 * PS * 2, O_AT = O_VT + 64 * PS * 2, O_EB = O_AT + 64 * PS * 2, O_DUM = O_EB + 1024;
    LAS unsigned char* L = F.lds; LAS bf16* ST = (LAS bf16*)L;
    const int tid = F.tid, lane = F.lane, w = F.wave, r = lane & 15, q = lane >> 4, tt = w >> 1, vt0 = 2 * (w & 1);
    f32x4 Sacc[2][4];
#pragma unroll
    for (int a = 0; a < 2; ++a)
#pragma unroll
        for (int c = 0; c < 4; ++c) Sacc[a][c] = (f32x4){0.f, 0.f, 0.f, 0.f};
    const int gq = ((tid >> 5) * 1024 + (tid & 31) * 8) * 2, lq = O_QD + (tid >> 5) * (LS * 2) + (tid & 31) * 16;
    const int gk = ((tid >> 3) * 64 + (tid & 7) * 8) * 2, lk = (tid >> 3) * (PS * 2) + (tid & 7) * 16;
    const bool ebok = tid < 64; const int ge = ebok ? tid * 16 : 0, le = ebok ? O_EB + tid * 16 : O_DUM;
    const unsigned char* pQD = (const unsigned char*)(QD + (size_t)(b * SEQ) * 1024 + h * 256); const size_t sQD = (size_t)64 * 1024 * 2;
    const size_t u0 = (size_t)(b * 32) * 4 + h;
    const unsigned char* pKD = (const unsigned char*)(KDDT + u0 * 256 * 64); const size_t sKD = (size_t)4 * 256 * 64 * 2;
    const unsigned char* pVT = (const unsigned char*)(VT + (u0 * 512 + vs * 64) * 64); const size_t sVT = (size_t)4 * 512 * 64 * 2;
    const unsigned char* pAT = (const unsigned char*)(ATT + u0 * 64 * 64); const size_t sAT = (size_t)4 * 64 * 64 * 2;
    const unsigned char* pEB = (const unsigned char*)(EB + u0 * 256); const size_t sEB = (size_t)4 * 256 * 4;
#define GP_LOAD(P, cc) do { const size_t c_ = (size_t)((cc) < 32 ? (cc) : 31); \
        _Pragma("unroll") for (int i = 0; i < 4; ++i) P[i] = *(const v4u*)(pQD + c_ * sQD + gq + i * (16 * 1024 * 2)); \
        _Pragma("unroll") for (int i = 0; i < 4; ++i) P[4 + i] = *(const v4u*)(pKD + c_ * sKD + gk + i * (64 * 64 * 2)); \
        P[8] = *(const v4u*)(pVT + c_ * sVT + gk); P[9] = *(const v4u*)(pAT + c_ * sAT + gk); P[10] = *(const v4u*)(pEB + c_ * sEB + ge); } while (0)
#define GP_STAGE(P) do { _Pragma("unroll") for (int i = 0; i < 11; ++i) asm volatile("" : "+v"(P[i])); \
        _Pragma("unroll") for (int i = 0; i < 4; ++i) *(LAS v4u*)(L + lq + i * (16 * LS * 2)) = P[i]; \
        _Pragma("unroll") for (int i = 0; i < 4; ++i) *(LAS v4u*)(L + O_KD + lk + i * (64 * PS * 2)) = P[4 + i]; \
        *(LAS v4u*)(L + O_VT + lk) = P[8]; *(LAS v4u*)(L + O_AT + lk) = P[9]; *(LAS v4u*)(L + le) = P[10]; } while (0)
    v4u PA[11];
    GP_LOAD(PA, 0);
    __syncthreads();
    for (int i = tid; i < 64 * LS / 2; i += NT) ((LAS unsigned*)ST)[i] = 0u;
    GP_STAGE(PA);
    WG_BAR();
    const LAS bf16* QDs = (const LAS bf16*)(L + O_QD); const LAS bf16* KDs = (const LAS bf16*)(L + O_KD); const LAS bf16* VTs = (const LAS bf16*)(L + O_VT); const LAS bf16* ATs = (const LAS bf16*)(L + O_AT);
    const LAS float* EBs = (const LAS float*)(L + O_EB);
    for (int c = 0; c < 32; ++c) {
        GP_LOAD(PA, c + 1);
        const int m0 = b * SEQ + c * 64;
        bf16x8v Bv[4][2], Akd[2][2]; f32x4 ebv[2];
#pragma unroll
        for (int vt = 0; vt < 4; ++vt)
#pragma unroll
            for (int ks = 0; ks < 2; ++ks) Bv[vt][ks] = *(const LAS bf16x8v*)(VTs + (16 * vt + r) * PS + ks * 32 + 8 * q);
#pragma unroll
        for (int dt = 0; dt < 2; ++dt) {
#pragma unroll
            for (int ks = 0; ks < 2; ++ks) Akd[dt][ks] = *(const LAS bf16x8v*)(KDs + (32 * w + 16 * dt + r) * PS + ks * 32 + 8 * q);
            ebv[dt] = *(const LAS f32x4*)(EBs + 32 * w + 16 * dt + 4 * q); }
        bf16x8v Aatt[2], Bo[2][2];
#pragma unroll
        for (int ks = 0; ks < 2; ++ks) { Aatt[ks] = *(const LAS bf16x8v*)(ATs + (16 * tt + r) * PS + ks * 32 + 8 * q);
#pragma unroll
            for (int vi = 0; vi < 2; ++vi) Bo[vi][ks] = *(const LAS bf16x8v*)(VTs + (16 * (vt0 + vi) + r) * PS + ks * 32 + 8 * q); }
        f32x4 oacc[2];
#pragma unroll
        for (int vi = 0; vi < 2; ++vi) { const int vt = vt0 + vi; f32x4 acc = {0.f, 0.f, 0.f, 0.f};
#pragma unroll
            for (int ks = 0; ks < 2; ++ks) acc = __builtin_amdgcn_mfma_f32_16x16x32_bf16(Bo[vi][ks], Aatt[ks], acc, 0, 0, 0);
#pragma unroll
            for (int ks = 0; ks < 8; ++ks) { const bf16x8v sfr = *(const LAS bf16x8v*)(ST + (16 * vt + r) * LS + ks * 32 + 8 * q), aq = *(const LAS bf16x8v*)(QDs + (16 * tt + r) * LS + ks * 32 + 8 * q);
                acc = __builtin_amdgcn_mfma_f32_16x16x32_bf16(sfr, aq, acc, 0, 0, 0); }
            oacc[vi] = acc; }
#pragma unroll
        for (int vi = 0; vi < 2; ++vi) *(f32x4*)(OA + (size_t)(m0 + 16 * tt + r) * 2048 + h * 512 + vs * 64 + 16 * (vt0 + vi) + 4 * q) = oacc[vi];
        WG_BAR();
#pragma unroll
        for (int dt = 0; dt < 2; ++dt)
#pragma unroll
            for (int vt = 0; vt < 4; ++vt) { f32x4 a = Sacc[dt][vt] * ebv[dt];
#pragma unroll
                for (int ks = 0; ks < 2; ++ks) a = __builtin_amdgcn_mfma_f32_16x16x32_bf16(Akd[dt][ks], Bv[vt][ks], a, 0, 0, 0);
                Sacc[dt][vt] = a; v2u o; o.x = pk2(a[0], a[1]); o.y = pk2(a[2], a[3]);
                *(LAS v2u*)(ST + (16 * vt + r) * LS + 32 * w + 16 * dt + 4 * q) = o; }
        GP_STAGE(PA);
        WG_BAR();
    }
#undef GP_LOAD
#undef GP_STAGE
#pragma unroll
    for (int dt = 0; dt < 2; ++dt)
#pragma unroll
        for (int vt = 0; vt < 4; ++vt)
#pragma unroll
            for (int j = 0; j < 4; ++j) gla_p[((size_t)(b * 4 + h) * 256 + 32 * w + 16 * dt + 4 * q + j) * 512 + vs * 64 + 16 * vt + r] = Sacc[dt][vt][j];
}

__device__ __forceinline__ void gla_sample_unit(Frame& F, const bf16* proj, const float* LA, float* OA, const float* S0g, float* Sog, int b, int h) {
    LAS float* qdT = (LAS float*)F.lds; LAS float* kddT = qdT + 2048; LAS float* kd = kddT + 2048; LAS float* eb = kd + 2048; LAS float* att = eb + 256; LAS float* ored = att + 64;
    const int tid = F.tid, lane = F.lane, w = F.wave, m0 = TP + b * DSEQ;
    const int vq = tid & 127, dg = tid >> 7, v0 = 4 * vq;
    const float* S0 = S0g + ((size_t)(b * 4 + h) * 256 + 64 * dg) * 512 + v0; float* So = Sog + ((size_t)(b * 4 + h) * 256 + 64 * dg) * 512 + v0;
    v2u vraw[8]; f32x4 s0[8], s1[8];
#pragma unroll
    for (int t = 0; t < 8; ++t) vraw[t] = *(const v2u*)(proj + (size_t)(m0 + t) * NPROJ + CV + h * 512 + v0);
#pragma unroll
    for (int i = 0; i < 8; ++i) s0[i] = *(const f32x4*)(S0 + (size_t)i * 512);
    WG_BAR();
    if (tid < 256) { const int d = tid; float bt[8]; float bc = 0.f;
#pragma unroll
        for (int t = 0; t < 8; ++t) { bc += LA[(size_t)(m0 + t) * 1024 + h * 256 + d]; bt[t] = bc; }
#pragma unroll
        for (int t = 0; t < 8; ++t) { const bf16* pr = proj + (size_t)(m0 + t) * NPROJ + h * 256 + d; const float q = bf2f(pr[CQ]) * 0.0625f, k = bf2f(pr[CK]);
            qdT[d * 8 + t] = q * __expf(bt[t]); kd[t * 256 + d] = k * __expf(-bt[t]); kddT[d * 8 + t] = k * __expf(bc - bt[t]); }
        eb[d] = __expf(bc); }
    WG_BAR();
    {
#pragma unroll
        for (int s = 0; s < 8; ++s) { float p = 0.f;
#pragma unroll
            for (int i = 0; i < 4; ++i) { const int d = lane + 64 * i; p += qdT[d * 8 + w] * kd[s * 256 + d]; }
            p = wave_sum(p); if (lane == 0) att[w * 8 + s] = (s <= w) ? p : 0.f; }
    }
    WG_BAR();
    f32x4 vv[8], o[8];
#pragma unroll
    for (int t = 0; t < 8; ++t) { const v2u x = vraw[t]; vv[t] = (f32x4){bflo(x.x), bfhi(x.x), bflo(x.y), bfhi(x.y)}; }
#pragma unroll
    for (int t = 0; t < 8; ++t) { f32x4 s = {0.f, 0.f, 0.f, 0.f};
        if (dg == 0) {
#pragma unroll
            for (int uu = 0; uu < 8; ++uu) s += att[t * 8 + uu] * vv[uu]; }
        o[t] = s; }
#pragma unroll 1
    for (int db = 0; db < 64; db += 8) {
        { const int dn = db + 8 < 64 ? db + 8 : db;
#pragma unroll
          for (int i = 0; i < 8; ++i) s1[i] = *(const f32x4*)(S0 + (size_t)(dn + i) * 512); }
#pragma unroll
        for (int i = 0; i < 8; ++i) { const int d = 64 * dg + db + i;
            const f32x4 q0 = *(const LAS f32x4*)(qdT + d * 8), q1 = *(const LAS f32x4*)(qdT + d * 8 + 4), k0 = *(const LAS f32x4*)(kddT + d * 8), k1 = *(const LAS f32x4*)(kddT + d * 8 + 4);
            o[0] += q0.x * s0[i]; o[1] += q0.y * s0[i]; o[2] += q0.z * s0[i]; o[3] += q0.w * s0[i]; o[4] += q1.x * s0[i]; o[5] += q1.y * s0[i]; o[6] += q1.z * s0[i]; o[7] += q1.w * s0[i];
            f32x4 sn = s0[i] * eb[d];
            sn += k0.x * vv[0]; sn += k0.y * vv[1]; sn += k0.z * vv[2]; sn += k0.w * vv[3]; sn += k1.x * vv[4]; sn += k1.y * vv[5]; sn += k1.z * vv[6]; sn += k1.w * vv[7];
            *(f32x4*)(So + (size_t)(db + i) * 512) = sn; }
#pragma unroll
        for (int i = 0; i < 8; ++i) s0[i] = s1[i];
    }
#pragma unroll
    for (int t = 0; t < 8; ++t) *(LAS f32x4*)(ored + (dg * 8 + t) * 512 + v0) = o[t];
    WG_BAR();
#pragma unroll
    for (int i = 0; i < 2; ++i) { const int idx = tid + 512 * i, t = idx >> 7, v4 = (idx & 127) * 4;
        const f32x4 s = (*(const LAS f32x4*)(ored + (0 * 8 + t) * 512 + v4) + *(const LAS f32x4*)(ored + (1 * 8 + t) * 512 + v4)) + (*(const LAS f32x4*)(ored + (2 * 8 + t) * 512 + v4) + *(const LAS f32x4*)(ored + (3 * 8 + t) * 512 + v4));
        *(f32x4*)(OA + (size_t)(m0 + t) * 2048 + h * 512 + v4) = s; }
}

__device__ __forceinline__ float sum16(float x) {
    x += dpp_f(x, 0); x += dpp_f(x, 1); x += dpp_f(x, 2);
    const int v = __builtin_bit_cast(int, x); x += __builtin_bit_cast(float, __builtin_amdgcn_update_dpp(v, v, 0x140, 0xF, 0xF, false));
    return x;
}
__device__ __forceinline__ f32x4 bf4(v2u w) { return (f32x4){bflo(w.x), bfhi(w.x), bflo(w.y), bfhi(w.y)}; }
struct P4In { v2u r, k, v, rp, kp, vp; f32x4 l1d, l1i, la; };
__device__ __forceinline__ P4In p4_load(const bf16* PROJ, const bf16* L1, int it, int lane) {
    const int m = it >> 3, hq = it & 7, c0 = hq * 256 + 4 * lane; const SeqPos sp = seqpos(m); const bf16* pr = PROJ + (size_t)m * NPROJ + c0;
    P4In x; x.r = *(const v2u*)(pr + CR); x.k = *(const v2u*)(pr + CKR); x.v = *(const v2u*)(pr + CVR);
    const bf16* pq = sp.t > 0 ? pr - NPROJ : pr;
    x.rp = *(const v2u*)(pq + CR); x.kp = *(const v2u*)(pq + CKR); x.vp = *(const v2u*)(pq + CVR);
    const bf16* l = L1 + (size_t)m * NL1 + c0; x.l1d = bf4(*(const v2u*)(l + 1024)); x.l1i = bf4(*(const v2u*)(l + 3072)); x.la = bf4(*(const v2u*)(l));
    return x;
}
struct P4Par { f32x4 mur, muk, muv, a0, w0, kk, ka, rk, ba; };
__device__ __forceinline__ void p4_compute(const P4In& x, const P4Par& P, const float* sshift, unsigned char* SCAN, float* BONUS, float* LA, int it, int lane) {
    const int m = it >> 3, hq = it & 7, c0 = hq * 256 + 4 * lane, h = 4 * hq + (lane >> 4), cl = lane & 15; const SeqPos sp = seqpos(m);
    f32x4 rp = bf4(x.rp), kp = bf4(x.kp), vp = bf4(x.vp);
    if (sp.t == 0) { if (sp.prm) { rp = (f32x4){0.f, 0.f, 0.f, 0.f}; kp = rp; vp = rp; }
        else { const float* sh = sshift + (size_t)sp.b * ZRC + c0; rp = *(const f32x4*)sh; kp = *(const f32x4*)(sh + 2144); vp = *(const f32x4*)(sh + 4192); } }
    const f32x4 z0 = bf4(x.r), z1 = bf4(x.k), z2 = bf4(x.v);
    const f32x4 r = z0 + (rp - z0) * P.mur, ksh = z1 + (kp - z1) * P.muk, vsh = z2 + (vp - z2) * P.muv;
    f32x4 a, dec, kk, k2; float ss = 0.f, bs = 0.f;
#pragma unroll
    for (int e = 0; e < 4; ++e) { a[e] = sigmoidf_(P.a0[e] + x.l1i[e]); const float wl = -softplusf_(-(P.w0[e] + x.l1d[e])) - 0.5f; dec[e] = __expf(-__expf(wl));
        kk[e] = ksh[e] * P.kk[e]; ss += kk[e] * kk[e]; k2[e] = ksh[e] * (1.0f + (a[e] - 1.0f) * P.ka[e]); bs += r[e] * k2[e] * P.rk[e]; }
    const float inv = 1.0f / fmaxf(sqrtf(sum16(ss)), 1e-12f); bs = sum16(bs);
    kk = kk * inv;
    unsigned char* rb = SCAN + ((size_t)m * 32 + h) * SCAN_REC; const f32x4 nk = -kk, ka = kk * a;
    *(f32x4*)(rb + 16 * cl) = dec;
    v2u t; t.x = pk2(r[0], r[1]); t.y = pk2(r[2], r[3]); *(v2u*)(rb + 256 + 8 * cl) = t;
    t.x = pk2(k2[0], k2[1]); t.y = pk2(k2[2], k2[3]); *(v2u*)(rb + 384 + 8 * cl) = t;
    t.x = pk2(nk[0], nk[1]); t.y = pk2(nk[2], nk[3]); *(v2u*)(rb + 512 + 8 * cl) = t;
    t.x = pk2(ka[0], ka[1]); t.y = pk2(ka[2], ka[3]); *(v2u*)(rb + 640 + 8 * cl) = t;
    t.x = pk2(vsh[0], vsh[1]); t.y = pk2(vsh[2], vsh[3]); *(v2u*)(rb + 768 + 8 * cl) = t;
    if (cl == 0) BONUS[m * 32 + h] = bs;
    if (hq < 4) { f32x4 la;
#pragma unroll
        for (int e = 0; e < 4; ++e) la[e] = -softplusf_(-(x.la[e] + P.ba[e])) * 0.0625f;
        *(f32x4*)(LA + (size_t)m * 1024 + c0) = la; }
}
struct P6In { f32x4 ob; v2u v, g; float bonus; };
__device__ __forceinline__ P6In p6_load(const float* OB, const unsigned char* SCAN, const float* BONUS, const bf16* Gb, int it, int lane) {
    const int m = it >> 3, hq = it & 7, c0 = hq * 256 + 4 * lane, h = 4 * hq + (lane >> 4), cl = lane & 15;
    P6In x; x.ob = *(const f32x4*)(OB + (size_t)m * 2048 + c0); x.v = *(const v2u*)(SCAN + ((size_t)m * 32 + h) * SCAN_REC + 768 + 8 * cl); x.g = *(const v2u*)(Gb + (size_t)m * 2048 + c0); x.bonus = BONUS[m * 32 + h];
    return x;
}
__device__ __forceinline__ void p6_compute(const P6In& x, f32x4 lnw, f32x4 lnb, bf16* OBP, int it, int lane) {
    const int m = it >> 3, hq = it & 7, c0 = hq * 256 + 4 * lane;
    const float mean = sum16((x.ob[0] + x.ob[1]) + (x.ob[2] + x.ob[3])) * (1.f / 64.f); const f32x4 dv = x.ob - mean;
    const float var = sum16((dv[0] * dv[0] + dv[1] * dv[1]) + (dv[2] * dv[2] + dv[3] * dv[3])) * (1.f / 64.f); const float rs = __builtin_amdgcn_rsqf(var + 64e-5f);
    const f32x4 y = (dv * rs * lnw + lnb + x.bonus * bf4(x.v)) * bf4(x.g);
    v2u o; o.x = pk2(y[0], y[1]); o.y = pk2(y[2], y[3]); *(v2u*)(OBP + (size_t)m * 2048 + c0) = o;
}

constexpr int LI1 = 64 * (NUP / 32), LI2 = (DFF / 64) * (D / 32), LI3 = 64 * 128, LI4 = 64 * 128, LI5 = 32 * 128, LI6 = 32 * 128, LI7 = 4 * 128;
constexpr int NLATE = LI1 + LI2 + LI3 + LI4 + LI5 + LI6 + LI7, NLATE_CHUNKS = NLATE / 64;
static_assert(NLATE % 64 == 0, "late items come in chunks of 64");
__device__ __forceinline__ TrDesc late_desc(KArgs& args, unsigned char* ws, int it) {
    int r = it;
    if (r < LI1) return TrDesc{args.in[I_WUP], (bf16*)(ws + WS_WT_UP), D, NUP, NUP / 32, r, false}; r -= LI1;
    if (r < LI2) return TrDesc{args.in[I_WDOWN], (bf16*)(ws + WS_WT_DOWN), DFF, D, D / 32, r, false}; r -= LI2;
    if (r < LI3) return TrDesc{args.in[I_WOUT], (bf16*)(ws + WS_WT_OUT), D, D, D / 32, r, false}; r -= LI3;
    if (r < LI4) return TrDesc{args.in[I_WPEG], (bf16*)(ws + WS_WT_PEG), D, D, D / 32, r, false}; r -= LI4;
    if (r < LI5) return TrDesc{args.in[I_WBRA], (bf16*)(ws + WS_WT_BRA), 2048, D, D / 32, r, false}; r -= LI5;
    if (r < LI6) return TrDesc{args.in[I_WBRB], (bf16*)(ws + WS_WT_BRB), 2048, D, D / 32, r, false}; r -= LI6;
    return TrDesc{args.in[I_WPE], (bf16*)(ws + WS_WT_PE), 256, D, D / 32, r, false};
}

__device__ __forceinline__ void late_chunk(Frame& F, KArgs& args, unsigned char* ws, int chunk) {
    LAS float* scr = (LAS float*)(F.lds + F.wave * 16384); const int base = chunk * 64 + F.wave * 8;
    float ta[32], tb[32];
    TrDesc da = late_desc(args, ws, base), db = da;
    tr_load(da, ta, F.lane);
#pragma unroll 1
    for (int i = 0; i < 8; i += 2) {
        db = late_desc(args, ws, base + i + 1); tr_load(db, tb, F.lane);
        tr_finish(da, ta, scr, F.lane);
        if (i + 2 < 8) { da = late_desc(args, ws, base + i + 2); tr_load(da, ta, F.lane); }
        tr_finish(db, tb, scr, F.lane);
    }
}
constexpr int TAILB = 192, NTB = 3, NT1 = 2, TAIL1 = NT1 * 120, PEG0 = 1160, PEG1 = 1288;
static_assert(NTB * TAILB + TAIL1 <= 1032, "tail chunks are w_up / w_down chunks (first needed after the branch GEMM)");
static_assert(NLATE_CHUNKS == 1424 && LI1 / 64 == 688 && (LI1 + LI2 + LI3) / 64 == PEG0 && (LI1 + LI2 + LI3 + LI4) / 64 == PEG1, "chunk map");

constexpr int N_PHASES = 15;
#ifndef REP0
#define REP0 1
#endif
#ifndef REP1
#define REP1 1
#endif
#ifndef REP5
#define REP5 1
#endif
#ifndef REP10
#define REP10 1
#endif
#ifndef REP12
#define REP12 1
#endif
__global__ void __launch_bounds__(NT, 2) fwd_kernel(Args args_unused) {
    extern __shared__ __attribute__((aligned(16))) unsigned char lds_[];
    KArgs& args = *(KArgs*)__builtin_amdgcn_kernarg_segment_ptr();
    Frame F;
    F.lds = (LAS unsigned char*)lds_;
    F.tid = threadIdx.x; F.lane = F.tid & 63; F.wave = __builtin_amdgcn_readfirstlane(F.tid >> 6);
    F.G = gridDim.x; { const int bx = blockIdx.x; F.vcu = (F.G % 8 == 0) ? (bx % 8) * (F.G / 8) + bx / 8 : bx; }
    F.gw = F.vcu * NWAVES + F.wave; F.NGW = F.G * NWAVES;
    unsigned char* ws = args.ws; float* out = args.out;
    unsigned* ctl = (unsigned*)(ws + WS_CTL);
    volatile LAS unsigned* MISC = (volatile LAS unsigned*)(F.lds + MISC_OFF);
    for (int u = F.tid; u < (LDS_BYTES - RING_BYTES) / 4; u += NT) ((LAS unsigned*)(F.lds + RING_BYTES))[u] = 0u;
    __syncthreads();
#if MK_ONE_LAUNCH
    XcdBarrier bar = xcd_barrier_post(ctl + CW_BAR, MISC + 8);
#define GRID_BAR() xcd_barrier(bar)
#else
#define GRID_BAR() do { } while (0)
#endif
    const int lo = args.ph_lo, hi = args.ph_hi;
#define IN(k) (lo <= (k) && (k) < hi)
#define SEAM(k) do { if (IN(k) && IN((k) + 1)) GRID_BAR(); } while (0)

    bf16* WT_IN = (bf16*)(ws + WS_WT_IN); bf16* WT_UP = (bf16*)(ws + WS_WT_UP); bf16* WT_DOWN = (bf16*)(ws + WS_WT_DOWN); bf16* WT_OUT = (bf16*)(ws + WS_WT_OUT);
    bf16* WT_PEG = (bf16*)(ws + WS_WT_PEG); bf16* WT_BRA = (bf16*)(ws + WS_WT_BRA); bf16* WT_BRB = (bf16*)(ws + WS_WT_BRB); bf16* WT_PE = (bf16*)(ws + WS_WT_PE);
    bf16* WL1 = (bf16*)(ws + WS_WL1); bf16* WG = (bf16*)(ws + WS_WG);
    bf16* H = (bf16*)(ws + WS_H); bf16* PROJ = (bf16*)(ws + WS_PROJ); bf16* UP = (bf16*)(ws + WS_PROJ);
    unsigned char* SCAN = ws + WS_SCAN; bf16* ACT = (bf16*)(ws + WS_SCAN); float* TMP = (float*)(ws + WS_SCAN);
    bf16* Gb = (bf16*)(ws + WS_G); float* LA = (float*)(ws + WS_LA); bf16* AL1 = (bf16*)(ws + WS_AL1); bf16* AG = (bf16*)(ws + WS_AG); bf16* PB = (bf16*)(ws + WS_PB);
    float* BONUS = (float*)(ws + WS_BONUS); bf16* PPb = (bf16*)(ws + WS_PP);
    bf16* QDg = (bf16*)(ws + WS_QD); bf16* KDDTg = (bf16*)(ws + WS_KDDT); bf16* VTg = (bf16*)(ws + WS_VT); bf16* ATTg = (bf16*)(ws + WS_ATT); float* EBg = (float*)(ws + WS_EB);
    float* MO = (float*)(ws + WS_PROJ); float* FF = (float*)(ws + WS_PROJ);
    float* MOS = (float*)(ws + WS_PROJ + 144 * MiB); float* FFS = (float*)(ws + WS_PROJ + 240 * MiB);
    bf16* L1 = (bf16*)(out + O_GLA_S);
    float* OA = out + O_Y; float* OB = out + O_Y + (size_t)T * 2048;
    bf16* OAP = H; bf16* OBP = H + (size_t)T * 2048;
    bf16* MIXED = (bf16*)(out + O_Y);
    float* Y = out + O_Y;

    if (IN(0)) {
        LAS float* scr = (LAS float*)(F.lds + F.wave * 16384);
        constexpr int I0 = 64 * (NPROJ / 32), I8 = 4 * 64;
#define P0_DESC(it_) ((it_) < I0 ? TrDesc{args.in[I_WIN], WT_IN, D, 20944, NPROJ / 32, (it_), true} : TrDesc{args.in[I_WGATE2], WG, 256, 2048, 2048 / 32, (it_) - I0, false})
        {   float ta[32], tb[32]; int it = F.gw;
            if (it < I0 + I8) { TrDesc da = P0_DESC(it), db = da; tr_load(da, ta, F.lane);
                for (; it < I0 + I8; it += 2 * F.NGW) {
                    const int i1 = it + F.NGW, i2 = it + 2 * F.NGW; const bool h1 = i1 < I0 + I8, h2 = i2 < I0 + I8;
                    if (h1) { db = P0_DESC(i1); tr_load(db, tb, F.lane); }
                    tr_finish(da, ta, scr, F.lane);
                    if (h2) { da = P0_DESC(i2); tr_load(da, ta, F.lane); }
                    if (h1) tr_finish(db, tb, scr, F.lane);
                } }
        }
#undef P0_DESC
        for (int e0 = F.vcu * NT + F.tid; e0 < NL1 * 256; e0 += 10 * F.G * NT) {
            float v[10];
#pragma unroll
            for (int j = 0; j < 10; ++j) { const int e = e0 + j * F.G * NT, k = e / NL1, n = e - k * NL1; const float* src = nullptr;
                if (e < NL1 * 256) {
                    if (n < 1024) { if (k < 16) src = args.in[I_WALPHA2] + k * 1024 + n; }
                    else if (n < 3072) { if (k >= 16 && k < 112) src = args.in[I_WDECAY2] + (k - 16) * 2048 + (n - 1024); }
                    else { if (k >= 112 && k < 208) src = args.in[I_WICLR2] + (k - 112) * 2048 + (n - 3072); } }
                v[j] = src ? *src : 0.f; }
#pragma unroll
            for (int j = 0; j < 10; ++j) { const int e = e0 + j * F.G * NT, k = e / NL1, n = e - k * NL1; if (e < NL1 * 256) WL1[n * 256 + k] = (bf16)f2bf(v[j]); }
        }
        for (int m = F.gw; m < T; m += F.NGW) {
            rms_row_bf16(xrow(args, m), args.in[I_GPREMIX], H + (size_t)m * D, F.lane);
            const float* pr = m < TP ? args.in[I_PP] + (size_t)m * 256 : args.in[I_PS] + (size_t)(m - TP) * 256;
            const f32x4 pv = *((const f32x4*)pr + F.lane); v2u w; w.x = pk2(pv.x, pv.y); w.y = pk2(pv.z, pv.w); *((v2u*)(PB + (size_t)m * 256) + F.lane) = w;
        }
    }
    SEAM(0);
    if (IN(1)) { run_gemm(F, H, WT_IN, T, NPROJ, D, FStoreBf16{PROJ, NPROJ});
        if (F.G == 256) { constexpr int rem = ((T / 256) * (NPROJ / 256)) % 256; const int c = (int)blockIdx.x;
            if (c >= rem) {
#pragma unroll 1
                for (int k = 0; k < NT1; ++k) late_chunk(F, args, ws, NTB * TAILB + k * 120 + c - rem); } }
    }
    SEAM(1);
    if (IN(2)) {
        const float* mu = args.in[I_MU];
        for (int m = F.gw; m < T; m += F.NGW) {
            const SeqPos sp = seqpos(m); const bf16* pr = PROJ + (size_t)m * NPROJ; const bf16* pp = pr - NPROJ;
            const float* sh = args.in[I_SSHIFT] + (size_t)sp.b * ZRC;
            for (int c = F.lane; c < 256; c += 64) {
                float val = 0.f;
                if (c < 16) val = bf2f(pr[CSM + c]);
                else if (c < 208) { const int oz = c < 112 ? 2048 + (c - 16) : 6240 + (c - 112); const float z = bf2f(pr[CSM + c]);
                    const float prev = sp.t > 0 ? bf2f(pp[CSM + c]) : (sp.prm ? 0.f : sh[oz]); const float zs = z + (prev - z) * mu[oz]; val = c < 112 ? 1.0f - 2.0f * __builtin_amdgcn_rcpf(1.0f + __builtin_amdgcn_exp2f(zs * 2.8853900817779268f)) : zs; }
                AL1[(size_t)m * 256 + c] = (bf16)f2bf(val);
                { const int oz = 6336 + c; const float z = bf2f(pr[CXG + c]); const float prev = sp.t > 0 ? bf2f(pp[CXG + c]) : (sp.prm ? 0.f : sh[oz]);
                  const float zs = z + (prev - z) * mu[oz]; AG[(size_t)m * 256 + c] = (bf16)f2bf(sigmoidf_(zs)); }
            }
            if (sp.t == sp.L - 1) { float* so = out + (sp.prm ? O_SHIFT_P : O_SHIFT_S) + (size_t)sp.b * ZRC;
                for (int oz = F.lane; oz < ZRC; oz += 64) so[oz] = bf2f(pr[zr_col(oz)]); }
        }
    }
    SEAM(2);
    if (IN(3)) {
        run_gemm(F, AL1, WL1, T, NL1, 256, FStoreBf16{L1, NL1});
        run_gemm(F, AG, WG, T, 2048, 256, FStoreBf16{Gb, 2048});
    }
    SEAM(3);
    if (IN(4)) {
        {
            const int hq = F.gw & 7, c0 = hq * 256 + 4 * F.lane; const float* mu = args.in[I_MU];
            P4Par P; P.mur = *(const f32x4*)(mu + c0); P.muk = *(const f32x4*)(mu + 2144 + c0); P.muv = *(const f32x4*)(mu + 4192 + c0);
            P.a0 = *(const f32x4*)(args.in[I_A0] + c0); P.w0 = *(const f32x4*)(args.in[I_W0] + c0); P.kk = *(const f32x4*)(args.in[I_KK] + c0); P.ka = *(const f32x4*)(args.in[I_KA] + c0);
            P.rk = *(const f32x4*)(args.in[I_RK] + c0); P.ba = *(const f32x4*)(args.in[I_BALPHA] + (c0 & 1023));
            if (F.G == 256) {
                const int g = F.vcu;
#pragma unroll 1
                for (int i = 0; i < 36; i += 2) { const int ma = i < 32 ? 32 * g + i : TP + 4 * g + (i - 32), ita = ma * 8 + hq, itb = ita + 8;
                    const P4In xa = p4_load(PROJ, L1, ita, F.lane), xb = p4_load(PROJ, L1, itb, F.lane);
                    p4_compute(xa, P, args.in[I_SSHIFT], SCAN, BONUS, LA, ita, F.lane);
                    p4_compute(xb, P, args.in[I_SSHIFT], SCAN, BONUS, LA, itb, F.lane); }
                asm volatile("s_waitcnt vmcnt(0)" ::: "memory");
                LAS unsigned char* wl = F.lds + F.wave * 16384;
#pragma unroll 1
                for (int k = 0; k < 8; ++k) { const int h = 4 * hq + (k & 3), mb = 32 * g + 16 * (k >> 2), b = mb >> 11, c = (mb & 2047) >> 4; const size_t uc = (size_t)(b * 32 + h) * RW_NCH + c;
                    rwkv_prep_unit(wl, F.lane, SCAN, mb, h, ws + WS_RW1 + uc * RW_A1, ws + WS_RW2 + uc * RW_A2); }
            } else
            for (int it = F.gw; it < T * 8; it += 2 * F.NGW) {
                const int it2 = it + F.NGW; const bool has2 = it2 < T * 8;
                const P4In xa = p4_load(PROJ, L1, it, F.lane), xb = p4_load(PROJ, L1, has2 ? it2 : it, F.lane);
                p4_compute(xa, P, args.in[I_SSHIFT], SCAN, BONUS, LA, it, F.lane);
                if (has2) p4_compute(xb, P, args.in[I_SSHIFT], SCAN, BONUS, LA, it2, F.lane);
            }
        }
        for (int uu = F.vcu; uu < 512; uu += F.G) gla_prep_unit(F, PROJ, L1, args.in[I_BALPHA], QDg, KDDTg, VTg, ATTg, EBg, uu >> 2, uu & 3);
    }
    SEAM(4);
    if (IN(5)) {
        const int g = F.vcu;
        if (g < 256) { const int u = g >> 1;
            if ((g & 1) == 0) {
                if (F.G == 256) { if ((g & 3) == 0) { const int bh = (g >> 2) * 2 + (F.wave >> 2);
                        rwkv_chunk_scan(F.lane, F.wave & 3, ws + WS_RW1, ws + WS_RW2, bh, out + O_RWKV_P + (size_t)bh * 4096, OB); } }
                else { const int b = u >> 5, h = u & 31; rwkv_unit<0>(F, SCAN, b * SEQ, SEQ, h, nullptr, out + O_RWKV_P + (size_t)(b * 32 + h) * 4096, OB); } }
            else { const int b = u >> 5, h = (u >> 3) & 3, vs = u & 7; gla_prompt_unit(F, QDg, KDDTg, VTg, ATTg, EBg, OA, out + O_GLA_P, b, h, vs); } }
        for (;;) {
            __syncthreads();
            if (F.tid == 0) MISC[0] = atomicAdd(ctl + CW_QUEUE, 1u);
            __syncthreads();
            const unsigned q = MISC[0];
            const bool tails = F.G == 256; const unsigned nq = tails ? (unsigned)(NLATE_CHUNKS - NTB * TAILB - TAIL1) : (unsigned)NLATE_CHUNKS;
            if (q >= 512u + nq + 1024u) break;
            if (q < 512u) { gla_sample_unit(F, PROJ, LA, OA, args.in[I_SGLA], out + O_GLA_S, (int)(q >> 2), (int)(q & 3)); }
            else if (q < 512u + nq) { int ch = (int)q - 512; if (tails) ch += NTB * TAILB + TAIL1;
                late_chunk(F, args, ws, ch); }
            else { const int u4 = (int)(q - 512u - nq), u = u4 * 4, b = u >> 5, h = u & 31;
                rwkv_unit<4>(F, SCAN, TP + b * DSEQ, DSEQ, h, args.in[I_SRWKV] + (size_t)u * 4096, out + O_RWKV_S + (size_t)u * 4096, OB); }
        }
    }
    SEAM(5);
    if (IN(6)) {
        {   const int hq = F.gw & 7, c0 = hq * 256 + 4 * F.lane;
            const f32x4 lnw = *(const f32x4*)(args.in[I_LNXW] + c0), lnb = *(const f32x4*)(args.in[I_LNXB] + c0);
            for (int it = F.gw; it < T * 8; it += 2 * F.NGW) {
                const int it2 = it + F.NGW; const bool has2 = it2 < T * 8;
                const P6In xa = p6_load(OB, SCAN, BONUS, Gb, it, F.lane), xb = p6_load(OB, SCAN, BONUS, Gb, has2 ? it2 : it, F.lane);
                p6_compute(xa, lnw, lnb, OBP, it, F.lane);
                if (has2) p6_compute(xb, lnw, lnb, OBP, it2, F.lane);
            }
        }
        for (int idx = F.gw; idx < T * 4; idx += F.NGW) {
            const int m = idx >> 2, h = idx & 3; const float* op = OA + (size_t)m * 2048 + h * 512 + F.lane * 8;
            const f32x4 o0 = *(const f32x4*)op, o1 = *(const f32x4*)(op + 4);
            const float ss = wave_sum((o0.x * o0.x + o0.y * o0.y) + (o0.z * o0.z + o0.w * o0.w) + (o1.x * o1.x + o1.y * o1.y) + (o1.z * o1.z + o1.w * o1.w));
            const float rs = __builtin_amdgcn_rsqf(ss * (1.f / 512.f) + 1e-6f);
            const f32x4 g0 = *(const f32x4*)(args.in[I_GLANORM] + F.lane * 8), g1 = *(const f32x4*)(args.in[I_GLANORM] + F.lane * 8 + 4);
            const v4u zg = *(const v4u*)(PROJ + (size_t)m * NPROJ + CZG + h * 512 + F.lane * 8);
            const float z[8] = {bflo(zg.x), bfhi(zg.x), bflo(zg.y), bfhi(zg.y), bflo(zg.z), bfhi(zg.z), bflo(zg.w), bfhi(zg.w)};
            const float o[8] = {o0.x * g0.x, o0.y * g0.y, o0.z * g0.z, o0.w * g0.w, o1.x * g1.x, o1.y * g1.y, o1.z * g1.z, o1.w * g1.w};
            float y[8];
#pragma unroll
            for (int i = 0; i < 8; ++i) y[i] = o[i] * rs * z[i] * sigmoidf_(z[i]);
            v4u w; w.x = pk2(y[0], y[1]); w.y = pk2(y[2], y[3]); w.z = pk2(y[4], y[5]); w.w = pk2(y[6], y[7]);
            *(v4u*)(OAP + (size_t)m * 2048 + h * 512 + F.lane * 8) = w;
        }
    }
    SEAM(6);
    if (IN(7)) {
        const int cblk = (int)blockIdx.x; const bool tails = F.G == 256;
        run_gemm_chain(F, OAP, WT_BRA, OBP, WT_BRB, T, D, 2048, FBranch{PROJ, MIXED});
        if (tails && cblk >= 64) {
#pragma unroll 1
            for (int k = 0; k < NTB; ++k) late_chunk(F, args, ws, k * TAILB + cblk - 64); }
    }
    SEAM(7);
    if (IN(8)) { run_gemm_split(F, MIXED, WT_OUT, T, D, D, FStoreF32Split{MO, D, MOS, TP, (size_t)TS * D, (bf16*)MO}); }
    SEAM(8);
    if (IN(9)) { for (int m = F.gw; m < T; m += F.NGW) sandwich_row(MO + (size_t)m * D, m < TP ? (const bf16*)MO + (size_t)m * D : nullptr, MOS + (size_t)(m - TP) * D, (size_t)TS * D, m >= TP ? 3 : 0, xrow(args, m), args.in[I_GPOSTMIX], Y + (size_t)m * D, args.in[I_GPREFFN], H + (size_t)m * D, F.lane); }
    SEAM(9);
    if (IN(10)) {
        if (F.G == 256) {
            constexpr int NUPT = (T / 256) * (NUP / 256), FULL = (NUPT / 256) * 256, NQ = (NUPT - FULL) * 4;
            run_gemm_lim(F, H, WT_UP, T, NUP, D, FStoreBf16{UP, NUP}, FULL);
            const int c = (int)blockIdx.x;
            if (c < NQ) { const int cq = (c & 7) * (NQ / 8) + (c >> 3); pg8::StaticOrder S; S.init(T, NUP, D, 256, 0); pg8::Unit u; S.tile(FULL + (cq >> 2), u);
                pg8::gemm_quarter(F.lds, H, WT_UP, D, 2 * u.pm + ((cq >> 1) & 1), 2 * u.pn + (cq & 1), FStoreBf16{UP, NUP}); }
            else run_gemm_gc(F, PB, WT_PE, T, D, 256, FStoreBf16{PPb, D}, 256 - NQ, c - NQ);
        } else { run_gemm(F, H, WT_UP, T, NUP, D, FStoreBf16{UP, NUP});
        { const int nup = (T / 256) * (NUP / 256), rem = nup % F.G; const int c = (int)blockIdx.x;
          if (rem == 0) run_gemm(F, PB, WT_PE, T, D, 256, FStoreBf16{PPb, D});
          else if (c >= rem) run_gemm_gc(F, PB, WT_PE, T, D, 256, FStoreBf16{PPb, D}, F.G - rem, c - rem); } }
    }
    SEAM(10);
    if (IN(11)) {
        const float* cw = args.in[I_CONVW]; const float* cb = args.in[I_CONVB];
        const int rpw = (T + F.G - 1) / F.G, mlo = F.vcu * rpw, mhi = (mlo + rpw < T) ? mlo + rpw : T;
        for (int jc = F.tid; jc < DFF / 8; jc += NT) {
            const int j = jc * 8;
            f32x4 cbv[2], c0v[2], c1v[2], c2v[2];
#pragma unroll
            for (int e = 0; e < 2; ++e) { cbv[e] = *(const f32x4*)(cb + j + 4 * e); c0v[e] = *(const f32x4*)(cw + j + 4 * e); c1v[e] = *(const f32x4*)(cw + DFF + j + 4 * e); c2v[e] = *(const f32x4*)(cw + 2 * DFF + j + 4 * e); }
            f32x4 h1[2] = {{0.f, 0.f, 0.f, 0.f}, {0.f, 0.f, 0.f, 0.f}}, h2[2] = {{0.f, 0.f, 0.f, 0.f}, {0.f, 0.f, 0.f, 0.f}};
            if (mlo >= 1 && mlo < mhi) { const v4u x = *(const v4u*)(UP + (size_t)(mlo - 1) * NUP + j); h1[0] = (f32x4){bflo(x.x), bfhi(x.x), bflo(x.y), bfhi(x.y)}; h1[1] = (f32x4){bflo(x.z), bfhi(x.z), bflo(x.w), bfhi(x.w)}; }
            if (mlo >= 2 && mlo < mhi) { const v4u x = *(const v4u*)(UP + (size_t)(mlo - 2) * NUP + j); h2[0] = (f32x4){bflo(x.x), bfhi(x.x), bflo(x.y), bfhi(x.y)}; h2[1] = (f32x4){bflo(x.z), bfhi(x.z), bflo(x.w), bfhi(x.w)}; }
            v4u g2[4], uv[4], g2n[4], uvn[4];
#pragma unroll
            for (int i = 0; i < 4; ++i) { const int m = (mlo + i < mhi) ? mlo + i : (mhi > 0 ? mhi - 1 : 0); const bf16* ur = UP + (size_t)m * NUP + j; g2[i] = *(const v4u*)ur; uv[i] = *(const v4u*)(ur + DFF); }
            for (int mb = mlo; mb < mhi; mb += 4) {
#pragma unroll
                for (int i = 0; i < 4; ++i) { const int m = (mb + 4 + i < mhi) ? mb + 4 + i : mhi - 1; const bf16* ur = UP + (size_t)m * NUP + j; g2n[i] = *(const v4u*)ur; uvn[i] = *(const v4u*)(ur + DFF); }
#pragma unroll
                for (int i = 0; i < 4; ++i) { const int m = mb + i;
                    if (m < mhi) { const SeqPos sp = seqpos(m); const float* st = args.in[I_SCONV] + (size_t)sp.b * 2 * DFF + j;
                        f32x4 t0[2], t1[2];
                        if (sp.t >= 1) { t1[0] = h1[0]; t1[1] = h1[1]; }
                        else if (sp.prm) { t1[0] = (f32x4){0.f, 0.f, 0.f, 0.f}; t1[1] = t1[0]; } else { t1[0] = *(const f32x4*)(st + DFF); t1[1] = *(const f32x4*)(st + DFF + 4); }
                        if (sp.t >= 2) { t0[0] = h2[0]; t0[1] = h2[1]; }
                        else if (sp.prm) { t0[0] = (f32x4){0.f, 0.f, 0.f, 0.f}; t0[1] = t0[0]; } else { t0[0] = *(const f32x4*)(st + sp.t * DFF); t0[1] = *(const f32x4*)(st + sp.t * DFF + 4); }
                        const v4u g = g2[i], u = uv[i];
                        const f32x4 t2[2] = {{bflo(g.x), bfhi(g.x), bflo(g.y), bfhi(g.y)}, {bflo(g.z), bfhi(g.z), bflo(g.w), bfhi(g.w)}};
                        const f32x4 vv[2] = {{bflo(u.x), bfhi(u.x), bflo(u.y), bfhi(u.y)}, {bflo(u.z), bfhi(u.z), bflo(u.w), bfhi(u.w)}};
                        f32x4 a[2];
#pragma unroll
                        for (int e = 0; e < 2; ++e) { const f32x4 cv = cbv[e] + t0[e] * c0v[e] + t1[e] * c1v[e] + t2[e] * c2v[e];
                            const f32x4 tq = cv * ((cv * cv) * (-2.0f * 0.7978845608028654f * 0.044715f * 1.4426950408889634f) + (-2.0f * 0.7978845608028654f * 1.4426950408889634f));
#pragma unroll
                            for (int x = 0; x < 4; ++x) a[e][x] = cv[x] * vv[e][x] * __builtin_amdgcn_rcpf(1.0f + __builtin_amdgcn_exp2f(tq[x])); }
                        v4u w; w.x = cvt_pk_bf16(a[0][0], a[0][1]); w.y = cvt_pk_bf16(a[0][2], a[0][3]); w.z = cvt_pk_bf16(a[1][0], a[1][1]); w.w = cvt_pk_bf16(a[1][2], a[1][3]);
                        *(v4u*)(ACT + (size_t)m * DFF + j) = w;
                        if (sp.t >= sp.L - 2) { float* co = out + (sp.prm ? O_CONV_P : O_CONV_S) + ((size_t)sp.b * 2 + (sp.t - (sp.L - 2))) * DFF + j; *(f32x4*)co = t2[0]; *(f32x4*)(co + 4) = t2[1]; }
                        h2[0] = h1[0]; h2[1] = h1[1]; h1[0] = t2[0]; h1[1] = t2[1]; }
                }
#pragma unroll
                for (int i = 0; i < 4; ++i) { g2[i] = g2n[i]; uv[i] = uvn[i]; }
            }
        }
    }
    SEAM(11);
    if (IN(12)) { run_gemm_split(F, ACT, WT_DOWN, T, D, DFF, FStoreF32Split{FF, D, FFS, TP, (size_t)TS * D, (bf16*)FF});
    }
    SEAM(12);
    if (IN(13)) {
        for (int m = F.gw; m < T; m += F.NGW) sandwich_row(FF + (size_t)m * D, m < TP ? (const bf16*)FF + (size_t)m * D : nullptr, FFS + (size_t)(m - TP) * D, (size_t)TS * D, m >= TP ? 3 : 0, Y + (size_t)m * D, args.in[I_GPOSTFFN], Y + (size_t)m * D, args.in[I_GPE], H + (size_t)m * D, F.lane);
    }
    SEAM(13);
    if (IN(14)) {
        if (F.G == 256) {
            run_gemm(F, H, WT_PEG, TP, D, D, FPeg{Y, PPb});
            const int c = (int)blockIdx.x, x = c & 7, idx = c >> 3;
            pg8::gemm_quarter(F.lds, H, WT_PEG, D, TP / 128 + (idx & 7), 4 * x + (idx >> 3), FPeg{Y, PPb});
        } else run_gemm(F, H, WT_PEG, T, D, D, FPeg{Y, PPb});
    }
#undef IN
#undef SEAM
}

extern "C" void kernel_launch(void* const* d_in, const int* in_sizes, int n_in, void* d_out, int out_size, void* d_ws, size_t ws_size, hipStream_t stream) {
    static int grid = 0;
    if (grid == 0) {
        if (n_in != 37 || out_size != (int)O_END || ws_size < WS_END) { fprintf(stderr, "kernel_launch: unexpected shapes (n_in %d out %d ws %zu)\n", n_in, out_size, ws_size); grid = -1; return; }
        int dev = 0, cus = 0, per_cu = 0;
        if (hipGetDevice(&dev) != hipSuccess || hipDeviceGetAttribute(&cus, hipDeviceAttributeMultiprocessorCount, dev) != hipSuccess) { grid = -1; return; }
        if (hipFuncSetAttribute((const void*)fwd_kernel, hipFuncAttributeMaxDynamicSharedMemorySize, LDS_BYTES) != hipSuccess) { fprintf(stderr, "kernel_launch: hipFuncSetAttribute failed\n"); grid = -1; return; }
        if (hipOccupancyMaxActiveBlocksPerMultiprocessor(&per_cu, (const void*)fwd_kernel, NT, LDS_BYTES) != hipSuccess || per_cu < 1) { fprintf(stderr, "kernel_launch: occupancy query says %d\n", per_cu); (void)hipGetLastError(); grid = -1; return; }
        grid = cus;
    }
    if (grid < 0) return;
    (void)hipMemsetAsync((char*)d_ws + WS_CTL, 0, CTL_ZERO_BYTES, stream);
    Args a{};
    for (int i = 0; i < 37; ++i) a.in[i] = (const float*)d_in[i];
    a.out = (float*)d_out; a.ws = (unsigned char*)d_ws;
#if MK_ONE_LAUNCH
    a.ph_lo = 0; a.ph_hi = N_PHASES;
    hipLaunchKernelGGL(fwd_kernel, dim3(grid), dim3(NT), LDS_BYTES, stream, a);
#else
    for (int p = 0; p < N_PHASES; ++p) { a.ph_lo = p; a.ph_hi = p + 1; hipLaunchKernelGGL(fwd_kernel, dim3(grid), dim3(NT), LDS_BYTES, stream, a); }
#endif
}
```

```cpp
#include <hip/hip_runtime.h>
#include <cstdio>
#include <cstdint>
#ifndef MK_ONE_LAUNCH
#define MK_ONE_LAUNCH 1
#endif
namespace pg8 {
#define PG8_LAS __attribute__((address_space(3)))
typedef unsigned short bf16_t;
typedef short bf16x8 __attribute__((ext_vector_type(8)));
typedef float f32x4 __attribute__((ext_vector_type(4)));
typedef unsigned u32x4 __attribute__((ext_vector_type(4)));
constexpr int BM = 256, BK = 64, HALF = 128, HTB = HALF * BK * 2  , STAGE_BYTES = 8 * HTB, NXCD = 8, WGM = 8;

__host__ __device__ __forceinline__ int lds_byte(int r, int c) { const int st = (r >> 4) * 2 + (c >> 5), rr = r & 15, cc = c & 31, ob = rr * 64 + cc * 2; return st * 1024 + (ob ^ (((ob >> 9) & 1) << 5)); }
__host__ __device__ __forceinline__ void stage_rc(int b, int& R, int& C) { const int st = b / 1024, sb = b % 1024, swz = sb ^ (((sb >> 9) & 1) << 5); R = (st >> 1) * 16 + swz / 64; C = (st & 1) * 32 + (swz % 64) / 2; }
__host__ __device__ __forceinline__ int perm32(int rho) { const int n = rho >> 4, i = rho & 15; return 8 * (i >> 2) + 4 * n + (i & 3); }

struct Unit { int pm, pn, k0, nt, part; };
struct Gemm { const bf16_t* A; const bf16_t* Bt; int M, N, K; const bf16_t* A2; const bf16_t* Bt2; };

struct StaticOrder {
    int nM, nN, nwg, G, c, ntk, lim;
    __host__ __device__ __forceinline__ void init(int M, int N, int K, int G_, int c_) { nM = M / BM; nN = N / BM; nwg = nM * nN; G = G_; c = c_; ntk = K / BK; lim = nwg; }
    __host__ __device__ __forceinline__ bool next(int i, Unit& u) const { const long L = (long)i * G + c; if (L >= lim) return false; tile(L, u); return true; }
    __host__ __device__ __forceinline__ bool tile(long L, Unit& u) const {
        int wgid = (int)L; { const int q = nwg / NXCD, r = nwg % NXCD, xcd = wgid % NXCD, off = wgid / NXCD; wgid = (xcd < r ? xcd * (q + 1) : r * (q + 1) + (xcd - r) * q) + off; }
        const int nig = WGM * nN, gid = wgid / nig, fm = gid * WGM, gsz = (nM - fm) < WGM ? (nM - fm) : WGM;
        u.pm = fm + ((wgid % nig) % gsz); u.pn = (wgid % nig) / gsz; u.k0 = 0; u.nt = ntk; u.part = 0; return true;
    }
    __device__ __forceinline__ void a_ready(const Unit&) const {}
    __device__ __forceinline__ void done(const Unit&) const {}
};

struct SplitOrder {
    StaticOrder full; int G, c, rounds, R, parts, pm0, nN, ntk; bool split;
    __host__ __device__ __forceinline__ void init(int M, int N, int K, int G_, int c_) {
        const int nM = M / BM; nN = N / BM; G = G_; c = c_; ntk = K / BK; const int U = nM * nN; rounds = U / G; R = U - rounds * G;
        const int pr = R > 0 ? G / R : 1;
        split = R > 0 && (G % R) == 0 && (R % nN) == 0 && ((rounds * G) % nN) == 0 && pr <= 4 && (ntk / 2) >= pr && (G % NXCD) == 0 && (NXCD % pr) == 0 && (NXCD / pr) * (G / NXCD) == R;
        parts = split ? pr : 1; pm0 = split ? (rounds * G) / nN : nM; full.init(pm0 * BM, N, K, G, c);
    }
    __host__ __device__ __forceinline__ bool next(int i, Unit& u) const {
        Unit f; const bool okf = full.next(i, f);
        const int x = c % NXCD, idx = c / NXCD, npx = G / NXCD, p = x % parts, grp = x / parts, tile = grp * npx + idx;
        const int pairs = ntk / 2, q = pairs / parts, rem = pairs % parts;
        const bool isp = split && i == rounds;
        u.pm = isp ? pm0 + tile / nN : f.pm; u.pn = isp ? tile % nN : f.pn; u.part = isp ? p : 0;
        u.nt = isp ? 2 * (q + (p < rem ? 1 : 0)) : ntk; u.k0 = isp ? 2 * BK * (p * q + (p < rem ? p : rem)) : 0;
        return isp || ((!split || i < rounds) && okf);
    }
    __device__ __forceinline__ void a_ready(const Unit&) const {}
    __device__ __forceinline__ void done(const Unit&) const {}
};

struct ChainOrder {
    StaticOrder full;
    __host__ __device__ __forceinline__ void init(int M, int N, int K, int G_, int c_) { full.init(M, N, K, G_, c_); }
    __host__ __device__ __forceinline__ bool next(int i, Unit& u) const { const bool ok = full.next(i >> 1, u); u.part = i & 1; return ok; }
    __device__ __forceinline__ void a_ready(const Unit&) const {}
    __device__ __forceinline__ void done(const Unit&) const {}
};
__device__ __forceinline__ unsigned cvt_pk_bf16(float lo, float hi) { unsigned r; asm volatile("v_cvt_pk_bf16_f32 %0, %1, %2" : "=v"(r) : "v"(lo), "v"(hi)); return r; }
typedef float f32x2 __attribute__((ext_vector_type(2)));
template <class F> struct EpiRow8 {
    static constexpr bool PERM = true, AFTER_DRAIN = false, CHAIN = false;
    F f;
    __device__ __forceinline__ void operator()(const f32x4 (&acc)[2][2][4][2], const Unit& u, int wr, int wc, int fr, int fq) const {
        const int row0 = u.pm * BM + wr * 64 + fr, col0 = u.pn * BM + wc * 32 + 8 * fq;
#pragma unroll
        for (int ai = 0; ai < 2; ++ai)
#pragma unroll
            for (int m = 0; m < 4; ++m) {
#pragma unroll
                for (int bj = 0; bj < 2; ++bj) f(row0 + ai * HALF + m * 16, col0 + bj * HALF, acc[ai][bj][m][0], acc[ai][bj][m][1], u.part);
            }
    }
};

template <class F> struct EpiRow8Chain {
    static constexpr bool PERM = true, AFTER_DRAIN = false, CHAIN = true;
    F f;
    __device__ __forceinline__ void mid(f32x4 (&acc)[2][2][4][2], const Unit& u, int wr, int wc, int fr, int fq) const {
        const int row0 = u.pm * BM + wr * 64 + fr, col0 = u.pn * BM + wc * 32 + 8 * fq;
#pragma unroll
        for (int ai = 0; ai < 2; ++ai)
#pragma unroll
            for (int m = 0; m < 4; ++m) {
#pragma unroll
                for (int bj = 0; bj < 2; ++bj) f.mid(row0 + ai * HALF + m * 16, col0 + bj * HALF, acc[ai][bj][m][0], acc[ai][bj][m][1]);
            }
    }
    __device__ __forceinline__ void operator()(const f32x4 (&acc)[2][2][4][2], const Unit& u, int wr, int wc, int fr, int fq) const {
        const int row0 = u.pm * BM + wr * 64 + fr, col0 = u.pn * BM + wc * 32 + 8 * fq;
#pragma unroll
        for (int ai = 0; ai < 2; ++ai)
#pragma unroll
            for (int m = 0; m < 4; ++m) {
#pragma unroll
                for (int bj = 0; bj < 2; ++bj) f(row0 + ai * HALF + m * 16, col0 + bj * HALF, acc[ai][bj][m][0], acc[ai][bj][m][1], u.part);
            }
    }
};
template <class Epi, class Sched, bool ALIGN_EPI = false, bool SP2 = false>
__device__ __forceinline__ void gemm_phase(PG8_LAS unsigned char* lds, const Gemm g, const Sched& S, const Epi& E) {
    const int tid = threadIdx.x, wid = __builtin_amdgcn_readfirstlane(tid >> 6), lane = tid & 63, wr = wid >> 2, wc = wid & 3, fr = lane & 15, fq = lane >> 4;
    const int K = g.K;
    unsigned voffA[2], voffB[2];
#pragma unroll
    for (int i = 0; i < 2; ++i) { int R, C; stage_rc(tid * 16 + i * 8192, R, C); const int Rb = Epi::PERM ? ((R & ~31) + perm32(R & 31)) : R;
        voffA[i] = (unsigned)(R * K + C) * 2u; voffB[i] = (unsigned)(Rb * K + C) * 2u; }
    const size_t kstep = (size_t)(BK * 2);
    const size_t hstep = (size_t)HALF * K * 2;
    const size_t tstep = 2 * hstep;
    const unsigned ldsw = (unsigned)wid * 1024u;
    const int aoff = lds_byte(wr * 64 + fr, fq * 8), boff = lds_byte(wc * 32 + fr, fq * 8);
#define PG8_SA(b, h) (((b) * 2 + (h)) * HTB)
#define PG8_SB(b, h) ((4 + (b) * 2 + (h)) * HTB)
#define PG8_STAGE(bufoff, gbase, voff) do { _Pragma("unroll") for (int _i = 0; _i < 2; ++_i) \
        __builtin_amdgcn_global_load_lds((const unsigned*)((const char*)(gbase) + (voff)[_i]), (PG8_LAS unsigned*)(lds + (bufoff) + ldsw + _i * 8192), 16, 0, 0); } while (0)
#define PG8_LDA(dst, b, h) do { _Pragma("unroll") for (int m = 0; m < 4; ++m) _Pragma("unroll") for (int k = 0; k < 2; ++k) dst[m][k] = *(const PG8_LAS bf16x8*)(lds + PG8_SA(b, h) + aoff + m * 2048 + k * 1024); } while (0)
#define PG8_LDB(dst, b, h) do { _Pragma("unroll") for (int n = 0; n < 2; ++n) _Pragma("unroll") for (int k = 0; k < 2; ++k) dst[n][k] = *(const PG8_LAS bf16x8*)(lds + PG8_SB(b, h) + boff + n * 2048 + k * 1024); } while (0)
#define PG8_MMA(ai, bj, At, Bt) do { __builtin_amdgcn_s_setprio(1); _Pragma("unroll") for (int m = 0; m < 4; ++m) _Pragma("unroll") for (int n = 0; n < 2; ++n) _Pragma("unroll") for (int k = 0; k < 2; ++k) \
        acc[ai][bj][m][n] = __builtin_amdgcn_mfma_f32_16x16x32_bf16(Bt[n][k], At[m][k], acc[ai][bj][m][n], 0, 0, 0); __builtin_amdgcn_s_setprio(0); } while (0)
#define PG8_WAIT_V(n) asm volatile("s_waitcnt vmcnt(" #n ")" ::: "memory")
#define PG8_WAIT_L(n) asm volatile("s_waitcnt lgkmcnt(" #n ")" ::: "memory")
#define PG8_BAR __builtin_amdgcn_s_barrier()
#define PG8_SCHED __builtin_amdgcn_sched_barrier(0)
    Unit cur, nxt; int ui = 0;
    if (!S.next(0, cur)) return;
    f32x4 acc[2][2][4][2];
#pragma unroll
    for (int a = 0; a < 2; ++a)
#pragma unroll
        for (int b = 0; b < 2; ++b)
#pragma unroll
            for (int m = 0; m < 4; ++m)
#pragma unroll
                for (int n = 0; n < 2; ++n) acc[a][b][m][n] = (f32x4){0.f, 0.f, 0.f, 0.f};
    bf16x8 At[4][2], B0[2][2], B1[2][2];
    const char* cA = (const char*)((Epi::CHAIN && cur.part) ? g.A2 : g.A) + (size_t)cur.pm * tstep + (size_t)cur.k0 * 2; const char* cB = (const char*)((Epi::CHAIN && cur.part) ? g.Bt2 : g.Bt) + (size_t)cur.pn * tstep + (size_t)cur.k0 * 2;
    S.a_ready(cur);
    if constexpr (SP2) {
        PG8_STAGE(PG8_SB(0, 0), cB, voffB); PG8_STAGE(PG8_SB(0, 1), cB + hstep, voffB); PG8_STAGE(PG8_SA(0, 0), cA, voffA); PG8_STAGE(PG8_SA(0, 1), cA + hstep, voffA);
        if (wr == 1) PG8_BAR;
        PG8_WAIT_V(2); PG8_BAR;
        PG8_STAGE(PG8_SB(1, 0), cB + kstep, voffB); PG8_STAGE(PG8_SA(1, 0), cA + kstep, voffA); PG8_STAGE(PG8_SB(1, 1), cB + hstep + kstep, voffB);
        PG8_WAIT_V(6); PG8_BAR;
    } else {
        PG8_STAGE(PG8_SB(0, 0), cB, voffB); PG8_STAGE(PG8_SA(0, 0), cA, voffA); PG8_STAGE(PG8_SB(0, 1), cB + hstep, voffB); PG8_STAGE(PG8_SA(0, 1), cA + hstep, voffA);
        if (wr == 1) PG8_BAR;
        PG8_WAIT_V(4); PG8_BAR;
        PG8_STAGE(PG8_SB(1, 0), cB + kstep, voffB); PG8_STAGE(PG8_SA(1, 0), cA + kstep, voffA); PG8_STAGE(PG8_SB(1, 1), cB + hstep + kstep, voffB);
        PG8_WAIT_V(6); PG8_BAR;
    }
    for (;;) {
        const bool has_next = S.next(ui + 1, nxt);
        const char* nA = has_next ? (const char*)((Epi::CHAIN && nxt.part) ? g.A2 : g.A) + (size_t)nxt.pm * tstep + (size_t)nxt.k0 * 2 : cA; const char* nB = has_next ? (const char*)((Epi::CHAIN && nxt.part) ? g.Bt2 : g.Bt) + (size_t)nxt.pn * tstep + (size_t)nxt.k0 * 2 : cB;
        const int nt = cur.nt;
        for (int t = 0; t < nt; t += 2) {
            const bool last = (t == nt - 2);
            const char* a1 = cA + (size_t)(t + 1) * kstep;
            const char* a2 = last ? nA : cA + (size_t)(t + 2) * kstep; const char* b2 = last ? nB : cB + (size_t)(t + 2) * kstep;
            const char* a3 = a2 + kstep; const char* b3 = b2 + kstep;
            if (last && has_next) S.a_ready(nxt);
            if constexpr (SP2) {
            PG8_LDB(B0, 0, 0); PG8_LDB(B1, 0, 1); PG8_SCHED; PG8_LDA(At, 0, 0); PG8_STAGE(PG8_SA(1, 1), a1 + hstep, voffA);
            PG8_WAIT_V(8); PG8_WAIT_L(0); PG8_BAR; PG8_MMA(0, 0, At, B0); PG8_MMA(0, 1, At, B1); PG8_BAR; PG8_SCHED;
            PG8_LDA(At, 0, 1); PG8_STAGE(PG8_SB(0, 0), b2, voffB); PG8_STAGE(PG8_SB(0, 1), b2 + hstep, voffB); PG8_STAGE(PG8_SA(0, 0), a2, voffA);
            PG8_WAIT_V(8); PG8_WAIT_L(0); PG8_BAR; PG8_MMA(1, 0, At, B0); PG8_MMA(1, 1, At, B1); PG8_BAR; PG8_SCHED;
            PG8_LDB(B0, 1, 0); PG8_LDB(B1, 1, 1); PG8_SCHED; PG8_LDA(At, 1, 0); PG8_STAGE(PG8_SA(0, 1), a2 + hstep, voffA);
            PG8_WAIT_V(8); PG8_WAIT_L(0); PG8_BAR; PG8_MMA(0, 0, At, B0); PG8_MMA(0, 1, At, B1); PG8_BAR; PG8_SCHED;
            PG8_LDA(At, 1, 1); PG8_STAGE(PG8_SB(1, 0), b3, voffB); PG8_STAGE(PG8_SB(1, 1), b3 + hstep, voffB); PG8_STAGE(PG8_SA(1, 0), a3, voffA);
            PG8_WAIT_V(8); PG8_WAIT_L(0); PG8_BAR; PG8_MMA(1, 0, At, B0); PG8_MMA(1, 1, At, B1); PG8_BAR; PG8_SCHED;
            } else {
            PG8_LDB(B0, 0, 0); PG8_SCHED; PG8_LDA(At, 0, 0); PG8_STAGE(PG8_SA(1, 1), a1 + hstep, voffA);
            PG8_WAIT_L(8); PG8_BAR; PG8_WAIT_L(0); PG8_MMA(0, 0, At, B0); PG8_BAR; PG8_SCHED;
            PG8_LDB(B1, 0, 1); PG8_STAGE(PG8_SB(0, 0), b2, voffB);
            PG8_BAR; PG8_WAIT_L(0); PG8_MMA(0, 1, At, B1); PG8_BAR;
            PG8_LDA(At, 0, 1); PG8_STAGE(PG8_SA(0, 0), a2, voffA);
            PG8_BAR; PG8_WAIT_L(0); PG8_MMA(1, 0, At, B0); PG8_BAR; PG8_SCHED;
            PG8_STAGE(PG8_SB(0, 1), b2 + hstep, voffB);
            PG8_WAIT_V(6); PG8_BAR; PG8_MMA(1, 1, At, B1); PG8_BAR;
            PG8_LDB(B0, 1, 0); PG8_SCHED; PG8_LDA(At, 1, 0); PG8_STAGE(PG8_SA(0, 1), a2 + hstep, voffA);
            PG8_WAIT_L(8); PG8_BAR; PG8_WAIT_L(0); PG8_MMA(0, 0, At, B0); PG8_BAR; PG8_SCHED;
            PG8_LDB(B1, 1, 1); PG8_STAGE(PG8_SB(1, 0), b3, voffB);
            PG8_BAR; PG8_WAIT_L(0); PG8_MMA(0, 1, At, B1); PG8_BAR;
            PG8_LDA(At, 1, 1); PG8_STAGE(PG8_SA(1, 0), a3, voffA);
            PG8_BAR; PG8_WAIT_L(0); PG8_MMA(1, 0, At, B0); PG8_BAR; PG8_SCHED;
            PG8_STAGE(PG8_SB(1, 1), b3 + hstep, voffB);
            PG8_WAIT_V(6); PG8_BAR; PG8_MMA(1, 1, At, B1); PG8_BAR;
            }
        }
        if constexpr (ALIGN_EPI) { if (wr == 0) PG8_BAR; }
        const bool mid_unit = Epi::CHAIN && cur.part == 0;
        if constexpr (Epi::CHAIN) { if (mid_unit) E.mid(acc, cur, wr, wc, fr, fq); else { E(acc, cur, wr, wc, fr, fq); S.done(cur); } }
        else if constexpr (!Epi::AFTER_DRAIN) { E(acc, cur, wr, wc, fr, fq); S.done(cur); }
        if (!has_next) break;
        if (!mid_unit)
#pragma unroll
        for (int a = 0; a < 2; ++a)
#pragma unroll
            for (int b = 0; b < 2; ++b)
#pragma unroll
                for (int m = 0; m < 4; ++m)
#pragma unroll
                    for (int n = 0; n < 2; ++n) acc[a][b][m][n] = (f32x4){0.f, 0.f, 0.f, 0.f};
        cur = nxt; cA = nA; cB = nB; ++ui;
        if constexpr (ALIGN_EPI) { if (wr == 1) PG8_BAR; }
    }
    PG8_WAIT_V(0);
    if constexpr (!ALIGN_EPI) { if (wr == 0) PG8_BAR; }
    PG8_BAR;
    if constexpr (Epi::AFTER_DRAIN) { E.fused(acc, cur, wr, wc, fr, fq, lds, wid, lane); S.done(cur); }
#undef PG8_SA
#undef PG8_SB
#undef PG8_STAGE
#undef PG8_LDA
#undef PG8_LDB
#undef PG8_MMA
#undef PG8_WAIT_V
#undef PG8_WAIT_L
#undef PG8_BAR
#undef PG8_SCHED
}

template <class F>
__device__ __forceinline__ void gemm_quarter(PG8_LAS unsigned char* lds, const bf16_t* A, const bf16_t* Bt, int K, int qm, int qn, const F& f) {
    const int tid = threadIdx.x, wid = __builtin_amdgcn_readfirstlane(tid >> 6), lane = tid & 63, wr = wid >> 2, wc = wid & 3, fr = lane & 15, fq = lane >> 4;
    unsigned voffA[2], voffB[2];
#pragma unroll
    for (int i = 0; i < 2; ++i) { int R, C; stage_rc(tid * 16 + i * 8192, R, C); const int Rb = (R & ~31) + perm32(R & 31);
        voffA[i] = (unsigned)(R * K + C) * 2u; voffB[i] = (unsigned)(Rb * K + C) * 2u; }
    const size_t kstep = (size_t)(BK * 2);
    const unsigned ldsw = (unsigned)wid * 1024u;
    const int aoff = lds_byte(wr * 64 + fr, fq * 8), boff = lds_byte(wc * 32 + fr, fq * 8);
    const char* cA = (const char*)A + (size_t)qm * HALF * K * 2; const char* cB = (const char*)Bt + (size_t)qn * HALF * K * 2;
    const int nt = K / BK;
#define PG8_QSTAGE(slot, t_) do { const size_t go_ = (size_t)(t_) * kstep; _Pragma("unroll") for (int _i = 0; _i < 2; ++_i) { \
        __builtin_amdgcn_global_load_lds((const unsigned*)(cA + go_ + voffA[_i]), (PG8_LAS unsigned*)(lds + (slot) * HTB + ldsw + _i * 8192), 16, 0, 0); \
        __builtin_amdgcn_global_load_lds((const unsigned*)(cB + go_ + voffB[_i]), (PG8_LAS unsigned*)(lds + (4 + (slot)) * HTB + ldsw + _i * 8192), 16, 0, 0); } } while (0)
    f32x4 acc[4][2];
#pragma unroll
    for (int m = 0; m < 4; ++m)
#pragma unroll
        for (int n = 0; n < 2; ++n) acc[m][n] = (f32x4){0.f, 0.f, 0.f, 0.f};
    bf16x8 At[4][2], Bq[2][2];
    PG8_QSTAGE(0, 0); PG8_QSTAGE(1, 1); PG8_QSTAGE(2, 2);
    for (int t = 0; t < nt; t += 4) {
#pragma unroll
        for (int sl = 0; sl < 4; ++sl) {
            asm volatile("s_waitcnt vmcnt(8)" ::: "memory"); __builtin_amdgcn_s_barrier();
            { const int tn = t + sl + 3; PG8_QSTAGE((sl + 3) & 3, tn < nt ? tn : tn - nt); }
#pragma unroll
            for (int m = 0; m < 4; ++m)
#pragma unroll
                for (int k = 0; k < 2; ++k) At[m][k] = *(const PG8_LAS bf16x8*)(lds + sl * HTB + aoff + m * 2048 + k * 1024);
#pragma unroll
            for (int n = 0; n < 2; ++n)
#pragma unroll
                for (int k = 0; k < 2; ++k) Bq[n][k] = *(const PG8_LAS bf16x8*)(lds + (4 + sl) * HTB + boff + n * 2048 + k * 1024);
            asm volatile("s_waitcnt lgkmcnt(0)" ::: "memory");
            __builtin_amdgcn_s_setprio(1);
#pragma unroll
            for (int m = 0; m < 4; ++m)
#pragma unroll
                for (int n = 0; n < 2; ++n)
#pragma unroll
                    for (int k = 0; k < 2; ++k) acc[m][n] = __builtin_amdgcn_mfma_f32_16x16x32_bf16(Bq[n][k], At[m][k], acc[m][n], 0, 0, 0);
            __builtin_amdgcn_s_setprio(0);
            __builtin_amdgcn_sched_barrier(0);
        }
    }
    asm volatile("s_waitcnt vmcnt(0)" ::: "memory"); __builtin_amdgcn_s_barrier();
#undef PG8_QSTAGE
    const int row0 = qm * HALF + wr * 64 + fr, col0 = qn * HALF + wc * 32 + 8 * fq;
#pragma unroll
    for (int m = 0; m < 4; ++m) f(row0 + m * 16, col0, acc[m][0], acc[m][1], 0);
}
}

#ifndef PG8_SP2
#define PG8_SP2 true
#endif
#ifndef PG8_ALIGN
#define PG8_ALIGN true
#endif

constexpr int NWAVES = 8, NT = 512;
constexpr int TP = 8192, TS = 1024, T = TP + TS, D = 4096;
constexpr int SEQ = 2048, DSEQ = 8, NB = 4, NDB = 128;
constexpr int NPROJ = 20992;
constexpr int CQ = 0, CK = 1024, CV = 2048, CZG = 4096, CR = 6144, CKR = 8192, CVR = 10240, CXG = 12288, CSM = 12544, CGA = 12800, CGB = 16896;
constexpr int ZRC = 6592;
constexpr int DFF = 11008, NUP = 2 * DFF;
constexpr int NL1 = 5120;
constexpr int SCAN_REC = 896;
constexpr int SCAN_LREC = 1408;
constexpr size_t O_Y = 0, O_GLA_P = 37748736, O_RWKV_P = 39845888, O_SHIFT_P = 40370176, O_CONV_P = 40396544,
                 O_GLA_S = 40484608, O_RWKV_S = 107593472, O_SHIFT_S = 124370688, O_CONV_S = 125214464, O_END = 128032512;
constexpr size_t MiB = 1u << 20;
constexpr size_t WS_CTL = 0, CTL_ZERO_BYTES = 1 * MiB;
constexpr size_t WS_WT_IN = 1 * MiB, WS_WT_UP = 165 * MiB, WS_WT_DOWN = 337 * MiB, WS_WT_OUT = 423 * MiB, WS_WT_PEG = 455 * MiB, WS_WT_BRA = 487 * MiB,
                 WS_WT_BRB = 503 * MiB, WS_WT_PE = 519 * MiB, WS_WL1 = 521 * MiB, WS_WG = 524 * MiB, WS_H = 525 * MiB, WS_PROJ = 597 * MiB,
                 WS_SCAN = 984 * MiB, WS_G = 1380 * MiB, WS_LA = 1416 * MiB, WS_AL1 = 1452 * MiB, WS_AG = 1457 * MiB, WS_PB = 1462 * MiB,
                 WS_BONUS = 1467 * MiB, WS_END = 1469 * MiB;
constexpr size_t WS_QD = WS_H, WS_KDDT = WS_H + 16 * MiB, WS_VT = WS_H + 32 * MiB, WS_ATT = WS_H + 64 * MiB, WS_EB = WS_H + 68 * MiB;
constexpr size_t WS_RW1 = WS_WT_IN, WS_RW2 = WS_SCAN + 256 * MiB;
static_assert((size_t)NB * 32 * (SEQ / 16) * 7168 <= 164 * MiB && WS_RW2 + (size_t)NB * 32 * (SEQ / 16) * 6656 <= WS_G && (size_t)T * 32 * SCAN_REC <= 256 * MiB, "chunk operand arrays");
constexpr size_t WS_PP = WS_SCAN + 200 * MiB;
constexpr int CW_QUEUE = 64;
constexpr int CW_BAR = 4096;

constexpr int RING_BYTES = 131072, MISC_OFF = RING_BYTES + 320, LDS_BYTES = 147456;

#define LAS __attribute__((address_space(3)))
typedef unsigned short bf16;
typedef unsigned v4u __attribute__((ext_vector_type(4)));
typedef unsigned v2u __attribute__((ext_vector_type(2)));
typedef float f32x4 __attribute__((ext_vector_type(4)));
#define LDS_WAIT() asm volatile("s_waitcnt lgkmcnt(0)" ::: "memory")
#define VM_WAIT() asm volatile("s_waitcnt vmcnt(0)" ::: "memory")
#define WG_BAR() do { asm volatile("s_waitcnt lgkmcnt(0)" ::: "memory"); __builtin_amdgcn_s_barrier(); asm volatile("" ::: "memory"); } while (0)
__device__ __forceinline__ unsigned f2bf(float f) { unsigned u = __builtin_bit_cast(unsigned, f); return (u + 0x7fffu + ((u >> 16) & 1u)) >> 16; }
typedef __bf16 hw_bf2 __attribute__((ext_vector_type(2)));
typedef float hw_f2 __attribute__((ext_vector_type(2)));
__device__ __forceinline__ unsigned pk2(float lo, float hi) { const hw_f2 v = {lo, hi}; return __builtin_bit_cast(unsigned, __builtin_convertvector(v, hw_bf2)); }
__device__ __forceinline__ float bf2f(unsigned b) { return __builtin_bit_cast(float, b << 16); }
__device__ __forceinline__ float bflo(unsigned w) { return __builtin_bit_cast(float, w << 16); }
__device__ __forceinline__ float bfhi(unsigned w) { return __builtin_bit_cast(float, w & 0xffff0000u); }
__device__ __forceinline__ float sigmoidf_(float x) { return __builtin_amdgcn_rcpf(1.0f + __builtin_amdgcn_exp2f(x * -1.4426950408889634f)); }
__device__ __forceinline__ float softplusf_(float x) { return fmaxf(x, 0.f) + 0.6931471805599453f * __builtin_amdgcn_logf(1.0f + __builtin_amdgcn_exp2f(fabsf(x) * -1.4426950408889634f)); }
__device__ __forceinline__ float wave_sum(float v) {
#pragma unroll
    for (int o = 1; o < 64; o <<= 1) v += __shfl_xor(v, o);
    return v;
}

#define XB_TMO      128
#define XB_XCNT(j)  (256  + 64 * (j))
#define XB_XSUB(j)  (1280 + 64 * (j))
#define XB_XGEN(j)  (2304 + 64 * (j))
#define XB_TOP      3328
#define XB_TOPGEN   3392
#define XCD_BAR_WORDS 3456
#define XB_SPIN_CAP (1u << 23)
__device__ __forceinline__ unsigned xb_ld(unsigned* p)              { return __hip_atomic_load(p, __ATOMIC_RELAXED, __HIP_MEMORY_SCOPE_AGENT); }
__device__ __forceinline__ unsigned xb_add(unsigned* p, unsigned v) { return __hip_atomic_fetch_add(p, v, __ATOMIC_RELAXED, __HIP_MEMORY_SCOPE_AGENT); }
__device__ __forceinline__ unsigned xb_xcc_id() { return (unsigned)__builtin_amdgcn_s_getreg((3 << 11) | 20) & 0xFu; }
#define XB_SPIN(cond, bar) do { unsigned _sp = 0; while (cond) { __builtin_amdgcn_s_sleep(1); \
    if ((++_sp & 255u) == 0u) { if (xb_ld(&(bar)[XB_TMO])) break; if (_sp > XB_SPIN_CAP) { atomicAdd(&(bar)[XB_TMO], 1u); break; } } } } while (0)
struct XcdBarrier { unsigned* bar; unsigned x; volatile LAS unsigned* st; };
__device__ __forceinline__ XcdBarrier xcd_barrier_post(unsigned* bar, volatile LAS unsigned* st) {
    XcdBarrier b; b.bar = bar; b.x = xb_xcc_id(); b.st = st;
    if (threadIdx.x == 0) (void)xb_add(&bar[XB_XCNT(b.x)], 1u);
    return b;
}
__device__ __forceinline__ void xcd_barrier_complete(unsigned* bar, unsigned x, unsigned& nloc, unsigned& nx) {
    const unsigned G = gridDim.x * gridDim.y * gridDim.z;
    unsigned sum, cnt, mine, sp = 0u;
    for (;;) {
        sum = 0u; cnt = 0u; mine = 0u;
#pragma unroll
        for (unsigned j = 0; j < 16; ++j) { const unsigned c = xb_ld(&bar[XB_XCNT(j)]); sum += c; cnt += (c > 0u) ? 1u : 0u; mine = (j == x) ? c : mine; }
        if (sum == G) break;
        __builtin_amdgcn_s_sleep(1);
        if ((++sp & 255u) == 0u) { if (xb_ld(&bar[XB_TMO])) break; if (sp > XB_SPIN_CAP) { atomicAdd(&bar[XB_TMO], 1u); break; } }
    }
    nloc = mine > 0u ? mine : 1u; nx = cnt > 0u ? cnt : 1u;
}
__device__ __forceinline__ void xcd_barrier(const XcdBarrier& b) {
    asm volatile("s_waitcnt vmcnt(0)" ::: "memory");
    __syncthreads();
    if (threadIdx.x == 0) {
        unsigned* bar = b.bar;
        __builtin_amdgcn_s_waitcnt(0);
        unsigned nloc = b.st[0], nx = b.st[1];
        if (nloc == 0u) { xcd_barrier_complete(bar, b.x, nloc, nx); b.st[0] = nloc; b.st[1] = nx; }
        const unsigned old = xb_add(&bar[XB_XSUB(b.x)], 1u);
        const unsigned gen = old / nloc;
        if (old + 1u == (gen + 1u) * nloc) {
            __builtin_amdgcn_fence(__ATOMIC_RELEASE, "agent");
            asm volatile("s_waitcnt vmcnt(0)" ::: "memory");
            const unsigned og = xb_add(&bar[XB_TOP], 1u);
            const unsigned tg = og / nx;
            if (og + 1u == (tg + 1u) * nx) xb_add(&bar[XB_TOPGEN], 1u);
            else XB_SPIN(xb_ld(&bar[XB_TOPGEN]) == tg, bar);
            __builtin_amdgcn_fence(__ATOMIC_ACQUIRE, "agent");
            xb_add(&bar[XB_XGEN(b.x)], 1u);
            asm volatile("s_waitcnt vmcnt(0)" ::: "memory");
        } else {
            XB_SPIN(xb_ld(&bar[XB_XGEN(b.x)]) == gen, bar);
            __builtin_amdgcn_fence(__ATOMIC_ACQUIRE, "agent");
            asm volatile("s_waitcnt vmcnt(0)" ::: "memory");
        }
    }
    __syncthreads();
}

struct Args { const float* in[37]; float* out; unsigned char* ws; int ph_lo, ph_hi; };
typedef __attribute__((address_space(4))) const Args KArgs;
struct Frame { LAS unsigned char* lds; int tid, lane, wave, vcu, G, gw, NGW; };
enum { I_XP = 0, I_XS, I_SGLA, I_SRWKV, I_SSHIFT, I_SCONV, I_PP, I_PS, I_WIN, I_WALPHA2, I_BALPHA, I_GLANORM, I_WBRA, I_MU, I_W0, I_WDECAY2, I_A0, I_WICLR2,
       I_WGATE2, I_KK, I_KA, I_RK, I_LNXW, I_LNXB, I_WBRB, I_WOUT, I_GPREMIX, I_GPOSTMIX, I_GPREFFN, I_GPOSTFFN, I_WUP, I_CONVW, I_CONVB, I_WDOWN, I_GPE, I_WPEG, I_WPE };

struct SeqPos { int b, t, L; bool prm; };
__device__ __forceinline__ SeqPos seqpos(int m) { SeqPos s; s.prm = m < TP; if (s.prm) { s.b = m >> 11; s.t = m & 2047; s.L = SEQ; } else { s.b = (m - TP) >> 3; s.t = (m - TP) & 7; s.L = DSEQ; } return s; }
__device__ __forceinline__ const float* xrow(KArgs& a, int m) { return m < TP ? a.in[I_XP] + (size_t)m * D : a.in[I_XS] + (size_t)(m - TP) * D; }

__host__ __device__ __forceinline__ int win_src16(int g) {
    const int n = g * 16;
    if (n < 4096) return n;
    if (n < 6144) return 4112 + (n - 4096);
    if (n < 8192) return 6160 + (n - 6144);
    if (n < 10240) return 8304 + (n - 8192);
    if (n < 12288) return 10352 + (n - 10240);
    if (n < 12544) return 12496 + (n - 12288);
    if (n < 12560) return 4096;
    if (n < 12656) return 8208 + (n - 12560);
    if (n < 12752) return 12400 + (n - 12656);
    if (n < 12800) return -1;
    if (n < 16896) return 12752 + (n - 12800);
    return 16848 + (n - 16896);
}
__host__ __device__ __forceinline__ int zr_col(int oz) {
    if (oz < 2048) return CR + oz;
    if (oz < 2144) return CSM + 16 + (oz - 2048);
    if (oz < 4192) return CKR + (oz - 2144);
    if (oz < 6240) return CVR + (oz - 4192);
    if (oz < 6336) return CSM + 112 + (oz - 6240);
    return CXG + (oz - 6336);
}

struct TrDesc { const float* W; bf16* WT; int K, Nsrc, nblk, item; bool map; };
__device__ __forceinline__ void tr_load(const TrDesc& d, float (&tv)[32], int lane) {
    const int kb = d.item / d.nblk, nb = d.item - kb * d.nblk, k0 = 64 * kb, n0 = 32 * nb, nl = lane & 31;
    int sc = n0 + nl;
    if (d.map) { const int s = win_src16((n0 + nl) >> 4); sc = s < 0 ? -1 : s + (nl & 15); }
    const float* wp = d.W + (size_t)(k0 + (lane >> 5)) * d.Nsrc + (sc >= 0 ? sc : 0);
#pragma unroll
    for (int i = 0; i < 32; ++i) tv[i] = __builtin_nontemporal_load(wp + (size_t)(2 * i) * d.Nsrc);
}
__device__ __forceinline__ void tr_finish(const TrDesc& d, const float (&tv)[32], LAS float* scr, int lane) {
    const int kb = d.item / d.nblk, nb = d.item - kb * d.nblk, k0 = 64 * kb, n0 = 32 * nb, nl = lane & 31;
    bool pad = false;
    if (d.map) pad = win_src16((n0 + nl) >> 4) < 0;
#pragma unroll
    for (int i = 0; i < 32; ++i) scr[(2 * i + (lane >> 5)) * 33 + nl] = pad ? 0.f : tv[i];
    LDS_WAIT(); asm volatile("" ::: "memory");
    const int c = lane & 7;
#pragma unroll
    for (int j = 0; j < 4; ++j) { const int n = (lane >> 3) + 8 * j; const LAS float* s = scr + (8 * c) * 33 + n;
        v4u o; o.x = pk2(s[0 * 33], s[1 * 33]); o.y = pk2(s[2 * 33], s[3 * 33]); o.z = pk2(s[4 * 33], s[5 * 33]); o.w = pk2(s[6 * 33], s[7 * 33]);
        *(v4u*)(d.WT + (size_t)(n0 + n) * d.K + k0 + 8 * c) = o; }
    LDS_WAIT(); asm volatile("" ::: "memory");
}
__device__ __forceinline__ void rms_row_bf16(const float* xr_, const float* gain, bf16* orow, int lane) {
    const f32x4* xr = (const f32x4*)xr_ + lane; f32x4 v[16]; float ss = 0.f;
#pragma unroll
    for (int j = 0; j < 16; ++j) { v[j] = xr[64 * j]; ss += (v[j].x * v[j].x + v[j].y * v[j].y) + (v[j].z * v[j].z + v[j].w * v[j].w); }
    const float rs = __builtin_amdgcn_rsqf(wave_sum(ss) * (1.f / D) + 1e-6f);
    const f32x4* gr = (const f32x4*)gain + lane; v2u* o = (v2u*)orow + lane;
#pragma unroll
    for (int j = 0; j < 16; ++j) { const f32x4 g = gr[64 * j]; v2u w; w.x = pk2(v[j].x * rs * g.x, v[j].y * rs * g.y); w.y = pk2(v[j].z * rs * g.z, v[j].w * rs * g.w); o[64 * j] = w; }
}
__device__ __forceinline__ void sandwich_row(const float* srow, const bf16* brow, const float* slabrow, size_t slab_stride, int nslab, const float* xi, const float* g1, float* xo, const float* g2, bf16* ho, int lane) {
    f32x4 v[16]; float ss = 0.f;
    if (brow) { const v2u* br = (const v2u*)brow + lane;
#pragma unroll
        for (int j = 0; j < 16; ++j) { const v2u x = br[64 * j]; v[j] = (f32x4){bflo(x.x), bfhi(x.x), bflo(x.y), bfhi(x.y)}; } }
    else { const f32x4* sr = (const f32x4*)srow + lane;
#pragma unroll
        for (int j = 0; j < 16; ++j) v[j] = sr[64 * j]; }
    for (int p = 0; p < nslab; ++p) { const f32x4* pr = (const f32x4*)(slabrow + (size_t)p * slab_stride) + lane;
#pragma unroll
        for (int j = 0; j < 16; ++j) v[j] += pr[64 * j]; }
#pragma unroll
    for (int j = 0; j < 16; ++j) { ss += (v[j].x * v[j].x + v[j].y * v[j].y) + (v[j].z * v[j].z + v[j].w * v[j].w); }
    const float rs = __builtin_amdgcn_rsqf(wave_sum(ss) * (1.f / D) + 1e-6f);
    const f32x4* xr = (const f32x4*)xi + lane; const f32x4* gr = (const f32x4*)g1 + lane; f32x4* xw = (f32x4*)xo + lane; float s2 = 0.f;
#pragma unroll
    for (int j = 0; j < 16; ++j) { const f32x4 x = xr[64 * j], g = gr[64 * j]; v[j] = x + v[j] * rs * g; xw[64 * j] = v[j]; s2 += (v[j].x * v[j].x + v[j].y * v[j].y) + (v[j].z * v[j].z + v[j].w * v[j].w); }
    const float r2 = __builtin_amdgcn_rsqf(wave_sum(s2) * (1.f / D) + 1e-6f);
    const f32x4* g2r = (const f32x4*)g2 + lane; v2u* o = (v2u*)ho + lane;
#pragma unroll
    for (int j = 0; j < 16; ++j) { const f32x4 g = g2r[64 * j]; v2u w; w.x = pk2(v[j].x * r2 * g.x, v[j].y * r2 * g.y); w.y = pk2(v[j].z * r2 * g.z, v[j].w * r2 * g.w); o[64 * j] = w; }
}

struct FStoreBf16 { bf16* O; int ld;
    __device__ __forceinline__ void operator()(int row, int col, f32x4 v0, f32x4 v1, int) const {
        v4u w; w.x = pg8::cvt_pk_bf16(v0[0], v0[1]); w.y = pg8::cvt_pk_bf16(v0[2], v0[3]); w.z = pg8::cvt_pk_bf16(v1[0], v1[1]); w.w = pg8::cvt_pk_bf16(v1[2], v1[3]);
        __builtin_nontemporal_store(w, (v4u*)(O + (size_t)row * ld + col)); } };
struct FStoreF32Split { float* O; int ld; float* slab; int row0; size_t slab_stride; bf16* Ob;
    __device__ __forceinline__ void operator()(int row, int col, f32x4 v0, f32x4 v1, int part) const {
        if (row < row0) { v4u w; w.x = pg8::cvt_pk_bf16(v0[0], v0[1]); w.y = pg8::cvt_pk_bf16(v0[2], v0[3]); w.z = pg8::cvt_pk_bf16(v1[0], v1[1]); w.w = pg8::cvt_pk_bf16(v1[2], v1[3]); *(v4u*)(Ob + (size_t)row * ld + col) = w; return; }
        float* p = part == 0 ? O + (size_t)row * ld + col : slab + (size_t)(part - 1) * slab_stride + (size_t)(row - row0) * ld + col; *(f32x4*)p = v0; *(f32x4*)(p + 4) = v1; } };
struct FStoreF32 { float* O; int ld;
    __device__ __forceinline__ void operator()(int row, int col, f32x4 v0, f32x4 v1, int) const { float* p = O + (size_t)row * ld + col; *(f32x4*)p = v0; *(f32x4*)(p + 4) = v1; } };
struct FBrA { const bf16* proj; float* tmp;
    __device__ __forceinline__ void operator()(int row, int col, f32x4 v0, f32x4 v1, int) const {
        const v4u g = *(const v4u*)(proj + (size_t)row * NPROJ + CGA + col);
        f32x4 s0 = {sigmoidf_(bflo(g.x)), sigmoidf_(bfhi(g.x)), sigmoidf_(bflo(g.y)), sigmoidf_(bfhi(g.y))}, s1 = {sigmoidf_(bflo(g.z)), sigmoidf_(bfhi(g.z)), sigmoidf_(bflo(g.w)), sigmoidf_(bfhi(g.w))};
        float* p = tmp + (size_t)row * D + col; *(f32x4*)p = s0 * v0; *(f32x4*)(p + 4) = s1 * v1; } };
struct FBrB { const bf16* proj; const float* tmp; bf16* mixed;
    __device__ __forceinline__ void operator()(int row, int col, f32x4 v0, f32x4 v1, int) const {
        const v4u g = *(const v4u*)(proj + (size_t)row * NPROJ + CGB + col);
        f32x4 s0 = {sigmoidf_(bflo(g.x)), sigmoidf_(bfhi(g.x)), sigmoidf_(bflo(g.y)), sigmoidf_(bfhi(g.y))}, s1 = {sigmoidf_(bflo(g.z)), sigmoidf_(bfhi(g.z)), sigmoidf_(bflo(g.w)), sigmoidf_(bfhi(g.w))};
        const float* p = tmp + (size_t)row * D + col; const f32x4 a0 = *(const f32x4*)p + s0 * v0, a1 = *(const f32x4*)(p + 4) + s1 * v1;
        v4u w; w.x = pg8::cvt_pk_bf16(a0[0], a0[1]); w.y = pg8::cvt_pk_bf16(a0[2], a0[3]); w.z = pg8::cvt_pk_bf16(a1[0], a1[1]); w.w = pg8::cvt_pk_bf16(a1[2], a1[3]);
        *(v4u*)(mixed + (size_t)row * D + col) = w; } };
struct FPeg { float* y; const bf16* pp;
    __device__ __forceinline__ void operator()(int row, int col, f32x4 v0, f32x4 v1, int) const {
        const v4u g = *(const v4u*)(pp + (size_t)row * D + col); float* p = y + (size_t)row * D + col;
        const f32x4 p0 = {bflo(g.x), bfhi(g.x), bflo(g.y), bfhi(g.y)}, p1 = {bflo(g.z), bfhi(g.z), bflo(g.w), bfhi(g.w)};
        f32x4 s0 = {sigmoidf_(v0[0]), sigmoidf_(v0[1]), sigmoidf_(v0[2]), sigmoidf_(v0[3])}, s1 = {sigmoidf_(v1[0]), sigmoidf_(v1[1]), sigmoidf_(v1[2]), sigmoidf_(v1[3])};
        *(f32x4*)p = *(const f32x4*)p + s0 * p0; *(f32x4*)(p + 4) = *(const f32x4*)(p + 4) + s1 * p1; } };

template <class F> __device__ __forceinline__ void run_gemm(Frame& F_, const bf16* A, const bf16* Bt, int M, int N, int K, const F& f) {
    pg8::Gemm g{A, Bt, M, N, K, nullptr, nullptr}; pg8::StaticOrder S; S.init(M, N, K, F_.G, (int)blockIdx.x);
    pg8::EpiRow8<F> E{f};
    pg8::gemm_phase<pg8::EpiRow8<F>, pg8::StaticOrder, PG8_ALIGN, PG8_SP2>(F_.lds, g, S, E);
}

struct FBranch { const bf16* proj; bf16* mixed;
    __device__ __forceinline__ void mid(int row, int col, f32x4& v0, f32x4& v1) const {
        const v4u ga = *(const v4u*)(proj + (size_t)row * NPROJ + CGA + col), gb = *(const v4u*)(proj + (size_t)row * NPROJ + CGB + col);
        const float a[8] = {bflo(ga.x), bfhi(ga.x), bflo(ga.y), bfhi(ga.y), bflo(ga.z), bfhi(ga.z), bflo(ga.w), bfhi(ga.w)}, b[8] = {bflo(gb.x), bfhi(gb.x), bflo(gb.y), bfhi(gb.y), bflo(gb.z), bfhi(gb.z), bflo(gb.w), bfhi(gb.w)};
#pragma unroll
        for (int e = 0; e < 4; ++e) { v0[e] *= (1.0f + __expf(-b[e])) * __builtin_amdgcn_rcpf(1.0f + __expf(-a[e])); v1[e] *= (1.0f + __expf(-b[4 + e])) * __builtin_amdgcn_rcpf(1.0f + __expf(-a[4 + e])); } }
    __device__ __forceinline__ void operator()(int row, int col, f32x4 v0, f32x4 v1, int) const {
        const v4u g = *(const v4u*)(proj + (size_t)row * NPROJ + CGB + col);
        const f32x4 s0 = {sigmoidf_(bflo(g.x)), sigmoidf_(bfhi(g.x)), sigmoidf_(bflo(g.y)), sigmoidf_(bfhi(g.y))}, s1 = {sigmoidf_(bflo(g.z)), sigmoidf_(bfhi(g.z)), sigmoidf_(bflo(g.w)), sigmoidf_(bfhi(g.w))};
        const f32x4 a0 = s0 * v0, a1 = s1 * v1;
        v4u w; w.x = pg8::cvt_pk_bf16(a0[0], a0[1]); w.y = pg8::cvt_pk_bf16(a0[2], a0[3]); w.z = pg8::cvt_pk_bf16(a1[0], a1[1]); w.w = pg8::cvt_pk_bf16(a1[2], a1[3]);
        *(v4u*)(mixed + (size_t)row * D + col) = w; } };
template <class F> __device__ __forceinline__ void run_gemm_chain(Frame& F_, const bf16* A, const bf16* Bt, const bf16* A2, const bf16* Bt2, int M, int N, int K, const F& f) {
    pg8::Gemm g{A, Bt, M, N, K, A2, Bt2}; pg8::ChainOrder S; S.init(M, N, K, F_.G, (int)blockIdx.x);
    pg8::EpiRow8Chain<F> E{f};
    pg8::gemm_phase<pg8::EpiRow8Chain<F>, pg8::ChainOrder, PG8_ALIGN, PG8_SP2>(F_.lds, g, S, E);
}
template <class F> __device__ __forceinline__ void run_gemm_lim(Frame& F_, const bf16* A, const bf16* Bt, int M, int N, int K, const F& f, int lim) {
    pg8::Gemm g{A, Bt, M, N, K, nullptr, nullptr}; pg8::StaticOrder S; S.init(M, N, K, F_.G, (int)blockIdx.x); S.lim = lim;
    pg8::EpiRow8<F> E{f};
    pg8::gemm_phase<pg8::EpiRow8<F>, pg8::StaticOrder, PG8_ALIGN, PG8_SP2>(F_.lds, g, S, E);
}
template <class F> __device__ __forceinline__ void run_gemm_gc(Frame& F_, const bf16* A, const bf16* Bt, int M, int N, int K, const F& f, int G, int c) {
    pg8::Gemm g{A, Bt, M, N, K, nullptr, nullptr}; pg8::StaticOrder S; S.init(M, N, K, G, c);
    pg8::EpiRow8<F> E{f};
    pg8::gemm_phase<pg8::EpiRow8<F>, pg8::StaticOrder, PG8_ALIGN, PG8_SP2>(F_.lds, g, S, E);
}
template <class F> __device__ __forceinline__ void run_gemm_split(Frame& F_, const bf16* A, const bf16* Bt, int M, int N, int K, const F& f) {
    pg8::Gemm g{A, Bt, M, N, K, nullptr, nullptr}; pg8::SplitOrder S; S.init(M, N, K, F_.G, (int)blockIdx.x);
    pg8::EpiRow8<F> E{f};
    pg8::gemm_phase<pg8::EpiRow8<F>, pg8::SplitOrder, PG8_ALIGN, PG8_SP2>(F_.lds, g, S, E);
}

typedef float f32x2 __attribute__((ext_vector_type(2)));
__device__ __forceinline__ float dpp_f(float x, int ctrl_sel) {
    const int v = __builtin_bit_cast(int, x); int r;
    if (ctrl_sel == 0) r = __builtin_amdgcn_update_dpp(v, v, 0xB1, 0xF, 0xF, false);
    else if (ctrl_sel == 1) r = __builtin_amdgcn_update_dpp(v, v, 0x4E, 0xF, 0xF, false);
    else r = __builtin_amdgcn_update_dpp(v, v, 0x141, 0xF, 0xF, false);
    return __builtin_bit_cast(float, r);
}
__device__ __forceinline__ float sum8(float x) {
    float a, b, c;
    asm volatile("s_nop 1\n\tv_add_f32_dpp %0, %1, %1 quad_perm:[1,0,3,2] row_mask:0xf bank_mask:0xf" : "=v"(a) : "v"(x));
    asm volatile("s_nop 1\n\tv_add_f32_dpp %0, %1, %1 quad_perm:[2,3,0,1] row_mask:0xf bank_mask:0xf" : "=v"(b) : "v"(a));
    asm volatile("s_nop 1\n\tv_add_f32_dpp %0, %1, %1 row_half_mirror row_mask:0xf bank_mask:0xf" : "=v"(c) : "v"(b));
    return c;
}
template <int HEADS>
__device__ __forceinline__ void rwkv_unit(Frame& F, const unsigned char* scan, int m0, int L, int h, const float* S0, float* Sout, float* OB) {
    constexpr int TB = 16, RB = SCAN_LREC, RG = SCAN_REC, PCS = RG / 16, NPC = (TB * PCS + 511) / 512;
    LAS unsigned char* buf = F.lds;
    const int tid = F.tid, v = tid >> 3, j = tid & 7;
    f32x2 S[4];
    if (S0) { const f32x4 a = *(const f32x4*)(S0 + v * 64 + 8 * j), b = *(const f32x4*)(S0 + v * 64 + 8 * j + 4); S[0] = (f32x2){a.x, a.y}; S[1] = (f32x2){a.z, a.w}; S[2] = (f32x2){b.x, b.y}; S[3] = (f32x2){b.z, b.w}; }
    else {
#pragma unroll
        for (int i = 0; i < 4; ++i) S[i] = (f32x2){0.f, 0.f}; }
    const int nst = L < TB ? L : TB, nblk = HEADS ? HEADS : L / nst, nch = nst * PCS;
    constexpr int DUMMY = 2 * TB * RB;
    int goff[NPC], lo0[NPC], lo1[NPC]; bool cv[NPC];
#pragma unroll
    for (int i = 0; i < NPC; ++i) { const int c = tid + 512 * i; const bool valid = c < nch; const int cc = valid ? c : 0, st = cc / PCS, p = cc - st * PCS; goff[i] = st * 32 * RG + p * 16;
        const int lo = st * RB + (p < 16 ? p * 16 : (p < 48 ? 256 + (p - 16) * 32 : 1280 + (p - 48) * 16)); cv[i] = p >= 16 && p < 48;
        lo0[i] = valid ? lo : -1; lo1[i] = (valid && cv[i]) ? lo + 16 : -1; }
    const unsigned char* gsrc = scan + ((size_t)m0 * 32 + h) * RG;
    const size_t bstep = HEADS ? (size_t)RG : (size_t)nst * 32 * RG;
#define RW_PUT(bo_, i_) do { const v4u x_ = pre[i_]; const f32x4 c0_ = {bflo(x_.x), bfhi(x_.x), bflo(x_.y), bfhi(x_.y)}, c1_ = {bflo(x_.z), bfhi(x_.z), bflo(x_.w), bfhi(x_.w)}; \
        *(LAS v4u*)(buf + (lo0[i_] >= 0 ? (bo_) + lo0[i_] : DUMMY)) = cv[i_] ? __builtin_bit_cast(v4u, c0_) : x_; *(LAS f32x4*)(buf + (lo1[i_] >= 0 ? (bo_) + lo1[i_] : DUMMY + 16)) = c1_; } while (0)
    LAS float* obuf = (LAS float*)(buf + DUMMY + 64); float* obg = OB + (size_t)m0 * 2048 + h * 64;
    v4u pre[NPC], prf[NPC];
    __syncthreads();
#pragma unroll
    for (int i = 0; i < NPC; ++i) pre[i] = *(const v4u*)(gsrc + goff[i]);
#pragma unroll
    for (int i = 0; i < NPC; ++i) RW_PUT(0, i);
    { const unsigned char* g1 = gsrc + (nblk > 1 ? bstep : 0);
#pragma unroll
      for (int i = 0; i < NPC; ++i) prf[i] = *(const v4u*)(g1 + goff[i]); }
    WG_BAR();
#define RW_LD(dst, rec_) do { const LAS unsigned char* r_ = (rec_); dst[0] = *(const LAS f32x4*)(r_); dst[1] = *(const LAS f32x4*)(r_ + 16); dst[2] = *(const LAS f32x4*)(r_ + 256); dst[3] = *(const LAS f32x4*)(r_ + 272); \
            dst[4] = *(const LAS f32x4*)(r_ + 512); dst[5] = *(const LAS f32x4*)(r_ + 528); dst[6] = *(const LAS f32x4*)(r_ + 768); dst[7] = *(const LAS f32x4*)(r_ + 784); dst[8] = *(const LAS f32x4*)(r_ + 1024); dst[9] = *(const LAS f32x4*)(r_ + 1040); } while (0)
    auto do_block = [&](int blk, v4u (&ld)[NPC], v4u (&use)[NPC]) {
        { const int b2 = blk + 2 < nblk ? blk + 2 : nblk - 1; const unsigned char* g2 = gsrc + (size_t)b2 * bstep;
#pragma unroll
          for (int i = 0; i < NPC; ++i) ld[i] = *(const v4u*)(g2 + goff[i]); }
        f32x4 na = {0.f, 0.f, 0.f, 0.f}, nb = na;
        if (HEADS) { const float* sn = S0 + (size_t)(blk + 1 < nblk ? blk + 1 : blk) * 4096 + v * 64 + 8 * j; na = *(const f32x4*)sn; nb = *(const f32x4*)(sn + 4); }
        const LAS unsigned char* cb = buf + (blk & 1) * (TB * RB) + 32 * j;
        f32x4 X[10], Y[10]; unsigned xv, yv;
        RW_LD(X, cb); xv = *(const LAS bf16*)(cb - 32 * j + 1280 + 2 * v);
#pragma unroll 2
        for (int s = 0; s < nst; ++s) {
            const LAS unsigned char* rn = cb + (s + 1 < nst ? s + 1 : s) * RB;
            yv = *(const LAS bf16*)(rn - 32 * j + 1280 + 2 * v); RW_LD(Y, rn);
            const float vv = bf2f(xv);
            const f32x2 W[4] = {{X[0].x, X[0].y}, {X[0].z, X[0].w}, {X[1].x, X[1].y}, {X[1].z, X[1].w}}, R[4] = {{X[2].x, X[2].y}, {X[2].z, X[2].w}, {X[3].x, X[3].y}, {X[3].z, X[3].w}}, K[4] = {{X[4].x, X[4].y}, {X[4].z, X[4].w}, {X[5].x, X[5].y}, {X[5].z, X[5].w}},
                        N[4] = {{X[6].x, X[6].y}, {X[6].z, X[6].w}, {X[7].x, X[7].y}, {X[7].z, X[7].w}}, A[4] = {{X[8].x, X[8].y}, {X[8].z, X[8].w}, {X[9].x, X[9].y}, {X[9].z, X[9].w}};
            f32x2 p = (S[0] * N[0] + S[1] * N[1]) + (S[2] * N[2] + S[3] * N[3]);
            const float sa = sum8(p.x + p.y);
            const f32x2 sa2 = {sa, sa}, vv2 = {vv, vv};
#pragma unroll
            for (int i = 0; i < 4; ++i) S[i] = S[i] * W[i] + sa2 * A[i] + vv2 * K[i];
            f32x2 q = (S[0] * R[0] + S[1] * R[1]) + (S[2] * R[2] + S[3] * R[3]);
            const float o = sum8(q.x + q.y);
            obuf[(blk & 1) * (TB * 64) + s * 64 + v] = o;
#pragma unroll
            for (int i = 0; i < 10; ++i) X[i] = Y[i];
            xv = yv;
        }
        if (HEADS) { float* so = Sout + (size_t)blk * 4096 + v * 64 + 8 * j; *(f32x4*)so = (f32x4){S[0].x, S[0].y, S[1].x, S[1].y}; *(f32x4*)(so + 4) = (f32x4){S[2].x, S[2].y, S[3].x, S[3].y};
            S[0] = (f32x2){na.x, na.y}; S[1] = (f32x2){na.z, na.w}; S[2] = (f32x2){nb.x, nb.y}; S[3] = (f32x2){nb.z, nb.w}; }
        { const int nbo = ((blk + 1) & 1) * (TB * RB);
#pragma unroll
          for (int i = 0; i < NPC; ++i) asm volatile("" : "+v"(use[i]));
#pragma unroll
          for (int i = 0; i < NPC; ++i) { pre[i] = use[i]; RW_PUT(nbo, i); } }
        WG_BAR();
        if (tid < nst * 16) { const int s = tid >> 4, c4 = (tid & 15) * 4; *(f32x4*)(obg + (HEADS ? (size_t)s * 2048 + blk * 64 : (size_t)(blk * nst + s) * 2048) + c4) = *(const LAS f32x4*)(obuf + (blk & 1) * (TB * 64) + s * 64 + c4); }
    };
    v4u prg[NPC];
    for (int blk = 0; blk < nblk; blk += 2) {
        do_block(blk, prg, prf);
        if (blk + 1 < nblk) do_block(blk + 1, prf, prg);
    }
#undef RW_LD
    if (!HEADS) { f32x4 a = {S[0].x, S[0].y, S[1].x, S[1].y}, b = {S[2].x, S[2].y, S[3].x, S[3].y};
        *(f32x4*)(Sout + v * 64 + 8 * j) = a; *(f32x4*)(Sout + v * 64 + 8 * j + 4) = b; }
#undef RW_PUT
}

typedef short bf16x8v __attribute__((ext_vector_type(8)));
constexpr int RW_C = 16, RW_NCH = SEQ / RW_C, RW_A1 = 7168, RW_A2 = 6656, RW_LSTR = 72;
__device__ __forceinline__ void rwkv_prep_unit(LAS unsigned char* wl, int lane, const unsigned char* scan, int m_base, int h, unsigned char* a1, unsigned char* a2) {
    LAS bf16* rowA = (LAS bf16*)wl; LAS bf16* rowR = rowA + 16 * RW_LSTR; LAS bf16* rowB = rowR + 16 * RW_LSTR; LAS bf16* rowK = rowB + 16 * RW_LSTR; LAS float* Ns = (LAS float*)(wl + 9216);
    const int key = lane, r16 = lane & 15, q = lane >> 4;
    const unsigned char* rec0 = scan + ((size_t)m_base * 32 + h) * SCAN_REC;
    float wv[16]; unsigned rr[16], kx[16], nn[16], aa[16], vx[16];
#pragma unroll
    for (int t = 0; t < 16; ++t) { const unsigned char* rec = rec0 + (size_t)t * 32 * SCAN_REC; wv[t] = *(const float*)(rec + 4 * key); rr[t] = *(const bf16*)(rec + 256 + 2 * key); kx[t] = *(const bf16*)(rec + 384 + 2 * key);
        nn[t] = *(const bf16*)(rec + 512 + 2 * key); aa[t] = *(const bf16*)(rec + 640 + 2 * key); vx[t] = *(const bf16*)(rec + 768 + 2 * key); }
    float cum[16]; float run = 0.f;
#pragma unroll
    for (int t = 0; t < 16; ++t) { const float cprev = run; run += __builtin_amdgcn_logf(wv[t]); cum[t] = run;
        const float g = __builtin_amdgcn_exp2f(run), gi = __builtin_amdgcn_exp2f(-run), gp = __builtin_amdgcn_exp2f(cprev);
        const unsigned ar = pk2(bf2f(nn[t]) * gp, bf2f(rr[t]) * g), bk = pk2(bf2f(aa[t]) * gi, bf2f(kx[t]) * gi);
        rowA[t * RW_LSTR + key] = (bf16)ar; rowR[t * RW_LSTR + key] = (bf16)(ar >> 16); rowB[t * RW_LSTR + key] = (bf16)bk; rowK[t * RW_LSTR + key] = (bf16)(bk >> 16); }
    {
        unsigned bgp[8], kgp[8], vp[8];
#pragma unroll
        for (int j = 0; j < 8; ++j) { const float e0 = __builtin_amdgcn_exp2f(run - cum[2 * j]), e1 = __builtin_amdgcn_exp2f(run - cum[2 * j + 1]);
            bgp[j] = pk2(bf2f(aa[2 * j]) * e0, bf2f(aa[2 * j + 1]) * e1); kgp[j] = pk2(bf2f(kx[2 * j]) * e0, bf2f(kx[2 * j + 1]) * e1); vp[j] = vx[2 * j] | (vx[2 * j + 1] << 16); }
        unsigned char* sb = a2 + (key >> 4) * 1024 + (key & 15) * 16;
#pragma unroll
        for (int kq = 0; kq < 4; ++kq) { v4u o; o.x = bgp[2 * kq]; o.y = bgp[2 * kq + 1]; o.z = kgp[2 * kq]; o.w = kgp[2 * kq + 1]; *(v4u*)(sb + kq * 256) = o; }
        *(float*)(a2 + 4096 + 4 * key) = __builtin_amdgcn_exp2f(run);
        v4u o0, o1; o0.x = vp[0]; o0.y = vp[1]; o0.z = vp[2]; o0.w = vp[3]; o1.x = vp[4]; o1.y = vp[5]; o1.z = vp[6]; o1.w = vp[7];
        *(v4u*)(a2 + 4352 + key * 32) = o0; *(v4u*)(a2 + 4352 + key * 32 + 16) = o1; }
    LDS_WAIT(); asm volatile("" ::: "memory");
    f32x4 nab = {0.f, 0.f, 0.f, 0.f}, mbr = nab, nak = nab, mkr = nab;
#pragma unroll
    for (int m = 0; m < 2; ++m) { const int o = r16 * RW_LSTR + 32 * m + 8 * q;
        const bf16x8v fb = *(const LAS bf16x8v*)(rowB + o), fk = *(const LAS bf16x8v*)(rowK + o), fa = *(const LAS bf16x8v*)(rowA + o), fr = *(const LAS bf16x8v*)(rowR + o);
        nab = __builtin_amdgcn_mfma_f32_16x16x32_bf16(fb, fa, nab, 0, 0, 0); mbr = __builtin_amdgcn_mfma_f32_16x16x32_bf16(fb, fr, mbr, 0, 0, 0);
        nak = __builtin_amdgcn_mfma_f32_16x16x32_bf16(fk, fa, nak, 0, 0, 0); mkr = __builtin_amdgcn_mfma_f32_16x16x32_bf16(fk, fr, mkr, 0, 0, 0); }
    {   const int t = r16, s0 = 4 * q; v4u fn, fm;
        fn.x = 0u; fn.y = 0u; fn.z = pk2(s0 < t ? nak[0] : 0.f, s0 + 1 < t ? nak[1] : 0.f); fn.w = pk2(s0 + 2 < t ? nak[2] : 0.f, s0 + 3 < t ? nak[3] : 0.f);
        fm.x = pk2(s0 <= t ? mbr[0] : 0.f, s0 + 1 <= t ? mbr[1] : 0.f); fm.y = pk2(s0 + 2 <= t ? mbr[2] : 0.f, s0 + 3 <= t ? mbr[3] : 0.f);
        fm.z = pk2(s0 <= t ? mkr[0] : 0.f, s0 + 1 <= t ? mkr[1] : 0.f); fm.w = pk2(s0 + 2 <= t ? mkr[2] : 0.f, s0 + 3 <= t ? mkr[3] : 0.f);
        *(v4u*)(a1 + 4096 + lane * 16) = fn; *(v4u*)(a1 + 6144 + lane * 16) = fm;
#pragma unroll
        for (int i = 0; i < 4; ++i) Ns[(s0 + i) * 16 + t] = (s0 + i < t) ? nab[i] : 0.f; }
#pragma unroll
    for (int m = 0; m < 2; ++m) { const int o = r16 * RW_LSTR + 32 * m + 4 * q;
        const v2u alo = *(const LAS v2u*)(rowA + o), ahi = *(const LAS v2u*)(rowA + o + 16), rlo = *(const LAS v2u*)(rowR + o), rhi = *(const LAS v2u*)(rowR + o + 16);
        v4u fa, fr; fa.x = alo.x; fa.y = alo.y; fa.z = ahi.x; fa.w = ahi.y; fr.x = rlo.x; fr.y = rlo.y; fr.z = rhi.x; fr.w = rhi.y;
        *(v4u*)(a1 + m * 1024 + lane * 16) = fa; *(v4u*)(a1 + 2048 + m * 1024 + lane * 16) = fr; }
    LDS_WAIT(); asm volatile("" ::: "memory");
    float x[16];
#pragma unroll
    for (int s_ = 15; s_ >= 0; --s_) { float acc = (s_ == r16) ? 1.f : 0.f;
        const f32x4 n0 = *(const LAS f32x4*)(Ns + s_ * 16), n1 = *(const LAS f32x4*)(Ns + s_ * 16 + 4), n2 = *(const LAS f32x4*)(Ns + s_ * 16 + 8), n3 = *(const LAS f32x4*)(Ns + s_ * 16 + 12);
        const float nr[16] = {n0.x, n0.y, n0.z, n0.w, n1.x, n1.y, n1.z, n1.w, n2.x, n2.y, n2.z, n2.w, n3.x, n3.y, n3.z, n3.w};
#pragma unroll
        for (int sp = s_ + 1; sp < 16; ++sp) acc += nr[sp] * x[sp];
        x[s_] = acc; }
    {   const float x0 = q == 0 ? x[0] : q == 1 ? x[4] : q == 2 ? x[8] : x[12], x1 = q == 0 ? x[1] : q == 1 ? x[5] : q == 2 ? x[9] : x[13];
        const float x2 = q == 0 ? x[2] : q == 1 ? x[6] : q == 2 ? x[10] : x[14], x3 = q == 0 ? x[3] : q == 1 ? x[7] : q == 2 ? x[11] : x[15];
        v4u fx; fx.x = pk2(x0, x1); fx.y = pk2(x2, x3); fx.z = 0u; fx.w = 0u; *(v4u*)(a1 + 5120 + lane * 16) = fx; }
    LDS_WAIT(); asm volatile("" ::: "memory");
}
struct RwSet { v4u fa0, fa1, fr0, fr1, fn, fx, fm, fs0, fs1, fs2, fs3; f32x4 g0, g1, g2, g3; v2u vt; };
__device__ __forceinline__ void rw_load(RwSet& S, const unsigned char* arr1, const unsigned char* arr2, size_t uc, int lane, int ws) {
    const unsigned char* p1 = arr1 + uc * RW_A1 + lane * 16; const unsigned char* p2 = arr2 + uc * RW_A2; const int r16 = lane & 15, q = lane >> 4;
    S.fa0 = *(const v4u*)p1; S.fa1 = *(const v4u*)(p1 + 1024); S.fr0 = *(const v4u*)(p1 + 2048); S.fr1 = *(const v4u*)(p1 + 3072); S.fn = *(const v4u*)(p1 + 4096); S.fx = *(const v4u*)(p1 + 5120); S.fm = *(const v4u*)(p1 + 6144);
    S.fs0 = *(const v4u*)(p2 + lane * 16); S.fs1 = *(const v4u*)(p2 + 1024 + lane * 16); S.fs2 = *(const v4u*)(p2 + 2048 + lane * 16); S.fs3 = *(const v4u*)(p2 + 3072 + lane * 16);
    const unsigned char* gp = p2 + 4096 + 16 * q; S.g0 = *(const f32x4*)gp; S.g1 = *(const f32x4*)(gp + 64); S.g2 = *(const f32x4*)(gp + 128); S.g3 = *(const f32x4*)(gp + 192);
    S.vt = *(const v2u*)(p2 + 4352 + (16 * ws + r16) * 32 + 8 * q);
}
__device__ __forceinline__ bf16x8v rw_bc(unsigned a, unsigned b, unsigned c, unsigned d) { v4u t; t.x = a; t.y = b; t.z = c; t.w = d; return __builtin_bit_cast(bf16x8v, t); }
typedef __bf16 rw_bf2 __attribute__((ext_vector_type(2)));
__device__ __forceinline__ unsigned cvt_pk_bf16(float lo, float hi) { const pg8::f32x2 v = {lo, hi}; return __builtin_bit_cast(unsigned, __builtin_convertvector(v, rw_bf2)); }
__device__ __forceinline__ void rw_step(const RwSet& S, f32x4 (&H)[4], float* ob) {
    const bf16x8v hb0 = rw_bc(cvt_pk_bf16(H[0][0], H[0][1]), cvt_pk_bf16(H[0][2], H[0][3]), cvt_pk_bf16(H[1][0], H[1][1]), cvt_pk_bf16(H[1][2], H[1][3]));
    const bf16x8v hb1 = rw_bc(cvt_pk_bf16(H[2][0], H[2][1]), cvt_pk_bf16(H[2][2], H[2][3]), cvt_pk_bf16(H[3][0], H[3][1]), cvt_pk_bf16(H[3][2], H[3][3]));
    const f32x4 z = {0.f, 0.f, 0.f, 0.f};
    f32x4 Y = __builtin_amdgcn_mfma_f32_16x16x32_bf16(__builtin_bit_cast(bf16x8v, S.fa0), hb0, z, 0, 0, 0);
    Y = __builtin_amdgcn_mfma_f32_16x16x32_bf16(__builtin_bit_cast(bf16x8v, S.fa1), hb1, Y, 0, 0, 0);
    Y = __builtin_amdgcn_mfma_f32_16x16x32_bf16(__builtin_bit_cast(bf16x8v, S.fn), rw_bc(0u, 0u, S.vt.x, S.vt.y), Y, 0, 0, 0);
    const f32x4 U = __builtin_amdgcn_mfma_f32_16x16x32_bf16(__builtin_bit_cast(bf16x8v, S.fx), rw_bc(cvt_pk_bf16(Y[0], Y[1]), cvt_pk_bf16(Y[2], Y[3]), 0u, 0u), z, 0, 0, 0);
    const bf16x8v ub = rw_bc(cvt_pk_bf16(U[0], U[1]), cvt_pk_bf16(U[2], U[3]), S.vt.x, S.vt.y);
    f32x4 O = __builtin_amdgcn_mfma_f32_16x16x32_bf16(__builtin_bit_cast(bf16x8v, S.fr0), hb0, z, 0, 0, 0);
    O = __builtin_amdgcn_mfma_f32_16x16x32_bf16(__builtin_bit_cast(bf16x8v, S.fr1), hb1, O, 0, 0, 0);
    O = __builtin_amdgcn_mfma_f32_16x16x32_bf16(__builtin_bit_cast(bf16x8v, S.fm), ub, O, 0, 0, 0);
    H[0] = __builtin_amdgcn_mfma_f32_16x16x32_bf16(__builtin_bit_cast(bf16x8v, S.fs0), ub, H[0] * S.g0, 0, 0, 0);
    H[1] = __builtin_amdgcn_mfma_f32_16x16x32_bf16(__builtin_bit_cast(bf16x8v, S.fs1), ub, H[1] * S.g1, 0, 0, 0);
    H[2] = __builtin_amdgcn_mfma_f32_16x16x32_bf16(__builtin_bit_cast(bf16x8v, S.fs2), ub, H[2] * S.g2, 0, 0, 0);
    H[3] = __builtin_amdgcn_mfma_f32_16x16x32_bf16(__builtin_bit_cast(bf16x8v, S.fs3), ub, H[3] * S.g3, 0, 0, 0);
    ob[0] = O[0]; ob[2048] = O[1]; ob[4096] = O[2]; ob[6144] = O[3];
}
__device__ __forceinline__ void rwkv_chunk_scan(int lane, int ws, const unsigned char* arr1, const unsigned char* arr2, int bh, float* Sout, float* OB) {
    const int r16 = lane & 15, q = lane >> 4, b = bh >> 5, h = bh & 31;
    f32x4 H[4];
#pragma unroll
    for (int i = 0; i < 4; ++i) H[i] = (f32x4){0.f, 0.f, 0.f, 0.f};
    const size_t uc0 = (size_t)bh * RW_NCH;
    float* ob = OB + (size_t)(b * SEQ + 4 * q) * 2048 + h * 64 + 16 * ws + r16;
    RwSet A, B, C; rw_load(A, arr1, arr2, uc0, lane, ws); rw_load(B, arr1, arr2, uc0 + 1, lane, ws);
    static_assert(RW_NCH % 3 == 2, "loop below: groups of three chunks, then two");
    for (int c = 0; c < RW_NCH - 2; c += 3) {
        rw_load(C, arr1, arr2, uc0 + c + 2, lane, ws);
        rw_step(A, H, ob + (size_t)c * 16 * 2048);
        rw_load(A, arr1, arr2, uc0 + c + 3, lane, ws);
        rw_step(B, H, ob + (size_t)(c + 1) * 16 * 2048);
        rw_load(B, arr1, arr2, uc0 + c + 4, lane, ws);
        rw_step(C, H, ob + (size_t)(c + 2) * 16 * 2048);
    }
    rw_step(A, H, ob + (size_t)(RW_NCH - 2) * 16 * 2048);
    rw_step(B, H, ob + (size_t)(RW_NCH - 1) * 16 * 2048);
#pragma unroll
    for (int kt = 0; kt < 4; ++kt) *(f32x4*)(Sout + (16 * ws + r16) * 64 + 16 * kt + 4 * q) = H[kt];
}

constexpr int RWL_PAIR = 13824, RWL_SLOT = 2 * RWL_PAIR, RWL_DUM = 4 * RWL_SLOT;
__device__ __forceinline__ void rwkv_chunk_scan_lds(Frame& F, const unsigned char* arr1, const unsigned char* arr2, int bh0, float* SoutBase, float* OB) {
    const int lane = F.lane, w = F.wave, ws = w & 3, pr = w >> 2, bh = bh0 + pr, r16 = lane & 15, q = lane >> 4, b = bh >> 5, h = bh & 31;
    LAS unsigned char* L = F.lds;
    f32x4 H[4];
#pragma unroll
    for (int i = 0; i < 4; ++i) H[i] = (f32x4){0.f, 0.f, 0.f, 0.f};
    const size_t uc0 = (size_t)bh * RW_NCH;
    float* ob = OB + (size_t)(b * SEQ + 4 * q) * 2048 + h * 64 + 16 * ws + r16;
    const unsigned char* gsrc[4]; int ldst[4];
#pragma unroll
    for (int i = 0; i < 4; ++i) { const int p = ws + 4 * i;
        if (p < 7) { gsrc[i] = arr1 + uc0 * RW_A1 + p * 1024 + lane * 16; ldst[i] = pr * RWL_PAIR + p * 1024; }
        else if (p < 11) { gsrc[i] = arr2 + uc0 * RW_A2 + (p - 7) * 1024 + lane * 16; ldst[i] = pr * RWL_PAIR + p * 1024; }
        else if (p < 13) { gsrc[i] = arr2 + uc0 * RW_A2 + 4352 + (p - 11) * 1024 + lane * 16; ldst[i] = pr * RWL_PAIR + 11520 + (p - 11) * 1024; }
        else if (p == 13) { gsrc[i] = arr2 + uc0 * RW_A2 + 4096 + lane * 4; ldst[i] = pr * RWL_PAIR + 11264; }
        else { gsrc[i] = arr1 + uc0 * RW_A1 + lane * 16; ldst[i] = RWL_DUM; } }
    const bool gc4 = ws == 1;
#define RWL_ISSUE(cc) do { const int c_ = (cc) < RW_NCH ? (cc) : RW_NCH - 1; const int so_ = ((cc) & 3) * RWL_SLOT; \
        _Pragma("unroll") for (int i = 0; i < 3; ++i) { const size_t st_ = (size_t)c_ * ((ws + 4 * i) < 7 ? RW_A1 : RW_A2); \
            __builtin_amdgcn_global_load_lds((const unsigned*)(gsrc[i] + st_), (LAS unsigned*)(L + (ldst[i] == RWL_DUM ? RWL_DUM : so_ + ldst[i])), 16, 0, 0); } \
        { const size_t st_ = (size_t)c_ * ((ws + 12) < 14 ? RW_A2 : RW_A1); \
          if (gc4) __builtin_amdgcn_global_load_lds((const unsigned*)(gsrc[3] + st_), (LAS unsigned*)(L + so_ + ldst[3]), 4, 0, 0); \
          else __builtin_amdgcn_global_load_lds((const unsigned*)(gsrc[3] + st_), (LAS unsigned*)(L + (ldst[3] == RWL_DUM ? RWL_DUM : so_ + ldst[3])), 16, 0, 0); } } while (0)
    __syncthreads();
    RWL_ISSUE(0); RWL_ISSUE(1); RWL_ISSUE(2);
#pragma unroll 1
    for (int c = 0; c < RW_NCH; ++c) {
        if (c < 3) asm volatile("s_waitcnt vmcnt(8)" ::: "memory"); else asm volatile("s_waitcnt vmcnt(20)" ::: "memory");
        __builtin_amdgcn_s_barrier(); asm volatile("" ::: "memory");
        RWL_ISSUE(c + 3);
        const LAS unsigned char* S_ = L + (c & 3) * RWL_SLOT + pr * RWL_PAIR;
        RwSet A;
        A.fa0 = *(const LAS v4u*)(S_ + lane * 16); A.fa1 = *(const LAS v4u*)(S_ + 1024 + lane * 16); A.fr0 = *(const LAS v4u*)(S_ + 2048 + lane * 16); A.fr1 = *(const LAS v4u*)(S_ + 3072 + lane * 16);
        A.fn = *(const LAS v4u*)(S_ + 4096 + lane * 16); A.fx = *(const LAS v4u*)(S_ + 5120 + lane * 16); A.fm = *(const LAS v4u*)(S_ + 6144 + lane * 16);
        A.fs0 = *(const LAS v4u*)(S_ + 7168 + lane * 16); A.fs1 = *(const LAS v4u*)(S_ + 8192 + lane * 16); A.fs2 = *(const LAS v4u*)(S_ + 9216 + lane * 16); A.fs3 = *(const LAS v4u*)(S_ + 10240 + lane * 16);
        A.g0 = *(const LAS f32x4*)(S_ + 11264 + 16 * q); A.g1 = *(const LAS f32x4*)(S_ + 11264 + 64 + 16 * q); A.g2 = *(const LAS f32x4*)(S_ + 11264 + 128 + 16 * q); A.g3 = *(const LAS f32x4*)(S_ + 11264 + 192 + 16 * q);
        A.vt = *(const LAS v2u*)(S_ + 11520 + (16 * ws + r16) * 32 + 8 * q);
        asm volatile("s_waitcnt lgkmcnt(0)" ::: "memory");
        rw_step(A, H, ob + (size_t)c * 16 * 2048);
    }
#undef RWL_ISSUE
    asm volatile("s_waitcnt vmcnt(0)" ::: "memory"); __builtin_amdgcn_s_barrier();
    float* Sout = SoutBase + (size_t)bh * 4096;
#pragma unroll
    for (int kt = 0; kt < 4; ++kt) *(f32x4*)(Sout + (16 * ws + r16) * 64 + 16 * kt + 4 * q) = H[kt];
}

__device__ __forceinline__ bf16x8v ldfrag(const bf16* p) { return *(const bf16x8v*)p; }
__device__ __forceinline__ void gla_prep_unit(Frame& F, const bf16* proj, const bf16* L1, const float* b_alpha, bf16* QD, bf16* KDDT, bf16* VT, bf16* ATT, float* EB, int ci, int h) {
    constexpr int LS = 264, VLS = 520;
    LAS bf16* qd_s = (LAS bf16*)F.lds; LAS bf16* kd_s = qd_s + 64 * LS; LAS bf16* kdd_s = kd_s + 64 * LS; LAS float* tot = (LAS float*)(kdd_s + 64 * LS);
    LAS bf16* v_s = (LAS bf16*)F.lds;
    int tid_ = F.tid; asm volatile("" : "+v"(tid_));
    const int tid = tid_, lane = tid & 63, w = F.wave, dg = tid & 31, ts = tid >> 5, m0 = (ci >> 5) * SEQ + (ci & 31) * 64, u = ci * 4 + h;
    v4u l1v[4], qv[4], kv[4], vv[8];
#pragma unroll
    for (int i = 0; i < 4; ++i) { const size_t m = (size_t)(m0 + 4 * ts + i); l1v[i] = *(const v4u*)(L1 + m * NL1 + h * 256 + 8 * dg);
        qv[i] = *(const v4u*)(proj + m * NPROJ + CQ + h * 256 + 8 * dg); kv[i] = *(const v4u*)(proj + m * NPROJ + CK + h * 256 + 8 * dg); }
    float ba[8]; { const f32x4 b0 = *(const f32x4*)(b_alpha + h * 256 + 8 * dg), b1 = *(const f32x4*)(b_alpha + h * 256 + 8 * dg + 4); ba[0] = b0.x; ba[1] = b0.y; ba[2] = b0.z; ba[3] = b0.w; ba[4] = b1.x; ba[5] = b1.y; ba[6] = b1.z; ba[7] = b1.w; }
    __syncthreads();
    float bt[4][8];
    { float run[8];
#pragma unroll
      for (int e = 0; e < 8; ++e) run[e] = 0.f;
#pragma unroll
      for (int i = 0; i < 4; ++i) { const unsigned xw[4] = {l1v[i].x, l1v[i].y, l1v[i].z, l1v[i].w};
#pragma unroll
          for (int e = 0; e < 8; ++e) { const float x = ((e & 1) ? bfhi(xw[e >> 1]) : bflo(xw[e >> 1])) + ba[e]; run[e] += -(fmaxf(-x, 0.f) + __logf(1.0f + __expf(-fabsf(x)))) * 0.0625f; bt[i][e] = run[e]; }
          __builtin_amdgcn_sched_barrier(0); }
      *(LAS f32x4*)(tot + ts * 256 + 8 * dg) = (f32x4){run[0], run[1], run[2], run[3]}; *(LAS f32x4*)(tot + ts * 256 + 8 * dg + 4) = (f32x4){run[4], run[5], run[6], run[7]}; }
    WG_BAR();
    float off[8], be[8];
#pragma unroll
    for (int e = 0; e < 8; ++e) { off[e] = 0.f; be[e] = 0.f; }
#pragma unroll
    for (int s = 0; s < 16; ++s) { const f32x4 a = *(const LAS f32x4*)(tot + s * 256 + 8 * dg), b = *(const LAS f32x4*)(tot + s * 256 + 8 * dg + 4); const float t8[8] = {a.x, a.y, a.z, a.w, b.x, b.y, b.z, b.w}; const bool pre = s < ts;
#pragma unroll
        for (int e = 0; e < 8; ++e) { be[e] += t8[e]; off[e] += pre ? t8[e] : 0.f; } }
    if (ts == 0) { *(f32x4*)(EB + (size_t)u * 256 + 8 * dg) = (f32x4){__expf(be[0]), __expf(be[1]), __expf(be[2]), __expf(be[3])}; *(f32x4*)(EB + (size_t)u * 256 + 8 * dg + 4) = (f32x4){__expf(be[4]), __expf(be[5]), __expf(be[6]), __expf(be[7])}; }
#pragma unroll
    for (int i = 0; i < 4; ++i) { const int t = 4 * ts + i; const unsigned qw[4] = {qv[i].x, qv[i].y, qv[i].z, qv[i].w}, kw[4] = {kv[i].x, kv[i].y, kv[i].z, kv[i].w};
        float qd[8], kd[8], kdd[8];
#pragma unroll
        for (int e = 0; e < 8; ++e) { const float b = bt[i][e] + off[e], q = (e & 1) ? bfhi(qw[e >> 1]) : bflo(qw[e >> 1]), k = (e & 1) ? bfhi(kw[e >> 1]) : bflo(kw[e >> 1]);
            qd[e] = q * 0.0625f * __expf(b); kd[e] = k * __expf(-b); kdd[e] = k * __expf(be[e] - b); }
        v4u oq, ok, okk; oq.x = pk2(qd[0], qd[1]); oq.y = pk2(qd[2], qd[3]); oq.z = pk2(qd[4], qd[5]); oq.w = pk2(qd[6], qd[7]);
        ok.x = pk2(kd[0], kd[1]); ok.y = pk2(kd[2], kd[3]); ok.z = pk2(kd[4], kd[5]); ok.w = pk2(kd[6], kd[7]);
        okk.x = pk2(kdd[0], kdd[1]); okk.y = pk2(kdd[2], kdd[3]); okk.z = pk2(kdd[4], kdd[5]); okk.w = pk2(kdd[6], kdd[7]);
        *(v4u*)(QD + (size_t)(m0 + t) * 1024 + h * 256 + 8 * dg) = oq;
        *(LAS v4u*)(qd_s + t * LS + 8 * dg) = oq; *(LAS v4u*)(kd_s + t * LS + 8 * dg) = ok; *(LAS v4u*)(kdd_s + t * LS + 8 * dg) = okk;
        __builtin_amdgcn_sched_barrier(0); }
    WG_BAR();
#pragma unroll
    for (int i = 0; i < 8; ++i) { const int p = tid + 512 * i; vv[i] = *(const v4u*)(proj + (size_t)(m0 + (p >> 6)) * NPROJ + CV + h * 512 + 8 * (p & 63)); }
    {
        const int d = tid & 255, half = tid >> 8; unsigned kp[16];
#pragma unroll
        for (int i = 0; i < 32; ++i) { const unsigned x = kdd_s[(32 * half + i) * LS + d]; if (i & 1) kp[i >> 1] |= x << 16; else kp[i >> 1] = x; }
        v4u* kd4 = (v4u*)(KDDT + ((size_t)u * 256 + d) * 64 + 32 * half);
#pragma unroll
        for (int i = 0; i < 4; ++i) { v4u o; o.x = kp[4 * i]; o.y = kp[4 * i + 1]; o.z = kp[4 * i + 2]; o.w = kp[4 * i + 3]; kd4[i] = o; } }
    {
        const int tt = w >> 1, r = lane & 15, q = lane >> 4;
#pragma unroll
        for (int si = 0; si < 2; ++si) { const int st = 2 * (w & 1) + si; f32x4 acc = {0.f, 0.f, 0.f, 0.f};
            if (st <= tt) {
#pragma unroll
                for (int ks = 0; ks < 8; ++ks) { const bf16x8v a = *(const LAS bf16x8v*)(kd_s + (16 * st + r) * LS + ks * 32 + 8 * q), b = *(const LAS bf16x8v*)(qd_s + (16 * tt + r) * LS + ks * 32 + 8 * q);
                    acc = __builtin_amdgcn_mfma_f32_16x16x32_bf16(a, b, acc, 0, 0, 0); }
            }
            const int t = 16 * tt + r, s0 = 16 * st + 4 * q; v2u o;
            o.x = pk2(t >= s0 ? acc[0] : 0.f, t >= s0 + 1 ? acc[1] : 0.f); o.y = pk2(t >= s0 + 2 ? acc[2] : 0.f, t >= s0 + 3 ? acc[3] : 0.f);
            *(v2u*)(ATT + ((size_t)u * 64 + t) * 64 + s0) = o; }
    }
    WG_BAR();
#pragma unroll
    for (int i = 0; i < 8; ++i) { const int p = tid + 512 * i; *(LAS v4u*)(v_s + (p >> 6) * VLS + 8 * (p & 63)) = vv[i]; }
    WG_BAR();
    {
        unsigned vp[32];
#pragma unroll
        for (int t = 0; t < 64; ++t) { const unsigned x = v_s[t * VLS + tid]; if (t & 1) vp[t >> 1] |= x << 16; else vp[t >> 1] = x; }
        v4u* v4 = (v4u*)(VT + ((size_t)u * 512 + tid) * 64);
#pragma unroll
        for (int i = 0; i < 8; ++i) { v4u o; o.x = vp[4 * i]; o.y = vp[4 * i + 1]; o.z = vp[4 * i + 2]; o.w = vp[4 * i + 3]; v4[i] = o; }
    }
}
__device__ __forceinline__ void gla_prompt_unit(Frame& F, const bf16* QD, const bf16* KDDT, const bf16* VT, const bf16* ATT, const float* EB, float* OA, float* gla_p, int b, int h, int vs) {
    constexpr int LS = 264, PS = 72;
    constexpr int O_QD = 64 * LS * 2, O_KD = O_QD + 64 * LS * 2, O_VT = O_KD + 256 * PS * 2, O_AT = O_VT + 64 * PS * 2, O_EB = O_AT + 64 * PS * 2, O_DUM = O_EB + 1024;
    LAS unsigned char* L = F.lds; LAS bf16* ST = (LAS bf16*)L;
    const int tid = F.tid, lane = F.lane, w = F.wave, r = lane & 15, q = lane >> 4, tt = w >> 1, vt0 = 2 * (w & 1);
    f32x4 Sacc[2][4];
#pragma unroll
    for (int a = 0; a < 2; ++a)
#pragma unroll
        for (int c = 0; c < 4; ++c) Sacc[a][c] = (f32x4){0.f, 0.f, 0.f, 0.f};
    const int gq = ((tid >> 5) * 1024 + (tid & 31) * 8) * 2, lq = O_QD + (tid >> 5) * (LS * 2) + (tid & 31) * 16;
    const int gk = ((tid >> 3) * 64 + (tid & 7) * 8) * 2, lk = (tid >> 3) * (PS * 2) + (tid & 7) * 16;
    const bool ebok = tid < 64; const int ge = ebok ? tid * 16 : 0, le = ebok ? O_EB + tid * 16 : O_DUM;
    const unsigned char* pQD = (const unsigned char*)(QD + (size_t)(b * SEQ) * 1024 + h * 256); const size_t sQD = (size_t)64 * 1024 * 2;
    const size_t u0 = (size_t)(b * 32) * 4 + h;
    const unsigned char* pKD = (const unsigned char*)(KDDT + u0 * 256 * 64); const size_t sKD = (size_t)4 * 256 * 64 * 2;
    const unsigned char* pVT = (const unsigned char*)(VT + (u0 * 512 + vs * 64) * 64); const size_t sVT = (size_t)4 * 512 * 64 * 2;
    const unsigned char* pAT = (const unsigned char*)(ATT + u0 * 64 * 64); const size_t sAT = (size_t)4 * 64 * 64 * 2;
    const unsigned char* pEB = (const unsigned char*)(EB + u0 * 256); const size_t sEB = (size_t)4 * 256 * 4;
#define GP_LOAD(P, cc) do { const size_t c_ = (size_t)((cc) < 32 ? (cc) : 31); \
        _Pragma("unroll") for (int i = 0; i < 4; ++i) P[i] = *(const v4u*)(pQD + c_ * sQD + gq + i * (16 * 1024 * 2)); \
        _Pragma("unroll") for (int i = 0; i < 4; ++i) P[4 + i] = *(const v4u*)(pKD + c_ * sKD + gk + i * (64 * 64 * 2)); \
        P[8] = *(const v4u*)(pVT + c_ * sVT + gk); P[9] = *(const v4u*)(pAT + c_ * sAT + gk); P[10] = *(const v4u*)(pEB + c_ * sEB + ge); } while (0)
#define GP_STAGE(P) do { _Pragma("unroll") for (int i = 0; i < 11; ++i) asm volatile("" : "+v"(P[i])); \
        _Pragma("unroll") for (int i = 0; i < 4; ++i) *(LAS v4u*)(L + lq + i * (16 * LS * 2)) = P[i]; \
        _Pragma("unroll") for (int i = 0; i < 4; ++i) *(LAS v4u*)(L + O_KD + lk + i * (64 * PS * 2)) = P[4 + i]; \
        *(LAS v4u*)(L + O_VT + lk) = P[8]; *(LAS v4u*)(L + O_AT + lk) = P[9]; *(LAS v4u*)(L + le) = P[10]; } while (0)
    v4u PA[11];
    GP_LOAD(PA, 0);
    __syncthreads();
    for (int i = tid; i < 64 * LS / 2; i += NT) ((LAS unsigned*)ST)[i] = 0u;
    GP_STAGE(PA);
    WG_BAR();
    const LAS bf16* QDs = (const LAS bf16*)(L + O_QD); const LAS bf16* KDs = (const LAS bf16*)(L + O_KD); const LAS bf16* VTs = (const LAS bf16*)(L + O_VT); const LAS bf16* ATs = (const LAS bf16*)(L + O_AT);
    const LAS float* EBs = (const LAS float*)(L + O_EB);
    for (int c = 0; c < 32; ++c) {
        GP_LOAD(PA, c + 1);
        const int m0 = b * SEQ + c * 64;
        bf16x8v Bv[4][2], Akd[2][2]; f32x4 ebv[2];
#pragma unroll
        for (int vt = 0; vt < 4; ++vt)
#pragma unroll
            for (int ks = 0; ks < 2; ++ks) Bv[vt][ks] = *(const LAS bf16x8v*)(VTs + (16 * vt + r) * PS + ks * 32 + 8 * q);
#pragma unroll
        for (int dt = 0; dt < 2; ++dt) {
#pragma unroll
            for (int ks = 0; ks < 2; ++ks) Akd[dt][ks] = *(const LAS bf16x8v*)(KDs + (32 * w + 16 * dt + r) * PS + ks * 32 + 8 * q);
            ebv[dt] = *(const LAS f32x4*)(EBs + 32 * w + 16 * dt + 4 * q); }
        bf16x8v Aatt[2], Bo[2][2];
#pragma unroll
        for (int ks = 0; ks < 2; ++ks) { Aatt[ks] = *(const LAS bf16x8v*)(ATs + (16 * tt + r) * PS + ks * 32 + 8 * q);
#pragma unroll
            for (int vi = 0; vi < 2; ++vi) Bo[vi][ks] = *(const LAS bf16x8v*)(VTs + (16 * (vt0 + vi) + r) * PS + ks * 32 + 8 * q); }
        f32x4 oacc[2];
#pragma unroll
        for (int vi = 0; vi < 2; ++vi) { const int vt = vt0 + vi; f32x4 acc = {0.f, 0.f, 0.f, 0.f};
#pragma unroll
            for (int ks = 0; ks < 2; ++ks) acc = __builtin_amdgcn_mfma_f32_16x16x32_bf16(Bo[vi][ks], Aatt[ks], acc, 0, 0, 0);
#pragma unroll
            for (int ks = 0; ks < 8; ++ks) { const bf16x8v sfr = *(const LAS bf16x8v*)(ST + (16 * vt + r) * LS + ks * 32 + 8 * q), aq = *(const LAS bf16x8v*)(QDs + (16 * tt + r) * LS + ks * 32 + 8 * q);
                acc = __builtin_amdgcn_mfma_f32_16x16x32_bf16(sfr, aq, acc, 0, 0, 0); }
            oacc[vi] = acc; }
#pragma unroll
        for (int vi = 0; vi < 2; ++vi) *(f32x4*)(OA + (size_t)(m0 + 16 * tt + r) * 2048 + h * 512 + vs * 64 + 16 * (vt0 + vi) + 4 * q) = oacc[vi];
        WG_BAR();
#pragma unroll
        for (int dt = 0; dt < 2; ++dt)
#pragma unroll
            for (int vt = 0; vt < 4; ++vt) { f32x4 a = Sacc[dt][vt] * ebv[dt];
#pragma unroll
                for (int ks = 0; ks < 2; ++ks) a = __builtin_amdgcn_mfma_f32_16x16x32_bf16(Akd[dt][ks], Bv[vt][ks], a, 0, 0, 0);
                Sacc[dt][vt] = a; v2u o; o.x = pk2(a[0], a[1]); o.y = pk2(a[2], a[3]);
                *(LAS v2u*)(ST + (16 * vt + r) * LS + 32 * w + 16 * dt + 4 * q) = o; }
        GP_STAGE(PA);
        WG_BAR();
    }
#undef GP_LOAD
#undef GP_STAGE
#pragma unroll
    for (int dt = 0; dt < 2; ++dt)
#pragma unroll
        for (int vt = 0; vt < 4; ++vt)
#pragma unroll
            for (int j = 0; j < 4; ++j) gla_p[((size_t)(b * 4 + h) * 256 + 32 * w + 16 * dt + 4 * q + j) * 512 + vs * 64 + 16 * vt + r] = Sacc[dt][vt][j];
}

__device__ __forceinline__ void gla_sample_unit(Frame& F, const bf16* proj, const float* LA, float* OA, const float* S0g, float* Sog, int b, int h) {
    LAS float* qdT = (LAS float*)F.lds; LAS float* kddT = qdT + 2048; LAS float* kd = kddT + 2048; LAS float* eb = kd + 2048; LAS float* att = eb + 256; LAS float* ored = att + 64;
    const int tid = F.tid, lane = F.lane, w = F.wave, m0 = TP + b * DSEQ;
    __syncthreads();
    if (tid < 256) { const int d = tid; float bt[8]; float bc = 0.f;
#pragma unroll
        for (int t = 0; t < 8; ++t) { bc += LA[(size_t)(m0 + t) * 1024 + h * 256 + d]; bt[t] = bc; }
#pragma unroll
        for (int t = 0; t < 8; ++t) { const bf16* pr = proj + (size_t)(m0 + t) * NPROJ + h * 256 + d; const float q = bf2f(pr[CQ]) * 0.0625f, k = bf2f(pr[CK]);
            qdT[d * 8 + t] = q * __expf(bt[t]); kd[t * 256 + d] = k * __expf(-bt[t]); kddT[d * 8 + t] = k * __expf(bc - bt[t]); }
        eb[d] = __expf(bc); }
    __syncthreads();
    {
#pragma unroll
        for (int s = 0; s < 8; ++s) { float p = 0.f;
#pragma unroll
            for (int i = 0; i < 4; ++i) { const int d = lane + 64 * i; p += qdT[d * 8 + w] * kd[s * 256 + d]; }
            p = wave_sum(p); if (lane == 0) att[w * 8 + s] = (s <= w) ? p : 0.f; }
    }
    __syncthreads();
    const int vq = tid & 127, dg = tid >> 7, v0 = 4 * vq;
    f32x4 vv[8], o[8];
#pragma unroll
    for (int t = 0; t < 8; ++t) { const v2u x = *(const v2u*)(proj + (size_t)(m0 + t) * NPROJ + CV + h * 512 + v0); vv[t] = (f32x4){bflo(x.x), bfhi(x.x), bflo(x.y), bfhi(x.y)}; }
#pragma unroll
    for (int t = 0; t < 8; ++t) { f32x4 s = {0.f, 0.f, 0.f, 0.f};
        if (dg == 0) {
#pragma unroll
            for (int uu = 0; uu < 8; ++uu) s += att[t * 8 + uu] * vv[uu]; }
        o[t] = s; }
    const float* S0 = S0g + ((size_t)(b * 4 + h) * 256 + 64 * dg) * 512 + v0; float* So = Sog + ((size_t)(b * 4 + h) * 256 + 64 * dg) * 512 + v0;
    f32x4 s0[8], s1[8];
#pragma unroll
    for (int i = 0; i < 8; ++i) s0[i] = *(const f32x4*)(S0 + (size_t)i * 512);
#pragma unroll 1
    for (int db = 0; db < 64; db += 8) {
        { const int dn = db + 8 < 64 ? db + 8 : db;
#pragma unroll
          for (int i = 0; i < 8; ++i) s1[i] = *(const f32x4*)(S0 + (size_t)(dn + i) * 512); }
#pragma unroll
        for (int i = 0; i < 8; ++i) { const int d = 64 * dg + db + i;
            const f32x4 q0 = *(const LAS f32x4*)(qdT + d * 8), q1 = *(const LAS f32x4*)(qdT + d * 8 + 4), k0 = *(const LAS f32x4*)(kddT + d * 8), k1 = *(const LAS f32x4*)(kddT + d * 8 + 4);
            o[0] += q0.x * s0[i]; o[1] += q0.y * s0[i]; o[2] += q0.z * s0[i]; o[3] += q0.w * s0[i]; o[4] += q1.x * s0[i]; o[5] += q1.y * s0[i]; o[6] += q1.z * s0[i]; o[7] += q1.w * s0[i];
            f32x4 sn = s0[i] * eb[d];
            sn += k0.x * vv[0]; sn += k0.y * vv[1]; sn += k0.z * vv[2]; sn += k0.w * vv[3]; sn += k1.x * vv[4]; sn += k1.y * vv[5]; sn += k1.z * vv[6]; sn += k1.w * vv[7];
            *(f32x4*)(So + (size_t)(db + i) * 512) = sn; }
#pragma unroll
        for (int i = 0; i < 8; ++i) s0[i] = s1[i];
    }
#pragma unroll
    for (int t = 0; t < 8; ++t) *(LAS f32x4*)(ored + (dg * 8 + t) * 512 + v0) = o[t];
    __syncthreads();
#pragma unroll
    for (int i = 0; i < 2; ++i) { const int idx = tid + 512 * i, t = idx >> 7, v4 = (idx & 127) * 4;
        const f32x4 s = (*(const LAS f32x4*)(ored + (0 * 8 + t) * 512 + v4) + *(const LAS f32x4*)(ored + (1 * 8 + t) * 512 + v4)) + (*(const LAS f32x4*)(ored + (2 * 8 + t) * 512 + v4) + *(const LAS f32x4*)(ored + (3 * 8 + t) * 512 + v4));
        *(f32x4*)(OA + (size_t)(m0 + t) * 2048 + h * 512 + v4) = s; }
}

__device__ __forceinline__ float sum16(float x) {
    x += dpp_f(x, 0); x += dpp_f(x, 1); x += dpp_f(x, 2);
    const int v = __builtin_bit_cast(int, x); x += __builtin_bit_cast(float, __builtin_amdgcn_update_dpp(v, v, 0x140, 0xF, 0xF, false));
    return x;
}
__device__ __forceinline__ f32x4 bf4(v2u w) { return (f32x4){bflo(w.x), bfhi(w.x), bflo(w.y), bfhi(w.y)}; }
struct P4In { v2u r, k, v, rp, kp, vp; f32x4 l1d, l1i, la; };
__device__ __forceinline__ P4In p4_load(const bf16* PROJ, const bf16* L1, int it, int lane) {
    const int m = it >> 3, hq = it & 7, c0 = hq * 256 + 4 * lane; const SeqPos sp = seqpos(m); const bf16* pr = PROJ + (size_t)m * NPROJ + c0;
    P4In x; x.r = *(const v2u*)(pr + CR); x.k = *(const v2u*)(pr + CKR); x.v = *(const v2u*)(pr + CVR);
    const bf16* pq = sp.t > 0 ? pr - NPROJ : pr;
    x.rp = *(const v2u*)(pq + CR); x.kp = *(const v2u*)(pq + CKR); x.vp = *(const v2u*)(pq + CVR);
    const bf16* l = L1 + (size_t)m * NL1 + c0; x.l1d = bf4(*(const v2u*)(l + 1024)); x.l1i = bf4(*(const v2u*)(l + 3072)); x.la = bf4(*(const v2u*)(l));
    return x;
}
struct P4Par { f32x4 mur, muk, muv, a0, w0, kk, ka, rk, ba; };
__device__ __forceinline__ void p4_compute(const P4In& x, const P4Par& P, const float* sshift, unsigned char* SCAN, float* BONUS, float* LA, int it, int lane) {
    const int m = it >> 3, hq = it & 7, c0 = hq * 256 + 4 * lane, h = 4 * hq + (lane >> 4), cl = lane & 15; const SeqPos sp = seqpos(m);
    f32x4 rp = bf4(x.rp), kp = bf4(x.kp), vp = bf4(x.vp);
    if (sp.t == 0) { if (sp.prm) { rp = (f32x4){0.f, 0.f, 0.f, 0.f}; kp = rp; vp = rp; }
        else { const float* sh = sshift + (size_t)sp.b * ZRC + c0; rp = *(const f32x4*)sh; kp = *(const f32x4*)(sh + 2144); vp = *(const f32x4*)(sh + 4192); } }
    const f32x4 z0 = bf4(x.r), z1 = bf4(x.k), z2 = bf4(x.v);
    const f32x4 r = z0 + (rp - z0) * P.mur, ksh = z1 + (kp - z1) * P.muk, vsh = z2 + (vp - z2) * P.muv;
    f32x4 a, dec, kk, k2; float ss = 0.f, bs = 0.f;
#pragma unroll
    for (int e = 0; e < 4; ++e) { a[e] = sigmoidf_(P.a0[e] + x.l1i[e]); const float wl = -softplusf_(-(P.w0[e] + x.l1d[e])) - 0.5f; dec[e] = __expf(-__expf(wl));
        kk[e] = ksh[e] * P.kk[e]; ss += kk[e] * kk[e]; k2[e] = ksh[e] * (1.0f + (a[e] - 1.0f) * P.ka[e]); bs += r[e] * k2[e] * P.rk[e]; }
    const float inv = 1.0f / fmaxf(sqrtf(sum16(ss)), 1e-12f); bs = sum16(bs);
    kk = kk * inv;
    unsigned char* rb = SCAN + ((size_t)m * 32 + h) * SCAN_REC; const f32x4 nk = -kk, ka = kk * a;
    *(f32x4*)(rb + 16 * cl) = dec;
    v2u t; t.x = pk2(r[0], r[1]); t.y = pk2(r[2], r[3]); *(v2u*)(rb + 256 + 8 * cl) = t;
    t.x = pk2(k2[0], k2[1]); t.y = pk2(k2[2], k2[3]); *(v2u*)(rb + 384 + 8 * cl) = t;
    t.x = pk2(nk[0], nk[1]); t.y = pk2(nk[2], nk[3]); *(v2u*)(rb + 512 + 8 * cl) = t;
    t.x = pk2(ka[0], ka[1]); t.y = pk2(ka[2], ka[3]); *(v2u*)(rb + 640 + 8 * cl) = t;
    t.x = pk2(vsh[0], vsh[1]); t.y = pk2(vsh[2], vsh[3]); *(v2u*)(rb + 768 + 8 * cl) = t;
    if (cl == 0) BONUS[m * 32 + h] = bs;
    if (hq < 4) { f32x4 la;
#pragma unroll
        for (int e = 0; e < 4; ++e) la[e] = -softplusf_(-(x.la[e] + P.ba[e])) * 0.0625f;
        *(f32x4*)(LA + (size_t)m * 1024 + c0) = la; }
}
struct P6In { f32x4 ob; v2u v, g; float bonus; };
__device__ __forceinline__ P6In p6_load(const float* OB, const unsigned char* SCAN, const float* BONUS, const bf16* Gb, int it, int lane) {
    const int m = it >> 3, hq = it & 7, c0 = hq * 256 + 4 * lane, h = 4 * hq + (lane >> 4), cl = lane & 15;
    P6In x; x.ob = *(const f32x4*)(OB + (size_t)m * 2048 + c0); x.v = *(const v2u*)(SCAN + ((size_t)m * 32 + h) * SCAN_REC + 768 + 8 * cl); x.g = *(const v2u*)(Gb + (size_t)m * 2048 + c0); x.bonus = BONUS[m * 32 + h];
    return x;
}
__device__ __forceinline__ void p6_compute(const P6In& x, f32x4 lnw, f32x4 lnb, bf16* OBP, int it, int lane) {
    const int m = it >> 3, hq = it & 7, c0 = hq * 256 + 4 * lane;
    const float mean = sum16((x.ob[0] + x.ob[1]) + (x.ob[2] + x.ob[3])) * (1.f / 64.f); const f32x4 dv = x.ob - mean;
    const float var = sum16((dv[0] * dv[0] + dv[1] * dv[1]) + (dv[2] * dv[2] + dv[3] * dv[3])) * (1.f / 64.f); const float rs = __builtin_amdgcn_rsqf(var + 64e-5f);
    const f32x4 y = (dv * rs * lnw + lnb + x.bonus * bf4(x.v)) * bf4(x.g);
    v2u o; o.x = pk2(y[0], y[1]); o.y = pk2(y[2], y[3]); *(v2u*)(OBP + (size_t)m * 2048 + c0) = o;
}

constexpr int LI1 = 64 * (NUP / 32), LI2 = (DFF / 64) * (D / 32), LI3 = 64 * 128, LI4 = 64 * 128, LI5 = 32 * 128, LI6 = 32 * 128, LI7 = 4 * 128;
constexpr int NLATE = LI1 + LI2 + LI3 + LI4 + LI5 + LI6 + LI7, NLATE_CHUNKS = NLATE / 64;
static_assert(NLATE % 64 == 0, "late items come in chunks of 64");
__device__ __forceinline__ TrDesc late_desc(KArgs& args, unsigned char* ws, int it) {
    int r = it;
    if (r < LI1) return TrDesc{args.in[I_WUP], (bf16*)(ws + WS_WT_UP), D, NUP, NUP / 32, r, false}; r -= LI1;
    if (r < LI2) return TrDesc{args.in[I_WDOWN], (bf16*)(ws + WS_WT_DOWN), DFF, D, D / 32, r, false}; r -= LI2;
    if (r < LI3) return TrDesc{args.in[I_WOUT], (bf16*)(ws + WS_WT_OUT), D, D, D / 32, r, false}; r -= LI3;
    if (r < LI4) return TrDesc{args.in[I_WPEG], (bf16*)(ws + WS_WT_PEG), D, D, D / 32, r, false}; r -= LI4;
    if (r < LI5) return TrDesc{args.in[I_WBRA], (bf16*)(ws + WS_WT_BRA), 2048, D, D / 32, r, false}; r -= LI5;
    if (r < LI6) return TrDesc{args.in[I_WBRB], (bf16*)(ws + WS_WT_BRB), 2048, D, D / 32, r, false}; r -= LI6;
    return TrDesc{args.in[I_WPE], (bf16*)(ws + WS_WT_PE), 256, D, D / 32, r, false};
}

__device__ __forceinline__ void late_chunk(Frame& F, KArgs& args, unsigned char* ws, int chunk) {
    LAS float* scr = (LAS float*)(F.lds + F.wave * 16384); const int base = chunk * 64 + F.wave * 8;
    float ta[32], tb[32];
    TrDesc da = late_desc(args, ws, base), db = da;
    tr_load(da, ta, F.lane);
#pragma unroll 1
    for (int i = 0; i < 8; i += 2) {
        db = late_desc(args, ws, base + i + 1); tr_load(db, tb, F.lane);
        tr_finish(da, ta, scr, F.lane);
        if (i + 2 < 8) { da = late_desc(args, ws, base + i + 2); tr_load(da, ta, F.lane); }
        tr_finish(db, tb, scr, F.lane);
    }
}
constexpr int TAILB = 192, NTB = 3, NT1 = 2, TAIL1 = NT1 * 120, PEG0 = 1160, PEG1 = 1288;
static_assert(NTB * TAILB + TAIL1 <= 1032, "tail chunks are w_up / w_down chunks (first needed after the branch GEMM)");
static_assert(NLATE_CHUNKS == 1424 && LI1 / 64 == 688 && (LI1 + LI2 + LI3) / 64 == PEG0 && (LI1 + LI2 + LI3 + LI4) / 64 == PEG1, "chunk map");

constexpr int N_PHASES = 15;
#ifndef REP0
#define REP0 1
#endif
#ifndef REP1
#define REP1 1
#endif
#ifndef REP5
#define REP5 1
#endif
#ifndef REP10
#define REP10 1
#endif
#ifndef REP12
#define REP12 1
#endif
__global__ void __launch_bounds__(NT, 2) fwd_kernel(Args args_unused) {
    extern __shared__ __attribute__((aligned(16))) unsigned char lds_[];
    KArgs& args = *(KArgs*)__builtin_amdgcn_kernarg_segment_ptr();
    Frame F;
    F.lds = (LAS unsigned char*)lds_;
    F.tid = threadIdx.x; F.lane = F.tid & 63; F.wave = __builtin_amdgcn_readfirstlane(F.tid >> 6);
    F.G = gridDim.x; { const int bx = blockIdx.x; F.vcu = (F.G % 8 == 0) ? (bx % 8) * (F.G / 8) + bx / 8 : bx; }
    F.gw = F.vcu * NWAVES + F.wave; F.NGW = F.G * NWAVES;
    unsigned char* ws = args.ws; float* out = args.out;
    unsigned* ctl = (unsigned*)(ws + WS_CTL);
    volatile LAS unsigned* MISC = (volatile LAS unsigned*)(F.lds + MISC_OFF);
    for (int u = F.tid; u < (LDS_BYTES - RING_BYTES) / 4; u += NT) ((LAS unsigned*)(F.lds + RING_BYTES))[u] = 0u;
    __syncthreads();
#if MK_ONE_LAUNCH
    XcdBarrier bar = xcd_barrier_post(ctl + CW_BAR, MISC + 8);
#define GRID_BAR() xcd_barrier(bar)
#else
#define GRID_BAR() do { } while (0)
#endif
    const int lo = args.ph_lo, hi = args.ph_hi;
#define IN(k) (lo <= (k) && (k) < hi)
#define SEAM(k) do { if (IN(k) && IN((k) + 1)) GRID_BAR(); } while (0)

    bf16* WT_IN = (bf16*)(ws + WS_WT_IN); bf16* WT_UP = (bf16*)(ws + WS_WT_UP); bf16* WT_DOWN = (bf16*)(ws + WS_WT_DOWN); bf16* WT_OUT = (bf16*)(ws + WS_WT_OUT);
    bf16* WT_PEG = (bf16*)(ws + WS_WT_PEG); bf16* WT_BRA = (bf16*)(ws + WS_WT_BRA); bf16* WT_BRB = (bf16*)(ws + WS_WT_BRB); bf16* WT_PE = (bf16*)(ws + WS_WT_PE);
    bf16* WL1 = (bf16*)(ws + WS_WL1); bf16* WG = (bf16*)(ws + WS_WG);
    bf16* H = (bf16*)(ws + WS_H); bf16* PROJ = (bf16*)(ws + WS_PROJ); bf16* UP = (bf16*)(ws + WS_PROJ);
    unsigned char* SCAN = ws + WS_SCAN; bf16* ACT = (bf16*)(ws + WS_SCAN); float* TMP = (float*)(ws + WS_SCAN);
    bf16* Gb = (bf16*)(ws + WS_G); float* LA = (float*)(ws + WS_LA); bf16* AL1 = (bf16*)(ws + WS_AL1); bf16* AG = (bf16*)(ws + WS_AG); bf16* PB = (bf16*)(ws + WS_PB);
    float* BONUS = (float*)(ws + WS_BONUS); bf16* PPb = (bf16*)(ws + WS_PP);
    bf16* QDg = (bf16*)(ws + WS_QD); bf16* KDDTg = (bf16*)(ws + WS_KDDT); bf16* VTg = (bf16*)(ws + WS_VT); bf16* ATTg = (bf16*)(ws + WS_ATT); float* EBg = (float*)(ws + WS_EB);
    float* MO = (float*)(ws + WS_PROJ); float* FF = (float*)(ws + WS_PROJ);
    float* MOS = (float*)(ws + WS_PROJ + 144 * MiB); float* FFS = (float*)(ws + WS_PROJ + 240 * MiB);
    bf16* L1 = (bf16*)(out + O_GLA_S);
    float* OA = out + O_Y; float* OB = out + O_Y + (size_t)T * 2048;
    bf16* OAP = H; bf16* OBP = H + (size_t)T * 2048;
    bf16* MIXED = (bf16*)(out + O_Y);
    float* Y = out + O_Y;

    if (IN(0)) {
        LAS float* scr = (LAS float*)(F.lds + F.wave * 16384);
        constexpr int I0 = 64 * (NPROJ / 32), I8 = 4 * 64;
#define P0_DESC(it_) ((it_) < I0 ? TrDesc{args.in[I_WIN], WT_IN, D, 20944, NPROJ / 32, (it_), true} : TrDesc{args.in[I_WGATE2], WG, 256, 2048, 2048 / 32, (it_) - I0, false})
        {   float ta[32], tb[32]; int it = F.gw;
            if (it < I0 + I8) { TrDesc da = P0_DESC(it), db = da; tr_load(da, ta, F.lane);
                for (; it < I0 + I8; it += 2 * F.NGW) {
                    const int i1 = it + F.NGW, i2 = it + 2 * F.NGW; const bool h1 = i1 < I0 + I8, h2 = i2 < I0 + I8;
                    if (h1) { db = P0_DESC(i1); tr_load(db, tb, F.lane); }
                    tr_finish(da, ta, scr, F.lane);
                    if (h2) { da = P0_DESC(i2); tr_load(da, ta, F.lane); }
                    if (h1) tr_finish(db, tb, scr, F.lane);
                } }
        }
#undef P0_DESC
        for (int e0 = F.vcu * NT + F.tid; e0 < NL1 * 256; e0 += 10 * F.G * NT) {
            float v[10];
#pragma unroll
            for (int j = 0; j < 10; ++j) { const int e = e0 + j * F.G * NT, k = e / NL1, n = e - k * NL1; const float* src = nullptr;
                if (e < NL1 * 256) {
                    if (n < 1024) { if (k < 16) src = args.in[I_WALPHA2] + k * 1024 + n; }
                    else if (n < 3072) { if (k >= 16 && k < 112) src = args.in[I_WDECAY2] + (k - 16) * 2048 + (n - 1024); }
                    else { if (k >= 112 && k < 208) src = args.in[I_WICLR2] + (k - 112) * 2048 + (n - 3072); } }
                v[j] = src ? *src : 0.f; }
#pragma unroll
            for (int j = 0; j < 10; ++j) { const int e = e0 + j * F.G * NT, k = e / NL1, n = e - k * NL1; if (e < NL1 * 256) WL1[n * 256 + k] = (bf16)f2bf(v[j]); }
        }
        for (int m = F.gw; m < T; m += F.NGW) {
            rms_row_bf16(xrow(args, m), args.in[I_GPREMIX], H + (size_t)m * D, F.lane);
            const float* pr = m < TP ? args.in[I_PP] + (size_t)m * 256 : args.in[I_PS] + (size_t)(m - TP) * 256;
            const f32x4 pv = *((const f32x4*)pr + F.lane); v2u w; w.x = pk2(pv.x, pv.y); w.y = pk2(pv.z, pv.w); *((v2u*)(PB + (size_t)m * 256) + F.lane) = w;
        }
    }
    SEAM(0);
    if (IN(1)) { run_gemm(F, H, WT_IN, T, NPROJ, D, FStoreBf16{PROJ, NPROJ});
        if (F.G == 256) { constexpr int rem = ((T / 256) * (NPROJ / 256)) % 256; const int c = (int)blockIdx.x;
            if (c >= rem) {
#pragma unroll 1
                for (int k = 0; k < NT1; ++k) late_chunk(F, args, ws, NTB * TAILB + k * 120 + c - rem); } }
    }
    SEAM(1);
    if (IN(2)) {
        const float* mu = args.in[I_MU];
        for (int m = F.gw; m < T; m += F.NGW) {
            const SeqPos sp = seqpos(m); const bf16* pr = PROJ + (size_t)m * NPROJ; const bf16* pp = pr - NPROJ;
            const float* sh = args.in[I_SSHIFT] + (size_t)sp.b * ZRC;
            for (int c = F.lane; c < 256; c += 64) {
                float val = 0.f;
                if (c < 16) val = bf2f(pr[CSM + c]);
                else if (c < 208) { const int oz = c < 112 ? 2048 + (c - 16) : 6240 + (c - 112); const float z = bf2f(pr[CSM + c]);
                    const float prev = sp.t > 0 ? bf2f(pp[CSM + c]) : (sp.prm ? 0.f : sh[oz]); const float zs = z + (prev - z) * mu[oz]; val = c < 112 ? tanhf(zs) : zs; }
                AL1[(size_t)m * 256 + c] = (bf16)f2bf(val);
                { const int oz = 6336 + c; const float z = bf2f(pr[CXG + c]); const float prev = sp.t > 0 ? bf2f(pp[CXG + c]) : (sp.prm ? 0.f : sh[oz]);
                  const float zs = z + (prev - z) * mu[oz]; AG[(size_t)m * 256 + c] = (bf16)f2bf(sigmoidf_(zs)); }
            }
            if (sp.t == sp.L - 1) { float* so = out + (sp.prm ? O_SHIFT_P : O_SHIFT_S) + (size_t)sp.b * ZRC;
                for (int oz = F.lane; oz < ZRC; oz += 64) so[oz] = bf2f(pr[zr_col(oz)]); }
        }
    }
    SEAM(2);
    if (IN(3)) {
        run_gemm(F, AL1, WL1, T, NL1, 256, FStoreBf16{L1, NL1});
        run_gemm(F, AG, WG, T, 2048, 256, FStoreBf16{Gb, 2048});
    }
    SEAM(3);
    if (IN(4)) {
        {
            const int hq = F.gw & 7, c0 = hq * 256 + 4 * F.lane; const float* mu = args.in[I_MU];
            P4Par P; P.mur = *(const f32x4*)(mu + c0); P.muk = *(const f32x4*)(mu + 2144 + c0); P.muv = *(const f32x4*)(mu + 4192 + c0);
            P.a0 = *(const f32x4*)(args.in[I_A0] + c0); P.w0 = *(const f32x4*)(args.in[I_W0] + c0); P.kk = *(const f32x4*)(args.in[I_KK] + c0); P.ka = *(const f32x4*)(args.in[I_KA] + c0);
            P.rk = *(const f32x4*)(args.in[I_RK] + c0); P.ba = *(const f32x4*)(args.in[I_BALPHA] + (c0 & 1023));
            if (F.G == 256) {
                const int g = F.vcu;
#pragma unroll 1
                for (int i = 0; i < 36; i += 2) { const int ma = i < 32 ? 32 * g + i : TP + 4 * g + (i - 32), ita = ma * 8 + hq, itb = ita + 8;
                    const P4In xa = p4_load(PROJ, L1, ita, F.lane), xb = p4_load(PROJ, L1, itb, F.lane);
                    p4_compute(xa, P, args.in[I_SSHIFT], SCAN, BONUS, LA, ita, F.lane);
                    p4_compute(xb, P, args.in[I_SSHIFT], SCAN, BONUS, LA, itb, F.lane); }
                asm volatile("s_waitcnt vmcnt(0)" ::: "memory");
                LAS unsigned char* wl = F.lds + F.wave * 16384;
#pragma unroll 1
                for (int k = 0; k < 8; ++k) { const int h = 4 * hq + (k & 3), mb = 32 * g + 16 * (k >> 2), b = mb >> 11, c = (mb & 2047) >> 4; const size_t uc = (size_t)(b * 32 + h) * RW_NCH + c;
                    rwkv_prep_unit(wl, F.lane, SCAN, mb, h, ws + WS_RW1 + uc * RW_A1, ws + WS_RW2 + uc * RW_A2); }
            } else
            for (int it = F.gw; it < T * 8; it += 2 * F.NGW) {
                const int it2 = it + F.NGW; const bool has2 = it2 < T * 8;
                const P4In xa = p4_load(PROJ, L1, it, F.lane), xb = p4_load(PROJ, L1, has2 ? it2 : it, F.lane);
                p4_compute(xa, P, args.in[I_SSHIFT], SCAN, BONUS, LA, it, F.lane);
                if (has2) p4_compute(xb, P, args.in[I_SSHIFT], SCAN, BONUS, LA, it2, F.lane);
            }
        }
        for (int uu = F.vcu; uu < 512; uu += F.G) gla_prep_unit(F, PROJ, L1, args.in[I_BALPHA], QDg, KDDTg, VTg, ATTg, EBg, uu >> 2, uu & 3);
    }
    SEAM(4);
    if (IN(5)) {
        const int g = F.vcu;
        if (g < 256) { const int u = g >> 1;
            if ((g & 1) == 0) {
                if (F.G == 256) { if ((g & 3) == 0)
                        rwkv_chunk_scan_lds(F, ws + WS_RW1, ws + WS_RW2, (g >> 2) * 2, out + O_RWKV_P, OB); }
                else { const int b = u >> 5, h = u & 31; rwkv_unit<0>(F, SCAN, b * SEQ, SEQ, h, nullptr, out + O_RWKV_P + (size_t)(b * 32 + h) * 4096, OB); } }
            else { const int b = u >> 5, h = (u >> 3) & 3, vs = u & 7; gla_prompt_unit(F, QDg, KDDTg, VTg, ATTg, EBg, OA, out + O_GLA_P, b, h, vs); } }
        for (;;) {
            __syncthreads();
            if (F.tid == 0) MISC[0] = atomicAdd(ctl + CW_QUEUE, 1u);
            __syncthreads();
            const unsigned q = MISC[0];
            const bool tails = F.G == 256; const unsigned nq = tails ? (unsigned)(NLATE_CHUNKS - NTB * TAILB - TAIL1) : (unsigned)NLATE_CHUNKS;
            if (q >= 512u + nq + 1024u) break;
            if (q < 512u) { gla_sample_unit(F, PROJ, LA, OA, args.in[I_SGLA], out + O_GLA_S, (int)(q >> 2), (int)(q & 3)); }
            else if (q < 512u + nq) { int ch = (int)q - 512; if (tails) ch += NTB * TAILB + TAIL1;
                late_chunk(F, args, ws, ch); }
            else { const int u4 = (int)(q - 512u - nq), u = u4 * 4, b = u >> 5, h = u & 31;
                rwkv_unit<4>(F, SCAN, TP + b * DSEQ, DSEQ, h, args.in[I_SRWKV] + (size_t)u * 4096, out + O_RWKV_S + (size_t)u * 4096, OB); }
        }
    }
    SEAM(5);
    if (IN(6)) {
        {   const int hq = F.gw & 7, c0 = hq * 256 + 4 * F.lane;
            const f32x4 lnw = *(const f32x4*)(args.in[I_LNXW] + c0), lnb = *(const f32x4*)(args.in[I_LNXB] + c0);
            for (int it = F.gw; it < T * 8; it += 2 * F.NGW) {
                const int it2 = it + F.NGW; const bool has2 = it2 < T * 8;
                const P6In xa = p6_load(OB, SCAN, BONUS, Gb, it, F.lane), xb = p6_load(OB, SCAN, BONUS, Gb, has2 ? it2 : it, F.lane);
                p6_compute(xa, lnw, lnb, OBP, it, F.lane);
                if (has2) p6_compute(xb, lnw, lnb, OBP, it2, F.lane);
            }
        }
        for (int idx = F.gw; idx < T * 4; idx += F.NGW) {
            const int m = idx >> 2, h = idx & 3; const float* op = OA + (size_t)m * 2048 + h * 512 + F.lane * 8;
            const f32x4 o0 = *(const f32x4*)op, o1 = *(const f32x4*)(op + 4);
            const float ss = wave_sum((o0.x * o0.x + o0.y * o0.y) + (o0.z * o0.z + o0.w * o0.w) + (o1.x * o1.x + o1.y * o1.y) + (o1.z * o1.z + o1.w * o1.w));
            const float rs = __builtin_amdgcn_rsqf(ss * (1.f / 512.f) + 1e-6f);
            const f32x4 g0 = *(const f32x4*)(args.in[I_GLANORM] + F.lane * 8), g1 = *(const f32x4*)(args.in[I_GLANORM] + F.lane * 8 + 4);
            const v4u zg = *(const v4u*)(PROJ + (size_t)m * NPROJ + CZG + h * 512 + F.lane * 8);
            const float z[8] = {bflo(zg.x), bfhi(zg.x), bflo(zg.y), bfhi(zg.y), bflo(zg.z), bfhi(zg.z), bflo(zg.w), bfhi(zg.w)};
            const float o[8] = {o0.x * g0.x, o0.y * g0.y, o0.z * g0.z, o0.w * g0.w, o1.x * g1.x, o1.y * g1.y, o1.z * g1.z, o1.w * g1.w};
            float y[8];
#pragma unroll
            for (int i = 0; i < 8; ++i) y[i] = o[i] * rs * z[i] * sigmoidf_(z[i]);
            v4u w; w.x = pk2(y[0], y[1]); w.y = pk2(y[2], y[3]); w.z = pk2(y[4], y[5]); w.w = pk2(y[6], y[7]);
            *(v4u*)(OAP + (size_t)m * 2048 + h * 512 + F.lane * 8) = w;
        }
    }
    SEAM(6);
    if (IN(7)) {
        const int cblk = (int)blockIdx.x; const bool tails = F.G == 256;
        run_gemm_chain(F, OAP, WT_BRA, OBP, WT_BRB, T, D, 2048, FBranch{PROJ, MIXED});
        if (tails && cblk >= 64) {
#pragma unroll 1
            for (int k = 0; k < NTB; ++k) late_chunk(F, args, ws, k * TAILB + cblk - 64); }
    }
    SEAM(7);
    if (IN(8)) { run_gemm_split(F, MIXED, WT_OUT, T, D, D, FStoreF32Split{MO, D, MOS, TP, (size_t)TS * D, (bf16*)MO}); }
    SEAM(8);
    if (IN(9)) { for (int m = F.gw; m < T; m += F.NGW) sandwich_row(MO + (size_t)m * D, m < TP ? (const bf16*)MO + (size_t)m * D : nullptr, MOS + (size_t)(m - TP) * D, (size_t)TS * D, m >= TP ? 3 : 0, xrow(args, m), args.in[I_GPOSTMIX], Y + (size_t)m * D, args.in[I_GPREFFN], H + (size_t)m * D, F.lane); }
    SEAM(9);
    if (IN(10)) {
        if (F.G == 256) {
            constexpr int NUPT = (T / 256) * (NUP / 256), FULL = (NUPT / 256) * 256, NQ = (NUPT - FULL) * 4;
            run_gemm_lim(F, H, WT_UP, T, NUP, D, FStoreBf16{UP, NUP}, FULL);
            const int c = (int)blockIdx.x;
            if (c < NQ) { const int cq = (c & 7) * (NQ / 8) + (c >> 3); pg8::StaticOrder S; S.init(T, NUP, D, 256, 0); pg8::Unit u; S.tile(FULL + (cq >> 2), u);
                pg8::gemm_quarter(F.lds, H, WT_UP, D, 2 * u.pm + ((cq >> 1) & 1), 2 * u.pn + (cq & 1), FStoreBf16{UP, NUP}); }
            else run_gemm_gc(F, PB, WT_PE, T, D, 256, FStoreBf16{PPb, D}, 256 - NQ, c - NQ);
        } else { run_gemm(F, H, WT_UP, T, NUP, D, FStoreBf16{UP, NUP});
        { const int nup = (T / 256) * (NUP / 256), rem = nup % F.G; const int c = (int)blockIdx.x;
          if (rem == 0) run_gemm(F, PB, WT_PE, T, D, 256, FStoreBf16{PPb, D});
          else if (c >= rem) run_gemm_gc(F, PB, WT_PE, T, D, 256, FStoreBf16{PPb, D}, F.G - rem, c - rem); } }
    }
    SEAM(10);
    if (IN(11)) {
        const float* cw = args.in[I_CONVW]; const float* cb = args.in[I_CONVB];
        const int rpw = (T + F.G - 1) / F.G, mlo = F.vcu * rpw, mhi = (mlo + rpw < T) ? mlo + rpw : T;
        for (int jc = F.tid; jc < DFF / 8; jc += NT) {
            const int j = jc * 8;
            f32x4 cbv[2], c0v[2], c1v[2], c2v[2];
#pragma unroll
            for (int e = 0; e < 2; ++e) { cbv[e] = *(const f32x4*)(cb + j + 4 * e); c0v[e] = *(const f32x4*)(cw + j + 4 * e); c1v[e] = *(const f32x4*)(cw + DFF + j + 4 * e); c2v[e] = *(const f32x4*)(cw + 2 * DFF + j + 4 * e); }
            f32x4 h1[2] = {{0.f, 0.f, 0.f, 0.f}, {0.f, 0.f, 0.f, 0.f}}, h2[2] = {{0.f, 0.f, 0.f, 0.f}, {0.f, 0.f, 0.f, 0.f}};
            if (mlo >= 1 && mlo < mhi) { const v4u x = *(const v4u*)(UP + (size_t)(mlo - 1) * NUP + j); h1[0] = (f32x4){bflo(x.x), bfhi(x.x), bflo(x.y), bfhi(x.y)}; h1[1] = (f32x4){bflo(x.z), bfhi(x.z), bflo(x.w), bfhi(x.w)}; }
            if (mlo >= 2 && mlo < mhi) { const v4u x = *(const v4u*)(UP + (size_t)(mlo - 2) * NUP + j); h2[0] = (f32x4){bflo(x.x), bfhi(x.x), bflo(x.y), bfhi(x.y)}; h2[1] = (f32x4){bflo(x.z), bfhi(x.z), bflo(x.w), bfhi(x.w)}; }
            v4u g2[4], uv[4], g2n[4], uvn[4];
#pragma unroll
            for (int i = 0; i < 4; ++i) { const int m = (mlo + i < mhi) ? mlo + i : (mhi > 0 ? mhi - 1 : 0); const bf16* ur = UP + (size_t)m * NUP + j; g2[i] = *(const v4u*)ur; uv[i] = *(const v4u*)(ur + DFF); }
            for (int mb = mlo; mb < mhi; mb += 4) {
#pragma unroll
                for (int i = 0; i < 4; ++i) { const int m = (mb + 4 + i < mhi) ? mb + 4 + i : mhi - 1; const bf16* ur = UP + (size_t)m * NUP + j; g2n[i] = *(const v4u*)ur; uvn[i] = *(const v4u*)(ur + DFF); }
#pragma unroll
                for (int i = 0; i < 4; ++i) { const int m = mb + i;
                    if (m < mhi) { const SeqPos sp = seqpos(m); const float* st = args.in[I_SCONV] + (size_t)sp.b * 2 * DFF + j;
                        f32x4 t0[2], t1[2];
                        if (sp.t >= 1) { t1[0] = h1[0]; t1[1] = h1[1]; }
                        else if (sp.prm) { t1[0] = (f32x4){0.f, 0.f, 0.f, 0.f}; t1[1] = t1[0]; } else { t1[0] = *(const f32x4*)(st + DFF); t1[1] = *(const f32x4*)(st + DFF + 4); }
                        if (sp.t >= 2) { t0[0] = h2[0]; t0[1] = h2[1]; }
                        else if (sp.prm) { t0[0] = (f32x4){0.f, 0.f, 0.f, 0.f}; t0[1] = t0[0]; } else { t0[0] = *(const f32x4*)(st + sp.t * DFF); t0[1] = *(const f32x4*)(st + sp.t * DFF + 4); }
                        const v4u g = g2[i], u = uv[i];
                        const f32x4 t2[2] = {{bflo(g.x), bfhi(g.x), bflo(g.y), bfhi(g.y)}, {bflo(g.z), bfhi(g.z), bflo(g.w), bfhi(g.w)}};
                        const f32x4 vv[2] = {{bflo(u.x), bfhi(u.x), bflo(u.y), bfhi(u.y)}, {bflo(u.z), bfhi(u.z), bflo(u.w), bfhi(u.w)}};
                        f32x4 a[2];
#pragma unroll
                        for (int e = 0; e < 2; ++e) { const f32x4 cv = cbv[e] + t0[e] * c0v[e] + t1[e] * c1v[e] + t2[e] * c2v[e];
                            const f32x4 tq = cv * ((cv * cv) * (-2.0f * 0.7978845608028654f * 0.044715f * 1.4426950408889634f) + (-2.0f * 0.7978845608028654f * 1.4426950408889634f));
#pragma unroll
                            for (int x = 0; x < 4; ++x) a[e][x] = cv[x] * vv[e][x] * __builtin_amdgcn_rcpf(1.0f + __builtin_amdgcn_exp2f(tq[x])); }
                        v4u w; w.x = cvt_pk_bf16(a[0][0], a[0][1]); w.y = cvt_pk_bf16(a[0][2], a[0][3]); w.z = cvt_pk_bf16(a[1][0], a[1][1]); w.w = cvt_pk_bf16(a[1][2], a[1][3]);
                        *(v4u*)(ACT + (size_t)m * DFF + j) = w;
                        if (sp.t >= sp.L - 2) { float* co = out + (sp.prm ? O_CONV_P : O_CONV_S) + ((size_t)sp.b * 2 + (sp.t - (sp.L - 2))) * DFF + j; *(f32x4*)co = t2[0]; *(f32x4*)(co + 4) = t2[1]; }
                        h2[0] = h1[0]; h2[1] = h1[1]; h1[0] = t2[0]; h1[1] = t2[1]; }
                }
#pragma unroll
                for (int i = 0; i < 4; ++i) { g2[i] = g2n[i]; uv[i] = uvn[i]; }
            }
        }
    }
    SEAM(11);
    if (IN(12)) { run_gemm_split(F, ACT, WT_DOWN, T, D, DFF, FStoreF32Split{FF, D, FFS, TP, (size_t)TS * D, (bf16*)FF});
    }
    SEAM(12);
    if (IN(13)) {
        for (int m = F.gw; m < T; m += F.NGW) sandwich_row(FF + (size_t)m * D, m < TP ? (const bf16*)FF + (size_t)m * D : nullptr, FFS + (size_t)(m - TP) * D, (size_t)TS * D, m >= TP ? 3 : 0, Y + (size_t)m * D, args.in[I_GPOSTFFN], Y + (size_t)m * D, args.in[I_GPE], H + (size_t)m * D, F.lane);
    }
    SEAM(13);
    if (IN(14)) {
        if (F.G == 256) {
            run_gemm(F, H, WT_PEG, TP, D, D, FPeg{Y, PPb});
            const int c = (int)blockIdx.x, x = c & 7, idx = c >> 3;
            pg8::gemm_quarter(F.lds, H, WT_PEG, D, TP / 128 + (idx & 7), 4 * x + (idx >> 3), FPeg{Y, PPb});
        } else run_gemm(F, H, WT_PEG, T, D, D, FPeg{Y, PPb});
    }
#undef IN
#undef SEAM
}

extern "C" void kernel_launch(void* const* d_in, const int* in_sizes, int n_in, void* d_out, int out_size, void* d_ws, size_t ws_size, hipStream_t stream) {
    static int grid = 0;
    if (grid == 0) {
        if (n_in != 37 || out_size != (int)O_END || ws_size < WS_END) { fprintf(stderr, "kernel_launch: unexpected shapes (n_in %d out %d ws %zu)\n", n_in, out_size, ws_size); grid = -1; return; }
        int dev = 0, cus = 0, per_cu = 0;
        if (hipGetDevice(&dev) != hipSuccess || hipDeviceGetAttribute(&cus, hipDeviceAttributeMultiprocessorCount, dev) != hipSuccess) { grid = -1; return; }
        if (hipFuncSetAttribute((const void*)fwd_kernel, hipFuncAttributeMaxDynamicSharedMemorySize, LDS_BYTES) != hipSuccess) { fprintf(stderr, "kernel_launch: hipFuncSetAttribute failed\n"); grid = -1; return; }
        if (hipOccupancyMaxActiveBlocksPerMultiprocessor(&per_cu, (const void*)fwd_kernel, NT, LDS_BYTES) != hipSuccess || per_cu < 1) { fprintf(stderr, "kernel_launch: occupancy query says %d\n", per_cu); (void)hipGetLastError(); grid = -1; return; }
        grid = cus;
    }
    if (grid < 0) return;
    (void)hipMemsetAsync((char*)d_ws + WS_CTL, 0, CTL_ZERO_BYTES, stream);
    Args a{};
    for (int i = 0; i < 37; ++i) a.in[i] = (const float*)d_in[i];
    a.out = (float*)d_out; a.ws = (unsigned char*)d_ws;
#if MK_ONE_LAUNCH
    a.ph_lo = 0; a.ph_hi = N_PHASES;
    hipLaunchKernelGGL(fwd_kernel, dim3(grid), dim3(NT), LDS_BYTES, stream, a);
#else
    for (int p = 0; p < N_PHASES; ++p) { a.ph_lo = p; a.ph_hi = p + 1; hipLaunchKernelGGL(fwd_kernel, dim3(grid), dim3(NT), LDS_BYTES, stream, a); }
#endif
}
```

```cpp
#include <hip/hip_runtime.h>
#include <cstdio>
#include <cstdint>
#ifndef MK_ONE_LAUNCH
#define MK_ONE_LAUNCH 1
#endif
namespace pg8 {
#define PG8_LAS __attribute__((address_space(3)))
typedef unsigned short bf16_t;
typedef short bf16x8 __attribute__((ext_vector_type(8)));
typedef float f32x4 __attribute__((ext_vector_type(4)));
typedef unsigned u32x4 __attribute__((ext_vector_type(4)));
constexpr int BM = 256, BK = 64, HALF = 128, HTB = HALF * BK * 2  , STAGE_BYTES = 8 * HTB, NXCD = 8, WGM = 8;

__host__ __device__ __forceinline__ int lds_byte(int r, int c) { const int st = (r >> 4) * 2 + (c >> 5), rr = r & 15, cc = c & 31, ob = rr * 64 + cc * 2; return st * 1024 + (ob ^ (((ob >> 9) & 1) << 5)); }
__host__ __device__ __forceinline__ void stage_rc(int b, int& R, int& C) { const int st = b / 1024, sb = b % 1024, swz = sb ^ (((sb >> 9) & 1) << 5); R = (st >> 1) * 16 + swz / 64; C = (st & 1) * 32 + (swz % 64) / 2; }
__host__ __device__ __forceinline__ int perm32(int rho) { const int n = rho >> 4, i = rho & 15; return 8 * (i >> 2) + 4 * n + (i & 3); }

struct Unit { int pm, pn, k0, nt, part; };
struct Gemm { const bf16_t* A; const bf16_t* Bt; int M, N, K; const bf16_t* A2; const bf16_t* Bt2; };

struct StaticOrder {
    int nM, nN, nwg, G, c, ntk, lim;
    __host__ __device__ __forceinline__ void init(int M, int N, int K, int G_, int c_) { nM = M / BM; nN = N / BM; nwg = nM * nN; G = G_; c = c_; ntk = K / BK; lim = nwg; }
    __host__ __device__ __forceinline__ bool next(int i, Unit& u) const { const long L = (long)i * G + c; if (L >= lim) return false; tile(L, u); return true; }
    __host__ __device__ __forceinline__ bool tile(long L, Unit& u) const {
        int wgid = (int)L; { const int q = nwg / NXCD, r = nwg % NXCD, xcd = wgid % NXCD, off = wgid / NXCD; wgid = (xcd < r ? xcd * (q + 1) : r * (q + 1) + (xcd - r) * q) + off; }
        const int nig = WGM * nN, gid = wgid / nig, fm = gid * WGM, gsz = (nM - fm) < WGM ? (nM - fm) : WGM;
        u.pm = fm + ((wgid % nig) % gsz); u.pn = (wgid % nig) / gsz; u.k0 = 0; u.nt = ntk; u.part = 0; return true;
    }
    __device__ __forceinline__ void a_ready(const Unit&) const {}
    __device__ __forceinline__ void done(const Unit&) const {}
};

struct SplitOrder {
    StaticOrder full; int G, c, rounds, R, parts, pm0, nN, ntk; bool split;
    __host__ __device__ __forceinline__ void init(int M, int N, int K, int G_, int c_) {
        const int nM = M / BM; nN = N / BM; G = G_; c = c_; ntk = K / BK; const int U = nM * nN; rounds = U / G; R = U - rounds * G;
        const int pr = R > 0 ? G / R : 1;
        split = R > 0 && (G % R) == 0 && (R % nN) == 0 && ((rounds * G) % nN) == 0 && pr <= 4 && (ntk / 2) >= pr && (G % NXCD) == 0 && (NXCD % pr) == 0 && (NXCD / pr) * (G / NXCD) == R;
        parts = split ? pr : 1; pm0 = split ? (rounds * G) / nN : nM; full.init(pm0 * BM, N, K, G, c);
    }
    __host__ __device__ __forceinline__ bool next(int i, Unit& u) const {
        Unit f; const bool okf = full.next(i, f);
        const int x = c % NXCD, idx = c / NXCD, npx = G / NXCD, p = x % parts, grp = x / parts, tile = grp * npx + idx;
        const int pairs = ntk / 2, q = pairs / parts, rem = pairs % parts;
        const bool isp = split && i == rounds;
        u.pm = isp ? pm0 + tile / nN : f.pm; u.pn = isp ? tile % nN : f.pn; u.part = isp ? p : 0;
        u.nt = isp ? 2 * (q + (p < rem ? 1 : 0)) : ntk; u.k0 = isp ? 2 * BK * (p * q + (p < rem ? p : rem)) : 0;
        return isp || ((!split || i < rounds) && okf);
    }
    __device__ __forceinline__ void a_ready(const Unit&) const {}
    __device__ __forceinline__ void done(const Unit&) const {}
};

struct ChainOrder {
    StaticOrder full;
    __host__ __device__ __forceinline__ void init(int M, int N, int K, int G_, int c_) { full.init(M, N, K, G_, c_); }
    __host__ __device__ __forceinline__ bool next(int i, Unit& u) const { const bool ok = full.next(i >> 1, u); u.part = i & 1; return ok; }
    __device__ __forceinline__ void a_ready(const Unit&) const {}
    __device__ __forceinline__ void done(const Unit&) const {}
};
__device__ __forceinline__ unsigned cvt_pk_bf16(float lo, float hi) { unsigned r; asm volatile("v_cvt_pk_bf16_f32 %0, %1, %2" : "=v"(r) : "v"(lo), "v"(hi)); return r; }
typedef float f32x2 __attribute__((ext_vector_type(2)));
template <class F> struct EpiRow8 {
    static constexpr bool PERM = true, AFTER_DRAIN = false, CHAIN = false;
    F f;
    __device__ __forceinline__ void operator()(const f32x4 (&acc)[2][2][4][2], const Unit& u, int wr, int wc, int fr, int fq) const {
        const int row0 = u.pm * BM + wr * 64 + fr, col0 = u.pn * BM + wc * 32 + 8 * fq;
#pragma unroll
        for (int ai = 0; ai < 2; ++ai)
#pragma unroll
            for (int m = 0; m < 4; ++m) {
#pragma unroll
                for (int bj = 0; bj < 2; ++bj) f(row0 + ai * HALF + m * 16, col0 + bj * HALF, acc[ai][bj][m][0], acc[ai][bj][m][1], u.part);
            }
    }
};

template <class F> struct EpiRow8Chain {
    static constexpr bool PERM = true, AFTER_DRAIN = false, CHAIN = true;
    F f;
    __device__ __forceinline__ void mid(f32x4 (&acc)[2][2][4][2], const Unit& u, int wr, int wc, int fr, int fq) const {
        const int row0 = u.pm * BM + wr * 64 + fr, col0 = u.pn * BM + wc * 32 + 8 * fq;
#pragma unroll
        for (int ai = 0; ai < 2; ++ai)
#pragma unroll
            for (int m = 0; m < 4; ++m) {
#pragma unroll
                for (int bj = 0; bj < 2; ++bj) f.mid(row0 + ai * HALF + m * 16, col0 + bj * HALF, acc[ai][bj][m][0], acc[ai][bj][m][1]);
            }
    }
    __device__ __forceinline__ void operator()(const f32x4 (&acc)[2][2][4][2], const Unit& u, int wr, int wc, int fr, int fq) const {
        const int row0 = u.pm * BM + wr * 64 + fr, col0 = u.pn * BM + wc * 32 + 8 * fq;
#pragma unroll
        for (int ai = 0; ai < 2; ++ai)
#pragma unroll
            for (int m = 0; m < 4; ++m) {
#pragma unroll
                for (int bj = 0; bj < 2; ++bj) f(row0 + ai * HALF + m * 16, col0 + bj * HALF, acc[ai][bj][m][0], acc[ai][bj][m][1], u.part);
            }
    }
};
template <class Epi, class Sched, bool ALIGN_EPI = false, bool SP2 = false>
__device__ __forceinline__ void gemm_phase(PG8_LAS unsigned char* lds, const Gemm g, const Sched& S, const Epi& E) {
    const int tid = threadIdx.x, wid = __builtin_amdgcn_readfirstlane(tid >> 6), lane = tid & 63, wr = wid >> 2, wc = wid & 3, fr = lane & 15, fq = lane >> 4;
    const int K = g.K;
    unsigned voffA[2], voffB[2];
#pragma unroll
    for (int i = 0; i < 2; ++i) { int R, C; stage_rc(tid * 16 + i * 8192, R, C); const int Rb = Epi::PERM ? ((R & ~31) + perm32(R & 31)) : R;
        voffA[i] = (unsigned)(R * K + C) * 2u; voffB[i] = (unsigned)(Rb * K + C) * 2u; }
    const size_t kstep = (size_t)(BK * 2);
    const size_t hstep = (size_t)HALF * K * 2;
    const size_t tstep = 2 * hstep;
    const unsigned ldsw = (unsigned)wid * 1024u;
    const int aoff = lds_byte(wr * 64 + fr, fq * 8), boff = lds_byte(wc * 32 + fr, fq * 8);
#define PG8_SA(b, h) (((b) * 2 + (h)) * HTB)
#define PG8_SB(b, h) ((4 + (b) * 2 + (h)) * HTB)
#define PG8_STAGE(bufoff, gbase, voff) do { _Pragma("unroll") for (int _i = 0; _i < 2; ++_i) \
        __builtin_amdgcn_global_load_lds((const unsigned*)((const char*)(gbase) + (voff)[_i]), (PG8_LAS unsigned*)(lds + (bufoff) + ldsw + _i * 8192), 16, 0, 0); } while (0)
#define PG8_LDA(dst, b, h) do { _Pragma("unroll") for (int m = 0; m < 4; ++m) _Pragma("unroll") for (int k = 0; k < 2; ++k) dst[m][k] = *(const PG8_LAS bf16x8*)(lds + PG8_SA(b, h) + aoff + m * 2048 + k * 1024); } while (0)
#define PG8_LDB(dst, b, h) do { _Pragma("unroll") for (int n = 0; n < 2; ++n) _Pragma("unroll") for (int k = 0; k < 2; ++k) dst[n][k] = *(const PG8_LAS bf16x8*)(lds + PG8_SB(b, h) + boff + n * 2048 + k * 1024); } while (0)
#define PG8_MMA(ai, bj, At, Bt) do { __builtin_amdgcn_s_setprio(1); _Pragma("unroll") for (int m = 0; m < 4; ++m) _Pragma("unroll") for (int n = 0; n < 2; ++n) _Pragma("unroll") for (int k = 0; k < 2; ++k) \
        acc[ai][bj][m][n] = __builtin_amdgcn_mfma_f32_16x16x32_bf16(Bt[n][k], At[m][k], acc[ai][bj][m][n], 0, 0, 0); __builtin_amdgcn_s_setprio(0); } while (0)
#define PG8_WAIT_V(n) asm volatile("s_waitcnt vmcnt(" #n ")" ::: "memory")
#define PG8_WAIT_L(n) asm volatile("s_waitcnt lgkmcnt(" #n ")" ::: "memory")
#define PG8_BAR __builtin_amdgcn_s_barrier()
#define PG8_SCHED __builtin_amdgcn_sched_barrier(0)
    Unit cur, nxt; int ui = 0;
    if (!S.next(0, cur)) return;
    f32x4 acc[2][2][4][2];
#pragma unroll
    for (int a = 0; a < 2; ++a)
#pragma unroll
        for (int b = 0; b < 2; ++b)
#pragma unroll
            for (int m = 0; m < 4; ++m)
#pragma unroll
                for (int n = 0; n < 2; ++n) acc[a][b][m][n] = (f32x4){0.f, 0.f, 0.f, 0.f};
    bf16x8 At[4][2], B0[2][2], B1[2][2];
    const char* cA = (const char*)((Epi::CHAIN && cur.part) ? g.A2 : g.A) + (size_t)cur.pm * tstep + (size_t)cur.k0 * 2; const char* cB = (const char*)((Epi::CHAIN && cur.part) ? g.Bt2 : g.Bt) + (size_t)cur.pn * tstep + (size_t)cur.k0 * 2;
    S.a_ready(cur);
    if constexpr (SP2) {
        PG8_STAGE(PG8_SB(0, 0), cB, voffB); PG8_STAGE(PG8_SB(0, 1), cB + hstep, voffB); PG8_STAGE(PG8_SA(0, 0), cA, voffA); PG8_STAGE(PG8_SA(0, 1), cA + hstep, voffA);
        if (wr == 1) PG8_BAR;
        PG8_WAIT_V(2); PG8_BAR;
        PG8_STAGE(PG8_SB(1, 0), cB + kstep, voffB); PG8_STAGE(PG8_SA(1, 0), cA + kstep, voffA); PG8_STAGE(PG8_SB(1, 1), cB + hstep + kstep, voffB);
        PG8_WAIT_V(6); PG8_BAR;
    } else {
        PG8_STAGE(PG8_SB(0, 0), cB, voffB); PG8_STAGE(PG8_SA(0, 0), cA, voffA); PG8_STAGE(PG8_SB(0, 1), cB + hstep, voffB); PG8_STAGE(PG8_SA(0, 1), cA + hstep, voffA);
        if (wr == 1) PG8_BAR;
        PG8_WAIT_V(4); PG8_BAR;
        PG8_STAGE(PG8_SB(1, 0), cB + kstep, voffB); PG8_STAGE(PG8_SA(1, 0), cA + kstep, voffA); PG8_STAGE(PG8_SB(1, 1), cB + hstep + kstep, voffB);
        PG8_WAIT_V(6); PG8_BAR;
    }
    for (;;) {
        const bool has_next = S.next(ui + 1, nxt);
        const char* nA = has_next ? (const char*)((Epi::CHAIN && nxt.part) ? g.A2 : g.A) + (size_t)nxt.pm * tstep + (size_t)nxt.k0 * 2 : cA; const char* nB = has_next ? (const char*)((Epi::CHAIN && nxt.part) ? g.Bt2 : g.Bt) + (size_t)nxt.pn * tstep + (size_t)nxt.k0 * 2 : cB;
        const int nt = cur.nt;
        for (int t = 0; t < nt; t += 2) {
            const bool last = (t == nt - 2);
            const char* a1 = cA + (size_t)(t + 1) * kstep;
            const char* a2 = last ? nA : cA + (size_t)(t + 2) * kstep; const char* b2 = last ? nB : cB + (size_t)(t + 2) * kstep;
            const char* a3 = a2 + kstep; const char* b3 = b2 + kstep;
            if (last && has_next) S.a_ready(nxt);
            if constexpr (SP2) {
            PG8_LDB(B0, 0, 0); PG8_LDB(B1, 0, 1); PG8_SCHED; PG8_LDA(At, 0, 0); PG8_STAGE(PG8_SA(1, 1), a1 + hstep, voffA);
            PG8_WAIT_V(8); PG8_WAIT_L(0); PG8_BAR; PG8_MMA(0, 0, At, B0); PG8_MMA(0, 1, At, B1); PG8_BAR; PG8_SCHED;
            PG8_LDA(At, 0, 1); PG8_STAGE(PG8_SB(0, 0), b2, voffB); PG8_STAGE(PG8_SB(0, 1), b2 + hstep, voffB); PG8_STAGE(PG8_SA(0, 0), a2, voffA);
            PG8_WAIT_V(8); PG8_WAIT_L(0); PG8_BAR; PG8_MMA(1, 0, At, B0); PG8_MMA(1, 1, At, B1); PG8_BAR; PG8_SCHED;
            PG8_LDB(B0, 1, 0); PG8_LDB(B1, 1, 1); PG8_SCHED; PG8_LDA(At, 1, 0); PG8_STAGE(PG8_SA(0, 1), a2 + hstep, voffA);
            PG8_WAIT_V(8); PG8_WAIT_L(0); PG8_BAR; PG8_MMA(0, 0, At, B0); PG8_MMA(0, 1, At, B1); PG8_BAR; PG8_SCHED;
            PG8_LDA(At, 1, 1); PG8_STAGE(PG8_SB(1, 0), b3, voffB); PG8_STAGE(PG8_SB(1, 1), b3 + hstep, voffB); PG8_STAGE(PG8_SA(1, 0), a3, voffA);
            PG8_WAIT_V(8); PG8_WAIT_L(0); PG8_BAR; PG8_MMA(1, 0, At, B0); PG8_MMA(1, 1, At, B1); PG8_BAR; PG8_SCHED;
            } else {
            PG8_LDB(B0, 0, 0); PG8_SCHED; PG8_LDA(At, 0, 0); PG8_STAGE(PG8_SA(1, 1), a1 + hstep, voffA);
            PG8_WAIT_L(8); PG8_BAR; PG8_WAIT_L(0); PG8_MMA(0, 0, At, B0); PG8_BAR; PG8_SCHED;
            PG8_LDB(B1, 0, 1); PG8_STAGE(PG8_SB(0, 0), b2, voffB);
            PG8_BAR; PG8_WAIT_L(0); PG8_MMA(0, 1, At, B1); PG8_BAR;
            PG8_LDA(At, 0, 1); PG8_STAGE(PG8_SA(0, 0), a2, voffA);
            PG8_BAR; PG8_WAIT_L(0); PG8_MMA(1, 0, At, B0); PG8_BAR; PG8_SCHED;
            PG8_STAGE(PG8_SB(0, 1), b2 + hstep, voffB);
            PG8_WAIT_V(6); PG8_BAR; PG8_MMA(1, 1, At, B1); PG8_BAR;
            PG8_LDB(B0, 1, 0); PG8_SCHED; PG8_LDA(At, 1, 0); PG8_STAGE(PG8_SA(0, 1), a2 + hstep, voffA);
            PG8_WAIT_L(8); PG8_BAR; PG8_WAIT_L(0); PG8_MMA(0, 0, At, B0); PG8_BAR; PG8_SCHED;
            PG8_LDB(B1, 1, 1); PG8_STAGE(PG8_SB(1, 0), b3, voffB);
            PG8_BAR; PG8_WAIT_L(0); PG8_MMA(0, 1, At, B1); PG8_BAR;
            PG8_LDA(At, 1, 1); PG8_STAGE(PG8_SA(1, 0), a3, voffA);
            PG8_BAR; PG8_WAIT_L(0); PG8_MMA(1, 0, At, B0); PG8_BAR; PG8_SCHED;
            PG8_STAGE(PG8_SB(1, 1), b3 + hstep, voffB);
            PG8_WAIT_V(6); PG8_BAR; PG8_MMA(1, 1, At, B1); PG8_BAR;
            }
        }
        if constexpr (ALIGN_EPI) { if (wr == 0) PG8_BAR; }
        const bool mid_unit = Epi::CHAIN && cur.part == 0;
        if constexpr (Epi::CHAIN) { if (mid_unit) E.mid(acc, cur, wr, wc, fr, fq); else { E(acc, cur, wr, wc, fr, fq); S.done(cur); } }
        else if constexpr (!Epi::AFTER_DRAIN) { E(acc, cur, wr, wc, fr, fq); S.done(cur); }
        if (!has_next) break;
        if (!mid_unit)
#pragma unroll
        for (int a = 0; a < 2; ++a)
#pragma unroll
            for (int b = 0; b < 2; ++b)
#pragma unroll
                for (int m = 0; m < 4; ++m)
#pragma unroll
                    for (int n = 0; n < 2; ++n) acc[a][b][m][n] = (f32x4){0.f, 0.f, 0.f, 0.f};
        cur = nxt; cA = nA; cB = nB; ++ui;
        if constexpr (ALIGN_EPI) { if (wr == 1) PG8_BAR; }
    }
    PG8_WAIT_V(0);
    if constexpr (!ALIGN_EPI) { if (wr == 0) PG8_BAR; }
    PG8_BAR;
    if constexpr (Epi::AFTER_DRAIN) { E.fused(acc, cur, wr, wc, fr, fq, lds, wid, lane); S.done(cur); }
#undef PG8_SA
#undef PG8_SB
#undef PG8_STAGE
#undef PG8_LDA
#undef PG8_LDB
#undef PG8_MMA
#undef PG8_WAIT_V
#undef PG8_WAIT_L
#undef PG8_BAR
#undef PG8_SCHED
}

template <class F>
__device__ __forceinline__ void gemm_quarter(PG8_LAS unsigned char* lds, const bf16_t* A, const bf16_t* Bt, int K, int qm, int qn, const F& f) {
    const int tid = threadIdx.x, wid = __builtin_amdgcn_readfirstlane(tid >> 6), lane = tid & 63, wr = wid >> 2, wc = wid & 3, fr = lane & 15, fq = lane >> 4;
    unsigned voffA[2], voffB[2];
#pragma unroll
    for (int i = 0; i < 2; ++i) { int R, C; stage_rc(tid * 16 + i * 8192, R, C); const int Rb = (R & ~31) + perm32(R & 31);
        voffA[i] = (unsigned)(R * K + C) * 2u; voffB[i] = (unsigned)(Rb * K + C) * 2u; }
    const size_t kstep = (size_t)(BK * 2);
    const unsigned ldsw = (unsigned)wid * 1024u;
    const int aoff = lds_byte(wr * 64 + fr, fq * 8), boff = lds_byte(wc * 32 + fr, fq * 8);
    const char* cA = (const char*)A + (size_t)qm * HALF * K * 2; const char* cB = (const char*)Bt + (size_t)qn * HALF * K * 2;
    const int nt = K / BK;
#define PG8_QSTAGE(slot, t_) do { const size_t go_ = (size_t)(t_) * kstep; _Pragma("unroll") for (int _i = 0; _i < 2; ++_i) { \
        __builtin_amdgcn_global_load_lds((const unsigned*)(cA + go_ + voffA[_i]), (PG8_LAS unsigned*)(lds + (slot) * HTB + ldsw + _i * 8192), 16, 0, 0); \
        __builtin_amdgcn_global_load_lds((const unsigned*)(cB + go_ + voffB[_i]), (PG8_LAS unsigned*)(lds + (4 + (slot)) * HTB + ldsw + _i * 8192), 16, 0, 0); } } while (0)
    f32x4 acc[4][2];
#pragma unroll
    for (int m = 0; m < 4; ++m)
#pragma unroll
        for (int n = 0; n < 2; ++n) acc[m][n] = (f32x4){0.f, 0.f, 0.f, 0.f};
    bf16x8 At[4][2], Bq[2][2];
    PG8_QSTAGE(0, 0); PG8_QSTAGE(1, 1); PG8_QSTAGE(2, 2);
    for (int t = 0; t < nt; t += 4) {
#pragma unroll
        for (int sl = 0; sl < 4; ++sl) {
            asm volatile("s_waitcnt vmcnt(8)" ::: "memory"); __builtin_amdgcn_s_barrier();
            { const int tn = t + sl + 3; PG8_QSTAGE((sl + 3) & 3, tn < nt ? tn : tn - nt); }
#pragma unroll
            for (int m = 0; m < 4; ++m)
#pragma unroll
                for (int k = 0; k < 2; ++k) At[m][k] = *(const PG8_LAS bf16x8*)(lds + sl * HTB + aoff + m * 2048 + k * 1024);
#pragma unroll
            for (int n = 0; n < 2; ++n)
#pragma unroll
                for (int k = 0; k < 2; ++k) Bq[n][k] = *(const PG8_LAS bf16x8*)(lds + (4 + sl) * HTB + boff + n * 2048 + k * 1024);
            asm volatile("s_waitcnt lgkmcnt(0)" ::: "memory");
            __builtin_amdgcn_s_setprio(1);
#pragma unroll
            for (int m = 0; m < 4; ++m)
#pragma unroll
                for (int n = 0; n < 2; ++n)
#pragma unroll
                    for (int k = 0; k < 2; ++k) acc[m][n] = __builtin_amdgcn_mfma_f32_16x16x32_bf16(Bq[n][k], At[m][k], acc[m][n], 0, 0, 0);
            __builtin_amdgcn_s_setprio(0);
            __builtin_amdgcn_sched_barrier(0);
        }
    }
    asm volatile("s_waitcnt vmcnt(0)" ::: "memory"); __builtin_amdgcn_s_barrier();
#undef PG8_QSTAGE
    const int row0 = qm * HALF + wr * 64 + fr, col0 = qn * HALF + wc * 32 + 8 * fq;
#pragma unroll
    for (int m = 0; m < 4; ++m) f(row0 + m * 16, col0, acc[m][0], acc[m][1], 0);
}
}

#ifndef PG8_SP2
#define PG8_SP2 true
#endif
#ifndef PG8_ALIGN
#define PG8_ALIGN true
#endif

constexpr int NWAVES = 8, NT = 512;
constexpr int TP = 8192, TS = 1024, T = TP + TS, D = 4096;
constexpr int SEQ = 2048, DSEQ = 8, NB = 4, NDB = 128;
constexpr int NPROJ = 20992;
constexpr int CQ = 0, CK = 1024, CV = 2048, CZG = 4096, CR = 6144, CKR = 8192, CVR = 10240, CXG = 12288, CSM = 12544, CGA = 12800, CGB = 16896;
constexpr int ZRC = 6592;
constexpr int DFF = 11008, NUP = 2 * DFF;
constexpr int NL1 = 5120;
constexpr int SCAN_REC = 896;
constexpr int SCAN_LREC = 1408;
constexpr size_t O_Y = 0, O_GLA_P = 37748736, O_RWKV_P = 39845888, O_SHIFT_P = 40370176, O_CONV_P = 40396544,
                 O_GLA_S = 40484608, O_RWKV_S = 107593472, O_SHIFT_S = 124370688, O_CONV_S = 125214464, O_END = 128032512;
constexpr size_t MiB = 1u << 20;
constexpr size_t WS_CTL = 0, CTL_ZERO_BYTES = 1 * MiB;
constexpr size_t WS_WT_IN = 1 * MiB, WS_WT_UP = 165 * MiB, WS_WT_DOWN = 337 * MiB, WS_WT_OUT = 423 * MiB, WS_WT_PEG = 455 * MiB, WS_WT_BRA = 487 * MiB,
                 WS_WT_BRB = 503 * MiB, WS_WT_PE = 519 * MiB, WS_WL1 = 521 * MiB, WS_WG = 524 * MiB, WS_H = 525 * MiB, WS_PROJ = 597 * MiB,
                 WS_SCAN = 984 * MiB, WS_G = 1380 * MiB, WS_LA = 1416 * MiB, WS_AL1 = 1452 * MiB, WS_AG = 1457 * MiB, WS_PB = 1462 * MiB,
                 WS_BONUS = 1467 * MiB, WS_END = 1469 * MiB;
constexpr size_t WS_QD = WS_H, WS_KDDT = WS_H + 16 * MiB, WS_VT = WS_H + 32 * MiB, WS_ATT = WS_H + 64 * MiB, WS_EB = WS_H + 68 * MiB;
constexpr size_t WS_RW1 = WS_WT_IN, WS_RW2 = WS_SCAN + 256 * MiB;
static_assert((size_t)NB * 32 * (SEQ / 16) * 7168 <= 164 * MiB && WS_RW2 + (size_t)NB * 32 * (SEQ / 16) * 6656 <= WS_G && (size_t)T * 32 * SCAN_REC <= 256 * MiB, "chunk operand arrays");
constexpr size_t WS_PP = WS_SCAN + 200 * MiB;
constexpr int CW_QUEUE = 64;
constexpr int CW_BAR = 4096;

constexpr int RING_BYTES = 131072, MISC_OFF = RING_BYTES + 320, LDS_BYTES = 147456;

#define LAS __attribute__((address_space(3)))
typedef unsigned short bf16;
typedef unsigned v4u __attribute__((ext_vector_type(4)));
typedef unsigned v2u __attribute__((ext_vector_type(2)));
typedef float f32x4 __attribute__((ext_vector_type(4)));
#define LDS_WAIT() asm volatile("s_waitcnt lgkmcnt(0)" ::: "memory")
#define VM_WAIT() asm volatile("s_waitcnt vmcnt(0)" ::: "memory")
#define WG_BAR() do { asm volatile("s_waitcnt lgkmcnt(0)" ::: "memory"); __builtin_amdgcn_s_barrier(); asm volatile("" ::: "memory"); } while (0)
__device__ __forceinline__ unsigned f2bf(float f) { unsigned u = __builtin_bit_cast(unsigned, f); return (u + 0x7fffu + ((u >> 16) & 1u)) >> 16; }
typedef __bf16 hw_bf2 __attribute__((ext_vector_type(2)));
typedef float hw_f2 __attribute__((ext_vector_type(2)));
__device__ __forceinline__ unsigned pk2(float lo, float hi) { const hw_f2 v = {lo, hi}; return __builtin_bit_cast(unsigned, __builtin_convertvector(v, hw_bf2)); }
__device__ __forceinline__ float bf2f(unsigned b) { return __builtin_bit_cast(float, b << 16); }
__device__ __forceinline__ float bflo(unsigned w) { return __builtin_bit_cast(float, w << 16); }
__device__ __forceinline__ float bfhi(unsigned w) { return __builtin_bit_cast(float, w & 0xffff0000u); }
__device__ __forceinline__ float sigmoidf_(float x) { return __builtin_amdgcn_rcpf(1.0f + __builtin_amdgcn_exp2f(x * -1.4426950408889634f)); }
__device__ __forceinline__ float softplusf_(float x) { return fmaxf(x, 0.f) + 0.6931471805599453f * __builtin_amdgcn_logf(1.0f + __builtin_amdgcn_exp2f(fabsf(x) * -1.4426950408889634f)); }
__device__ __forceinline__ float wave_sum(float v) {
#pragma unroll
    for (int o = 1; o < 64; o <<= 1) v += __shfl_xor(v, o);
    return v;
}

#define XB_TMO      128
#define XB_XCNT(j)  (256  + 64 * (j))
#define XB_XSUB(j)  (1280 + 64 * (j))
#define XB_XGEN(j)  (2304 + 64 * (j))
#define XB_TOP      3328
#define XB_TOPGEN   3392
#define XCD_BAR_WORDS 3456
#define XB_SPIN_CAP (1u << 23)
__device__ __forceinline__ unsigned xb_ld(unsigned* p)              { return __hip_atomic_load(p, __ATOMIC_RELAXED, __HIP_MEMORY_SCOPE_AGENT); }
__device__ __forceinline__ unsigned xb_add(unsigned* p, unsigned v) { return __hip_atomic_fetch_add(p, v, __ATOMIC_RELAXED, __HIP_MEMORY_SCOPE_AGENT); }
__device__ __forceinline__ unsigned xb_xcc_id() { return (unsigned)__builtin_amdgcn_s_getreg((3 << 11) | 20) & 0xFu; }
#define XB_SPIN(cond, bar) do { unsigned _sp = 0; while (cond) { __builtin_amdgcn_s_sleep(1); \
    if ((++_sp & 255u) == 0u) { if (xb_ld(&(bar)[XB_TMO])) break; if (_sp > XB_SPIN_CAP) { atomicAdd(&(bar)[XB_TMO], 1u); break; } } } } while (0)
struct XcdBarrier { unsigned* bar; unsigned x; volatile LAS unsigned* st; };
__device__ __forceinline__ XcdBarrier xcd_barrier_post(unsigned* bar, volatile LAS unsigned* st) {
    XcdBarrier b; b.bar = bar; b.x = xb_xcc_id(); b.st = st;
    if (threadIdx.x == 0) (void)xb_add(&bar[XB_XCNT(b.x)], 1u);
    return b;
}
__device__ __forceinline__ void xcd_barrier_complete(unsigned* bar, unsigned x, unsigned& nloc, unsigned& nx) {
    const unsigned G = gridDim.x * gridDim.y * gridDim.z;
    unsigned sum, cnt, mine, sp = 0u;
    for (;;) {
        sum = 0u; cnt = 0u; mine = 0u;
#pragma unroll
        for (unsigned j = 0; j < 16; ++j) { const unsigned c = xb_ld(&bar[XB_XCNT(j)]); sum += c; cnt += (c > 0u) ? 1u : 0u; mine = (j == x) ? c : mine; }
        if (sum == G) break;
        __builtin_amdgcn_s_sleep(1);
        if ((++sp & 255u) == 0u) { if (xb_ld(&bar[XB_TMO])) break; if (sp > XB_SPIN_CAP) { atomicAdd(&bar[XB_TMO], 1u); break; } }
    }
    nloc = mine > 0u ? mine : 1u; nx = cnt > 0u ? cnt : 1u;
}
__device__ __forceinline__ void xcd_barrier(const XcdBarrier& b) {
    asm volatile("s_waitcnt vmcnt(0)" ::: "memory");
    __syncthreads();
    if (threadIdx.x == 0) {
        unsigned* bar = b.bar;
        __builtin_amdgcn_s_waitcnt(0);
        unsigned nloc = b.st[0], nx = b.st[1];
        if (nloc == 0u) { xcd_barrier_complete(bar, b.x, nloc, nx); b.st[0] = nloc; b.st[1] = nx; }
        const unsigned old = xb_add(&bar[XB_XSUB(b.x)], 1u);
        const unsigned gen = old / nloc;
        if (old + 1u == (gen + 1u) * nloc) {
            __builtin_amdgcn_fence(__ATOMIC_RELEASE, "agent");
            asm volatile("s_waitcnt vmcnt(0)" ::: "memory");
            const unsigned og = xb_add(&bar[XB_TOP], 1u);
            const unsigned tg = og / nx;
            if (og + 1u == (tg + 1u) * nx) xb_add(&bar[XB_TOPGEN], 1u);
            else XB_SPIN(xb_ld(&bar[XB_TOPGEN]) == tg, bar);
            __builtin_amdgcn_fence(__ATOMIC_ACQUIRE, "agent");
            xb_add(&bar[XB_XGEN(b.x)], 1u);
            asm volatile("s_waitcnt vmcnt(0)" ::: "memory");
        } else {
            XB_SPIN(xb_ld(&bar[XB_XGEN(b.x)]) == gen, bar);
            __builtin_amdgcn_fence(__ATOMIC_ACQUIRE, "agent");
            asm volatile("s_waitcnt vmcnt(0)" ::: "memory");
        }
    }
    __syncthreads();
}

struct Args { const float* in[37]; float* out; unsigned char* ws; int ph_lo, ph_hi; };
typedef __attribute__((address_space(4))) const Args KArgs;
struct Frame { LAS unsigned char* lds; int tid, lane, wave, vcu, G, gw, NGW; };
enum { I_XP = 0, I_XS, I_SGLA, I_SRWKV, I_SSHIFT, I_SCONV, I_PP, I_PS, I_WIN, I_WALPHA2, I_BALPHA, I_GLANORM, I_WBRA, I_MU, I_W0, I_WDECAY2, I_A0, I_WICLR2,
       I_WGATE2, I_KK, I_KA, I_RK, I_LNXW, I_LNXB, I_WBRB, I_WOUT, I_GPREMIX, I_GPOSTMIX, I_GPREFFN, I_GPOSTFFN, I_WUP, I_CONVW, I_CONVB, I_WDOWN, I_GPE, I_WPEG, I_WPE };

struct SeqPos { int b, t, L; bool prm; };
__device__ __forceinline__ SeqPos seqpos(int m) { SeqPos s; s.prm = m < TP; if (s.prm) { s.b = m >> 11; s.t = m & 2047; s.L = SEQ; } else { s.b = (m - TP) >> 3; s.t = (m - TP) & 7; s.L = DSEQ; } return s; }
__device__ __forceinline__ const float* xrow(KArgs& a, int m) { return m < TP ? a.in[I_XP] + (size_t)m * D : a.in[I_XS] + (size_t)(m - TP) * D; }

__host__ __device__ __forceinline__ int win_src16(int g) {
    const int n = g * 16;
    if (n < 4096) return n;
    if (n < 6144) return 4112 + (n - 4096);
    if (n < 8192) return 6160 + (n - 6144);
    if (n < 10240) return 8304 + (n - 8192);
    if (n < 12288) return 10352 + (n - 10240);
    if (n < 12544) return 12496 + (n - 12288);
    if (n < 12560) return 4096;
    if (n < 12656) return 8208 + (n - 12560);
    if (n < 12752) return 12400 + (n - 12656);
    if (n < 12800) return -1;
    if (n < 16896) return 12752 + (n - 12800);
    return 16848 + (n - 16896);
}
__host__ __device__ __forceinline__ int zr_col(int oz) {
    if (oz < 2048) return CR + oz;
    if (oz < 2144) return CSM + 16 + (oz - 2048);
    if (oz < 4192) return CKR + (oz - 2144);
    if (oz < 6240) return CVR + (oz - 4192);
    if (oz < 6336) return CSM + 112 + (oz - 6240);
    return CXG + (oz - 6336);
}

struct TrDesc { const float* W; bf16* WT; int K, Nsrc, nblk, item; bool map; };
__device__ __forceinline__ void tr_load(const TrDesc& d, float (&tv)[32], int lane) {
    const int kb = d.item / d.nblk, nb = d.item - kb * d.nblk, k0 = 64 * kb, n0 = 32 * nb, nl = lane & 31;
    int sc = n0 + nl;
    if (d.map) { const int s = win_src16((n0 + nl) >> 4); sc = s < 0 ? -1 : s + (nl & 15); }
    const float* wp = d.W + (size_t)(k0 + (lane >> 5)) * d.Nsrc + (sc >= 0 ? sc : 0);
#pragma unroll
    for (int i = 0; i < 32; ++i) tv[i] = __builtin_nontemporal_load(wp + (size_t)(2 * i) * d.Nsrc);
}
__device__ __forceinline__ void tr_finish(const TrDesc& d, const float (&tv)[32], LAS float* scr, int lane) {
    const int kb = d.item / d.nblk, nb = d.item - kb * d.nblk, k0 = 64 * kb, n0 = 32 * nb, nl = lane & 31;
    bool pad = false;
    if (d.map) pad = win_src16((n0 + nl) >> 4) < 0;
#pragma unroll
    for (int i = 0; i < 32; ++i) scr[(2 * i + (lane >> 5)) * 33 + nl] = pad ? 0.f : tv[i];
    LDS_WAIT(); asm volatile("" ::: "memory");
    const int c = lane & 7;
#pragma unroll
    for (int j = 0; j < 4; ++j) { const int n = (lane >> 3) + 8 * j; const LAS float* s = scr + (8 * c) * 33 + n;
        v4u o; o.x = pk2(s[0 * 33], s[1 * 33]); o.y = pk2(s[2 * 33], s[3 * 33]); o.z = pk2(s[4 * 33], s[5 * 33]); o.w = pk2(s[6 * 33], s[7 * 33]);
        *(v4u*)(d.WT + (size_t)(n0 + n) * d.K + k0 + 8 * c) = o; }
    LDS_WAIT(); asm volatile("" ::: "memory");
}
__device__ __forceinline__ void rms_row_bf16(const float* xr_, const float* gain, bf16* orow, int lane) {
    const f32x4* xr = (const f32x4*)xr_ + lane; f32x4 v[16]; float ss = 0.f;
#pragma unroll
    for (int j = 0; j < 16; ++j) { v[j] = xr[64 * j]; ss += (v[j].x * v[j].x + v[j].y * v[j].y) + (v[j].z * v[j].z + v[j].w * v[j].w); }
    const float rs = __builtin_amdgcn_rsqf(wave_sum(ss) * (1.f / D) + 1e-6f);
    const f32x4* gr = (const f32x4*)gain + lane; v2u* o = (v2u*)orow + lane;
#pragma unroll
    for (int j = 0; j < 16; ++j) { const f32x4 g = gr[64 * j]; v2u w; w.x = pk2(v[j].x * rs * g.x, v[j].y * rs * g.y); w.y = pk2(v[j].z * rs * g.z, v[j].w * rs * g.w); o[64 * j] = w; }
}
__device__ __forceinline__ void sandwich_row(const float* srow, const bf16* brow, const float* slabrow, size_t slab_stride, int nslab, const float* xi, const float* g1, float* xo, const float* g2, bf16* ho, int lane) {
    f32x4 v[16]; float ss = 0.f;
    if (brow) { const v2u* br = (const v2u*)brow + lane;
#pragma unroll
        for (int j = 0; j < 16; ++j) { const v2u x = br[64 * j]; v[j] = (f32x4){bflo(x.x), bfhi(x.x), bflo(x.y), bfhi(x.y)}; } }
    else { const f32x4* sr = (const f32x4*)srow + lane;
#pragma unroll
        for (int j = 0; j < 16; ++j) v[j] = sr[64 * j]; }
    for (int p = 0; p < nslab; ++p) { const f32x4* pr = (const f32x4*)(slabrow + (size_t)p * slab_stride) + lane;
#pragma unroll
        for (int j = 0; j < 16; ++j) v[j] += pr[64 * j]; }
#pragma unroll
    for (int j = 0; j < 16; ++j) { ss += (v[j].x * v[j].x + v[j].y * v[j].y) + (v[j].z * v[j].z + v[j].w * v[j].w); }
    const float rs = __builtin_amdgcn_rsqf(wave_sum(ss) * (1.f / D) + 1e-6f);
    const f32x4* xr = (const f32x4*)xi + lane; const f32x4* gr = (const f32x4*)g1 + lane; f32x4* xw = (f32x4*)xo + lane; float s2 = 0.f;
#pragma unroll
    for (int j = 0; j < 16; ++j) { const f32x4 x = xr[64 * j], g = gr[64 * j]; v[j] = x + v[j] * rs * g; xw[64 * j] = v[j]; s2 += (v[j].x * v[j].x + v[j].y * v[j].y) + (v[j].z * v[j].z + v[j].w * v[j].w); }
    const float r2 = __builtin_amdgcn_rsqf(wave_sum(s2) * (1.f / D) + 1e-6f);
    const f32x4* g2r = (const f32x4*)g2 + lane; v2u* o = (v2u*)ho + lane;
#pragma unroll
    for (int j = 0; j < 16; ++j) { const f32x4 g = g2r[64 * j]; v2u w; w.x = pk2(v[j].x * r2 * g.x, v[j].y * r2 * g.y); w.y = pk2(v[j].z * r2 * g.z, v[j].w * r2 * g.w); o[64 * j] = w; }
}

struct FStoreBf16 { bf16* O; int ld;
    __device__ __forceinline__ void operator()(int row, int col, f32x4 v0, f32x4 v1, int) const {
        v4u w; w.x = pg8::cvt_pk_bf16(v0[0], v0[1]); w.y = pg8::cvt_pk_bf16(v0[2], v0[3]); w.z = pg8::cvt_pk_bf16(v1[0], v1[1]); w.w = pg8::cvt_pk_bf16(v1[2], v1[3]);
        __builtin_nontemporal_store(w, (v4u*)(O + (size_t)row * ld + col)); } };
struct FStoreF32Split { float* O; int ld; float* slab; int row0; size_t slab_stride; bf16* Ob;
    __device__ __forceinline__ void operator()(int row, int col, f32x4 v0, f32x4 v1, int part) const {
        if (row < row0) { v4u w; w.x = pg8::cvt_pk_bf16(v0[0], v0[1]); w.y = pg8::cvt_pk_bf16(v0[2], v0[3]); w.z = pg8::cvt_pk_bf16(v1[0], v1[1]); w.w = pg8::cvt_pk_bf16(v1[2], v1[3]); *(v4u*)(Ob + (size_t)row * ld + col) = w; return; }
        float* p = part == 0 ? O + (size_t)row * ld + col : slab + (size_t)(part - 1) * slab_stride + (size_t)(row - row0) * ld + col; *(f32x4*)p = v0; *(f32x4*)(p + 4) = v1; } };
struct FStoreF32 { float* O; int ld;
    __device__ __forceinline__ void operator()(int row, int col, f32x4 v0, f32x4 v1, int) const { float* p = O + (size_t)row * ld + col; *(f32x4*)p = v0; *(f32x4*)(p + 4) = v1; } };
struct FBrA { const bf16* proj; float* tmp;
    __device__ __forceinline__ void operator()(int row, int col, f32x4 v0, f32x4 v1, int) const {
        const v4u g = *(const v4u*)(proj + (size_t)row * NPROJ + CGA + col);
        f32x4 s0 = {sigmoidf_(bflo(g.x)), sigmoidf_(bfhi(g.x)), sigmoidf_(bflo(g.y)), sigmoidf_(bfhi(g.y))}, s1 = {sigmoidf_(bflo(g.z)), sigmoidf_(bfhi(g.z)), sigmoidf_(bflo(g.w)), sigmoidf_(bfhi(g.w))};
        float* p = tmp + (size_t)row * D + col; *(f32x4*)p = s0 * v0; *(f32x4*)(p + 4) = s1 * v1; } };
struct FBrB { const bf16* proj; const float* tmp; bf16* mixed;
    __device__ __forceinline__ void operator()(int row, int col, f32x4 v0, f32x4 v1, int) const {
        const v4u g = *(const v4u*)(proj + (size_t)row * NPROJ + CGB + col);
        f32x4 s0 = {sigmoidf_(bflo(g.x)), sigmoidf_(bfhi(g.x)), sigmoidf_(bflo(g.y)), sigmoidf_(bfhi(g.y))}, s1 = {sigmoidf_(bflo(g.z)), sigmoidf_(bfhi(g.z)), sigmoidf_(bflo(g.w)), sigmoidf_(bfhi(g.w))};
        const float* p = tmp + (size_t)row * D + col; const f32x4 a0 = *(const f32x4*)p + s0 * v0, a1 = *(const f32x4*)(p + 4) + s1 * v1;
        v4u w; w.x = pg8::cvt_pk_bf16(a0[0], a0[1]); w.y = pg8::cvt_pk_bf16(a0[2], a0[3]); w.z = pg8::cvt_pk_bf16(a1[0], a1[1]); w.w = pg8::cvt_pk_bf16(a1[2], a1[3]);
        *(v4u*)(mixed + (size_t)row * D + col) = w; } };
struct FPeg { float* y; const bf16* pp;
    __device__ __forceinline__ void operator()(int row, int col, f32x4 v0, f32x4 v1, int) const {
        const v4u g = *(const v4u*)(pp + (size_t)row * D + col); float* p = y + (size_t)row * D + col;
        const f32x4 p0 = {bflo(g.x), bfhi(g.x), bflo(g.y), bfhi(g.y)}, p1 = {bflo(g.z), bfhi(g.z), bflo(g.w), bfhi(g.w)};
        f32x4 s0 = {sigmoidf_(v0[0]), sigmoidf_(v0[1]), sigmoidf_(v0[2]), sigmoidf_(v0[3])}, s1 = {sigmoidf_(v1[0]), sigmoidf_(v1[1]), sigmoidf_(v1[2]), sigmoidf_(v1[3])};
        *(f32x4*)p = *(const f32x4*)p + s0 * p0; *(f32x4*)(p + 4) = *(const f32x4*)(p + 4) + s1 * p1; } };

template <class F> __device__ __forceinline__ void run_gemm(Frame& F_, const bf16* A, const bf16* Bt, int M, int N, int K, const F& f) {
    pg8::Gemm g{A, Bt, M, N, K, nullptr, nullptr}; pg8::StaticOrder S; S.init(M, N, K, F_.G, (int)blockIdx.x);
    pg8::EpiRow8<F> E{f};
    pg8::gemm_phase<pg8::EpiRow8<F>, pg8::StaticOrder, PG8_ALIGN, PG8_SP2>(F_.lds, g, S, E);
}

struct FBranch { const bf16* proj; bf16* mixed;
    __device__ __forceinline__ void mid(int row, int col, f32x4& v0, f32x4& v1) const {
        const v4u ga = *(const v4u*)(proj + (size_t)row * NPROJ + CGA + col), gb = *(const v4u*)(proj + (size_t)row * NPROJ + CGB + col);
        const float a[8] = {bflo(ga.x), bfhi(ga.x), bflo(ga.y), bfhi(ga.y), bflo(ga.z), bfhi(ga.z), bflo(ga.w), bfhi(ga.w)}, b[8] = {bflo(gb.x), bfhi(gb.x), bflo(gb.y), bfhi(gb.y), bflo(gb.z), bfhi(gb.z), bflo(gb.w), bfhi(gb.w)};
#pragma unroll
        for (int e = 0; e < 4; ++e) { v0[e] *= (1.0f + __expf(-b[e])) * __builtin_amdgcn_rcpf(1.0f + __expf(-a[e])); v1[e] *= (1.0f + __expf(-b[4 + e])) * __builtin_amdgcn_rcpf(1.0f + __expf(-a[4 + e])); } }
    __device__ __forceinline__ void operator()(int row, int col, f32x4 v0, f32x4 v1, int) const {
        const v4u g = *(const v4u*)(proj + (size_t)row * NPROJ + CGB + col);
        const f32x4 s0 = {sigmoidf_(bflo(g.x)), sigmoidf_(bfhi(g.x)), sigmoidf_(bflo(g.y)), sigmoidf_(bfhi(g.y))}, s1 = {sigmoidf_(bflo(g.z)), sigmoidf_(bfhi(g.z)), sigmoidf_(bflo(g.w)), sigmoidf_(bfhi(g.w))};
        const f32x4 a0 = s0 * v0, a1 = s1 * v1;
        v4u w; w.x = pg8::cvt_pk_bf16(a0[0], a0[1]); w.y = pg8::cvt_pk_bf16(a0[2], a0[3]); w.z = pg8::cvt_pk_bf16(a1[0], a1[1]); w.w = pg8::cvt_pk_bf16(a1[2], a1[3]);
        *(v4u*)(mixed + (size_t)row * D + col) = w; } };
template <class F> __device__ __forceinline__ void run_gemm_chain(Frame& F_, const bf16* A, const bf16* Bt, const bf16* A2, const bf16* Bt2, int M, int N, int K, const F& f) {
    pg8::Gemm g{A, Bt, M, N, K, A2, Bt2}; pg8::ChainOrder S; S.init(M, N, K, F_.G, (int)blockIdx.x);
    pg8::EpiRow8Chain<F> E{f};
    pg8::gemm_phase<pg8::EpiRow8Chain<F>, pg8::ChainOrder, PG8_ALIGN, PG8_SP2>(F_.lds, g, S, E);
}
template <class F> __device__ __forceinline__ void run_gemm_lim(Frame& F_, const bf16* A, const bf16* Bt, int M, int N, int K, const F& f, int lim) {
    pg8::Gemm g{A, Bt, M, N, K, nullptr, nullptr}; pg8::StaticOrder S; S.init(M, N, K, F_.G, (int)blockIdx.x); S.lim = lim;
    pg8::EpiRow8<F> E{f};
    pg8::gemm_phase<pg8::EpiRow8<F>, pg8::StaticOrder, PG8_ALIGN, PG8_SP2>(F_.lds, g, S, E);
}
template <class F> __device__ __forceinline__ void run_gemm_gc(Frame& F_, const bf16* A, const bf16* Bt, int M, int N, int K, const F& f, int G, int c) {
    pg8::Gemm g{A, Bt, M, N, K, nullptr, nullptr}; pg8::StaticOrder S; S.init(M, N, K, G, c);
    pg8::EpiRow8<F> E{f};
    pg8::gemm_phase<pg8::EpiRow8<F>, pg8::StaticOrder, PG8_ALIGN, PG8_SP2>(F_.lds, g, S, E);
}
template <class F> __device__ __forceinline__ void run_gemm_split(Frame& F_, const bf16* A, const bf16* Bt, int M, int N, int K, const F& f) {
    pg8::Gemm g{A, Bt, M, N, K, nullptr, nullptr}; pg8::SplitOrder S; S.init(M, N, K, F_.G, (int)blockIdx.x);
    pg8::EpiRow8<F> E{f};
    pg8::gemm_phase<pg8::EpiRow8<F>, pg8::SplitOrder, PG8_ALIGN, PG8_SP2>(F_.lds, g, S, E);
}

typedef float f32x2 __attribute__((ext_vector_type(2)));
__device__ __forceinline__ float dpp_f(float x, int ctrl_sel) {
    const int v = __builtin_bit_cast(int, x); int r;
    if (ctrl_sel == 0) r = __builtin_amdgcn_update_dpp(v, v, 0xB1, 0xF, 0xF, false);
    else if (ctrl_sel == 1) r = __builtin_amdgcn_update_dpp(v, v, 0x4E, 0xF, 0xF, false);
    else r = __builtin_amdgcn_update_dpp(v, v, 0x141, 0xF, 0xF, false);
    return __builtin_bit_cast(float, r);
}
__device__ __forceinline__ float sum8(float x) {
    float a, b, c;
    asm volatile("s_nop 1\n\tv_add_f32_dpp %0, %1, %1 quad_perm:[1,0,3,2] row_mask:0xf bank_mask:0xf" : "=v"(a) : "v"(x));
    asm volatile("s_nop 1\n\tv_add_f32_dpp %0, %1, %1 quad_perm:[2,3,0,1] row_mask:0xf bank_mask:0xf" : "=v"(b) : "v"(a));
    asm volatile("s_nop 1\n\tv_add_f32_dpp %0, %1, %1 row_half_mirror row_mask:0xf bank_mask:0xf" : "=v"(c) : "v"(b));
    return c;
}
template <int HEADS>
__device__ __forceinline__ void rwkv_unit(Frame& F, const unsigned char* scan, int m0, int L, int h, const float* S0, float* Sout, float* OB) {
    constexpr int TB = 16, RB = SCAN_LREC, RG = SCAN_REC, PCS = RG / 16, NPC = (TB * PCS + 511) / 512;
    LAS unsigned char* buf = F.lds;
    const int tid = F.tid, v = tid >> 3, j = tid & 7;
    f32x2 S[4];
    if (S0) { const f32x4 a = *(const f32x4*)(S0 + v * 64 + 8 * j), b = *(const f32x4*)(S0 + v * 64 + 8 * j + 4); S[0] = (f32x2){a.x, a.y}; S[1] = (f32x2){a.z, a.w}; S[2] = (f32x2){b.x, b.y}; S[3] = (f32x2){b.z, b.w}; }
    else {
#pragma unroll
        for (int i = 0; i < 4; ++i) S[i] = (f32x2){0.f, 0.f}; }
    const int nst = L < TB ? L : TB, nblk = HEADS ? HEADS : L / nst, nch = nst * PCS;
    constexpr int DUMMY = 2 * TB * RB;
    int goff[NPC], lo0[NPC], lo1[NPC]; bool cv[NPC];
#pragma unroll
    for (int i = 0; i < NPC; ++i) { const int c = tid + 512 * i; const bool valid = c < nch; const int cc = valid ? c : 0, st = cc / PCS, p = cc - st * PCS; goff[i] = st * 32 * RG + p * 16;
        const int lo = st * RB + (p < 16 ? p * 16 : (p < 48 ? 256 + (p - 16) * 32 : 1280 + (p - 48) * 16)); cv[i] = p >= 16 && p < 48;
        lo0[i] = valid ? lo : -1; lo1[i] = (valid && cv[i]) ? lo + 16 : -1; }
    const unsigned char* gsrc = scan + ((size_t)m0 * 32 + h) * RG;
    const size_t bstep = HEADS ? (size_t)RG : (size_t)nst * 32 * RG;
#define RW_PUT(bo_, i_) do { const v4u x_ = pre[i_]; const f32x4 c0_ = {bflo(x_.x), bfhi(x_.x), bflo(x_.y), bfhi(x_.y)}, c1_ = {bflo(x_.z), bfhi(x_.z), bflo(x_.w), bfhi(x_.w)}; \
        *(LAS v4u*)(buf + (lo0[i_] >= 0 ? (bo_) + lo0[i_] : DUMMY)) = cv[i_] ? __builtin_bit_cast(v4u, c0_) : x_; *(LAS f32x4*)(buf + (lo1[i_] >= 0 ? (bo_) + lo1[i_] : DUMMY + 16)) = c1_; } while (0)
    LAS float* obuf = (LAS float*)(buf + DUMMY + 64); float* obg = OB + (size_t)m0 * 2048 + h * 64;
    v4u pre[NPC], prf[NPC];
    __syncthreads();
#pragma unroll
    for (int i = 0; i < NPC; ++i) pre[i] = *(const v4u*)(gsrc + goff[i]);
#pragma unroll
    for (int i = 0; i < NPC; ++i) RW_PUT(0, i);
    { const unsigned char* g1 = gsrc + (nblk > 1 ? bstep : 0);
#pragma unroll
      for (int i = 0; i < NPC; ++i) prf[i] = *(const v4u*)(g1 + goff[i]); }
    WG_BAR();
#define RW_LD(dst, rec_) do { const LAS unsigned char* r_ = (rec_); dst[0] = *(const LAS f32x4*)(r_); dst[1] = *(const LAS f32x4*)(r_ + 16); dst[2] = *(const LAS f32x4*)(r_ + 256); dst[3] = *(const LAS f32x4*)(r_ + 272); \
            dst[4] = *(const LAS f32x4*)(r_ + 512); dst[5] = *(const LAS f32x4*)(r_ + 528); dst[6] = *(const LAS f32x4*)(r_ + 768); dst[7] = *(const LAS f32x4*)(r_ + 784); dst[8] = *(const LAS f32x4*)(r_ + 1024); dst[9] = *(const LAS f32x4*)(r_ + 1040); } while (0)
    auto do_block = [&](int blk, v4u (&ld)[NPC], v4u (&use)[NPC]) {
        { const int b2 = blk + 2 < nblk ? blk + 2 : nblk - 1; const unsigned char* g2 = gsrc + (size_t)b2 * bstep;
#pragma unroll
          for (int i = 0; i < NPC; ++i) ld[i] = *(const v4u*)(g2 + goff[i]); }
        f32x4 na = {0.f, 0.f, 0.f, 0.f}, nb = na;
        if (HEADS) { const float* sn = S0 + (size_t)(blk + 1 < nblk ? blk + 1 : blk) * 4096 + v * 64 + 8 * j; na = *(const f32x4*)sn; nb = *(const f32x4*)(sn + 4); }
        const LAS unsigned char* cb = buf + (blk & 1) * (TB * RB) + 32 * j;
        f32x4 X[10], Y[10]; unsigned xv, yv;
        RW_LD(X, cb); xv = *(const LAS bf16*)(cb - 32 * j + 1280 + 2 * v);
#pragma unroll 2
        for (int s = 0; s < nst; ++s) {
            const LAS unsigned char* rn = cb + (s + 1 < nst ? s + 1 : s) * RB;
            yv = *(const LAS bf16*)(rn - 32 * j + 1280 + 2 * v); RW_LD(Y, rn);
            const float vv = bf2f(xv);
            const f32x2 W[4] = {{X[0].x, X[0].y}, {X[0].z, X[0].w}, {X[1].x, X[1].y}, {X[1].z, X[1].w}}, R[4] = {{X[2].x, X[2].y}, {X[2].z, X[2].w}, {X[3].x, X[3].y}, {X[3].z, X[3].w}}, K[4] = {{X[4].x, X[4].y}, {X[4].z, X[4].w}, {X[5].x, X[5].y}, {X[5].z, X[5].w}},
                        N[4] = {{X[6].x, X[6].y}, {X[6].z, X[6].w}, {X[7].x, X[7].y}, {X[7].z, X[7].w}}, A[4] = {{X[8].x, X[8].y}, {X[8].z, X[8].w}, {X[9].x, X[9].y}, {X[9].z, X[9].w}};
            f32x2 p = (S[0] * N[0] + S[1] * N[1]) + (S[2] * N[2] + S[3] * N[3]);
            const float sa = sum8(p.x + p.y);
            const f32x2 sa2 = {sa, sa}, vv2 = {vv, vv};
#pragma unroll
            for (int i = 0; i < 4; ++i) S[i] = S[i] * W[i] + sa2 * A[i] + vv2 * K[i];
            f32x2 q = (S[0] * R[0] + S[1] * R[1]) + (S[2] * R[2] + S[3] * R[3]);
            const float o = sum8(q.x + q.y);
            obuf[(blk & 1) * (TB * 64) + s * 64 + v] = o;
#pragma unroll
            for (int i = 0; i < 10; ++i) X[i] = Y[i];
            xv = yv;
        }
        if (HEADS) { float* so = Sout + (size_t)blk * 4096 + v * 64 + 8 * j; *(f32x4*)so = (f32x4){S[0].x, S[0].y, S[1].x, S[1].y}; *(f32x4*)(so + 4) = (f32x4){S[2].x, S[2].y, S[3].x, S[3].y};
            S[0] = (f32x2){na.x, na.y}; S[1] = (f32x2){na.z, na.w}; S[2] = (f32x2){nb.x, nb.y}; S[3] = (f32x2){nb.z, nb.w}; }
        { const int nbo = ((blk + 1) & 1) * (TB * RB);
#pragma unroll
          for (int i = 0; i < NPC; ++i) asm volatile("" : "+v"(use[i]));
#pragma unroll
          for (int i = 0; i < NPC; ++i) { pre[i] = use[i]; RW_PUT(nbo, i); } }
        WG_BAR();
        if (tid < nst * 16) { const int s = tid >> 4, c4 = (tid & 15) * 4; *(f32x4*)(obg + (HEADS ? (size_t)s * 2048 + blk * 64 : (size_t)(blk * nst + s) * 2048) + c4) = *(const LAS f32x4*)(obuf + (blk & 1) * (TB * 64) + s * 64 + c4); }
    };
    v4u prg[NPC];
    for (int blk = 0; blk < nblk; blk += 2) {
        do_block(blk, prg, prf);
        if (blk + 1 < nblk) do_block(blk + 1, prf, prg);
    }
#undef RW_LD
    if (!HEADS) { f32x4 a = {S[0].x, S[0].y, S[1].x, S[1].y}, b = {S[2].x, S[2].y, S[3].x, S[3].y};
        *(f32x4*)(Sout + v * 64 + 8 * j) = a; *(f32x4*)(Sout + v * 64 + 8 * j + 4) = b; }
#undef RW_PUT
}

typedef short bf16x8v __attribute__((ext_vector_type(8)));
constexpr int RW_C = 16, RW_NCH = SEQ / RW_C, RW_A1 = 7168, RW_A2 = 6656, RW_LSTR = 72;
struct RwRec { float wv[16]; unsigned rr[16], kx[16], nn[16], aa[16], vx[16]; };
template <int T0, int T1>
__device__ __forceinline__ void rw_prep_load(RwRec& R, int lane, const unsigned char* scan, int m_base, int h) {
    const int key = lane; const unsigned char* rec0 = scan + ((size_t)m_base * 32 + h) * SCAN_REC;
    float (&wv)[16] = R.wv; unsigned (&rr)[16] = R.rr, (&kx)[16] = R.kx, (&nn)[16] = R.nn, (&aa)[16] = R.aa, (&vx)[16] = R.vx;
#pragma unroll
    for (int t = T0; t < T1; ++t) { const unsigned char* rec = rec0 + (size_t)t * 32 * SCAN_REC; wv[t] = *(const float*)(rec + 4 * key); rr[t] = *(const bf16*)(rec + 256 + 2 * key); kx[t] = *(const bf16*)(rec + 384 + 2 * key);
        nn[t] = *(const bf16*)(rec + 512 + 2 * key); aa[t] = *(const bf16*)(rec + 640 + 2 * key); vx[t] = *(const bf16*)(rec + 768 + 2 * key); }
}
__device__ __forceinline__ void rw_prep_a(const RwRec& R, LAS unsigned char* wl, int lane, unsigned char* a2) {
    LAS bf16* rowA = (LAS bf16*)wl; LAS bf16* rowR = rowA + 16 * RW_LSTR; LAS bf16* rowB = rowR + 16 * RW_LSTR; LAS bf16* rowK = rowB + 16 * RW_LSTR; LAS float* Ns = (LAS float*)(wl + 9216);
    const int key = lane, r16 = lane & 15, q = lane >> 4;
    (void)Ns; (void)r16; (void)q;
    const float (&wv)[16] = R.wv; const unsigned (&rr)[16] = R.rr, (&kx)[16] = R.kx, (&nn)[16] = R.nn, (&aa)[16] = R.aa, (&vx)[16] = R.vx;
    float cum[16]; float run = 0.f;
#pragma unroll
    for (int t = 0; t < 16; ++t) { const float cprev = run; run += __builtin_amdgcn_logf(wv[t]); cum[t] = run;
        const float g = __builtin_amdgcn_exp2f(run), gi = __builtin_amdgcn_exp2f(-run), gp = __builtin_amdgcn_exp2f(cprev);
        const unsigned ar = pk2(bf2f(nn[t]) * gp, bf2f(rr[t]) * g), bk = pk2(bf2f(aa[t]) * gi, bf2f(kx[t]) * gi);
        rowA[t * RW_LSTR + key] = (bf16)ar; rowR[t * RW_LSTR + key] = (bf16)(ar >> 16); rowB[t * RW_LSTR + key] = (bf16)bk; rowK[t * RW_LSTR + key] = (bf16)(bk >> 16); }
    {
        unsigned bgp[8], kgp[8], vp[8];
#pragma unroll
        for (int j = 0; j < 8; ++j) { const float e0 = __builtin_amdgcn_exp2f(run - cum[2 * j]), e1 = __builtin_amdgcn_exp2f(run - cum[2 * j + 1]);
            bgp[j] = pk2(bf2f(aa[2 * j]) * e0, bf2f(aa[2 * j + 1]) * e1); kgp[j] = pk2(bf2f(kx[2 * j]) * e0, bf2f(kx[2 * j + 1]) * e1); vp[j] = vx[2 * j] | (vx[2 * j + 1] << 16); }
        unsigned char* sb = a2 + (key >> 4) * 1024 + (key & 15) * 16;
#pragma unroll
        for (int kq = 0; kq < 4; ++kq) { v4u o; o.x = bgp[2 * kq]; o.y = bgp[2 * kq + 1]; o.z = kgp[2 * kq]; o.w = kgp[2 * kq + 1]; *(v4u*)(sb + kq * 256) = o; }
        *(float*)(a2 + 4096 + 4 * key) = __builtin_amdgcn_exp2f(run);
        v4u o0, o1; o0.x = vp[0]; o0.y = vp[1]; o0.z = vp[2]; o0.w = vp[3]; o1.x = vp[4]; o1.y = vp[5]; o1.z = vp[6]; o1.w = vp[7];
        *(v4u*)(a2 + 4352 + key * 32) = o0; *(v4u*)(a2 + 4352 + key * 32 + 16) = o1; }
}
__device__ __forceinline__ void rw_prep_b(LAS unsigned char* wl, int lane, unsigned char* a1) {
    LAS bf16* rowA = (LAS bf16*)wl; LAS bf16* rowR = rowA + 16 * RW_LSTR; LAS bf16* rowB = rowR + 16 * RW_LSTR; LAS bf16* rowK = rowB + 16 * RW_LSTR; LAS float* Ns = (LAS float*)(wl + 9216);
    const int key = lane, r16 = lane & 15, q = lane >> 4;
    (void)key;
    LDS_WAIT(); asm volatile("" ::: "memory");
    f32x4 nab = {0.f, 0.f, 0.f, 0.f}, mbr = nab, nak = nab, mkr = nab;
#pragma unroll
    for (int m = 0; m < 2; ++m) { const int o = r16 * RW_LSTR + 32 * m + 8 * q;
        const bf16x8v fb = *(const LAS bf16x8v*)(rowB + o), fk = *(const LAS bf16x8v*)(rowK + o), fa = *(const LAS bf16x8v*)(rowA + o), fr = *(const LAS bf16x8v*)(rowR + o);
        nab = __builtin_amdgcn_mfma_f32_16x16x32_bf16(fb, fa, nab, 0, 0, 0); mbr = __builtin_amdgcn_mfma_f32_16x16x32_bf16(fb, fr, mbr, 0, 0, 0);
        nak = __builtin_amdgcn_mfma_f32_16x16x32_bf16(fk, fa, nak, 0, 0, 0); mkr = __builtin_amdgcn_mfma_f32_16x16x32_bf16(fk, fr, mkr, 0, 0, 0); }
    {   const int t = r16, s0 = 4 * q; v4u fn, fm;
        fn.x = 0u; fn.y = 0u; fn.z = pk2(s0 < t ? nak[0] : 0.f, s0 + 1 < t ? nak[1] : 0.f); fn.w = pk2(s0 + 2 < t ? nak[2] : 0.f, s0 + 3 < t ? nak[3] : 0.f);
        fm.x = pk2(s0 <= t ? mbr[0] : 0.f, s0 + 1 <= t ? mbr[1] : 0.f); fm.y = pk2(s0 + 2 <= t ? mbr[2] : 0.f, s0 + 3 <= t ? mbr[3] : 0.f);
        fm.z = pk2(s0 <= t ? mkr[0] : 0.f, s0 + 1 <= t ? mkr[1] : 0.f); fm.w = pk2(s0 + 2 <= t ? mkr[2] : 0.f, s0 + 3 <= t ? mkr[3] : 0.f);
        *(v4u*)(a1 + 4096 + lane * 16) = fn; *(v4u*)(a1 + 6144 + lane * 16) = fm;
#pragma unroll
        for (int i = 0; i < 4; ++i) Ns[(s0 + i) * 16 + t] = (s0 + i < t) ? nab[i] : 0.f; }
#pragma unroll
    for (int m = 0; m < 2; ++m) { const int o = r16 * RW_LSTR + 32 * m + 4 * q;
        const v2u alo = *(const LAS v2u*)(rowA + o), ahi = *(const LAS v2u*)(rowA + o + 16), rlo = *(const LAS v2u*)(rowR + o), rhi = *(const LAS v2u*)(rowR + o + 16);
        v4u fa, fr; fa.x = alo.x; fa.y = alo.y; fa.z = ahi.x; fa.w = ahi.y; fr.x = rlo.x; fr.y = rlo.y; fr.z = rhi.x; fr.w = rhi.y;
        *(v4u*)(a1 + m * 1024 + lane * 16) = fa; *(v4u*)(a1 + 2048 + m * 1024 + lane * 16) = fr; }
    LDS_WAIT(); asm volatile("" ::: "memory");
    float x[16];
#pragma unroll
    for (int s_ = 15; s_ >= 0; --s_) { float acc = (s_ == r16) ? 1.f : 0.f;
        const f32x4 n0 = *(const LAS f32x4*)(Ns + s_ * 16), n1 = *(const LAS f32x4*)(Ns + s_ * 16 + 4), n2 = *(const LAS f32x4*)(Ns + s_ * 16 + 8), n3 = *(const LAS f32x4*)(Ns + s_ * 16 + 12);
        const float nr[16] = {n0.x, n0.y, n0.z, n0.w, n1.x, n1.y, n1.z, n1.w, n2.x, n2.y, n2.z, n2.w, n3.x, n3.y, n3.z, n3.w};
#pragma unroll
        for (int sp = s_ + 1; sp < 16; ++sp) acc += nr[sp] * x[sp];
        x[s_] = acc; }
    {   const float x0 = q == 0 ? x[0] : q == 1 ? x[4] : q == 2 ? x[8] : x[12], x1 = q == 0 ? x[1] : q == 1 ? x[5] : q == 2 ? x[9] : x[13];
        const float x2 = q == 0 ? x[2] : q == 1 ? x[6] : q == 2 ? x[10] : x[14], x3 = q == 0 ? x[3] : q == 1 ? x[7] : q == 2 ? x[11] : x[15];
        v4u fx; fx.x = pk2(x0, x1); fx.y = pk2(x2, x3); fx.z = 0u; fx.w = 0u; *(v4u*)(a1 + 5120 + lane * 16) = fx; }
    LDS_WAIT(); asm volatile("" ::: "memory");
}
struct RwSet { v4u fa0, fa1, fr0, fr1, fn, fx, fm, fs0, fs1, fs2, fs3; f32x4 g0, g1, g2, g3; v2u vt; };
__device__ __forceinline__ void rw_load(RwSet& S, const unsigned char* arr1, const unsigned char* arr2, size_t uc, int lane, int ws) {
    const unsigned char* p1 = arr1 + uc * RW_A1 + lane * 16; const unsigned char* p2 = arr2 + uc * RW_A2; const int r16 = lane & 15, q = lane >> 4;
    S.fa0 = *(const v4u*)p1; S.fa1 = *(const v4u*)(p1 + 1024); S.fr0 = *(const v4u*)(p1 + 2048); S.fr1 = *(const v4u*)(p1 + 3072); S.fn = *(const v4u*)(p1 + 4096); S.fx = *(const v4u*)(p1 + 5120); S.fm = *(const v4u*)(p1 + 6144);
    S.fs0 = *(const v4u*)(p2 + lane * 16); S.fs1 = *(const v4u*)(p2 + 1024 + lane * 16); S.fs2 = *(const v4u*)(p2 + 2048 + lane * 16); S.fs3 = *(const v4u*)(p2 + 3072 + lane * 16);
    const unsigned char* gp = p2 + 4096 + 16 * q; S.g0 = *(const f32x4*)gp; S.g1 = *(const f32x4*)(gp + 64); S.g2 = *(const f32x4*)(gp + 128); S.g3 = *(const f32x4*)(gp + 192);
    S.vt = *(const v2u*)(p2 + 4352 + (16 * ws + r16) * 32 + 8 * q);
}
__device__ __forceinline__ bf16x8v rw_bc(unsigned a, unsigned b, unsigned c, unsigned d) { v4u t; t.x = a; t.y = b; t.z = c; t.w = d; return __builtin_bit_cast(bf16x8v, t); }
typedef __bf16 rw_bf2 __attribute__((ext_vector_type(2)));
__device__ __forceinline__ unsigned cvt_pk_bf16(float lo, float hi) { const pg8::f32x2 v = {lo, hi}; return __builtin_bit_cast(unsigned, __builtin_convertvector(v, rw_bf2)); }
__device__ __forceinline__ void rw_step(const RwSet& S, f32x4 (&H)[4], float* ob) {
    const bf16x8v hb0 = rw_bc(cvt_pk_bf16(H[0][0], H[0][1]), cvt_pk_bf16(H[0][2], H[0][3]), cvt_pk_bf16(H[1][0], H[1][1]), cvt_pk_bf16(H[1][2], H[1][3]));
    const bf16x8v hb1 = rw_bc(cvt_pk_bf16(H[2][0], H[2][1]), cvt_pk_bf16(H[2][2], H[2][3]), cvt_pk_bf16(H[3][0], H[3][1]), cvt_pk_bf16(H[3][2], H[3][3]));
    const f32x4 z = {0.f, 0.f, 0.f, 0.f};
    f32x4 Y = __builtin_amdgcn_mfma_f32_16x16x32_bf16(__builtin_bit_cast(bf16x8v, S.fa0), hb0, z, 0, 0, 0);
    Y = __builtin_amdgcn_mfma_f32_16x16x32_bf16(__builtin_bit_cast(bf16x8v, S.fa1), hb1, Y, 0, 0, 0);
    Y = __builtin_amdgcn_mfma_f32_16x16x32_bf16(__builtin_bit_cast(bf16x8v, S.fn), rw_bc(0u, 0u, S.vt.x, S.vt.y), Y, 0, 0, 0);
    const f32x4 U = __builtin_amdgcn_mfma_f32_16x16x32_bf16(__builtin_bit_cast(bf16x8v, S.fx), rw_bc(cvt_pk_bf16(Y[0], Y[1]), cvt_pk_bf16(Y[2], Y[3]), 0u, 0u), z, 0, 0, 0);
    const bf16x8v ub = rw_bc(cvt_pk_bf16(U[0], U[1]), cvt_pk_bf16(U[2], U[3]), S.vt.x, S.vt.y);
    f32x4 O = __builtin_amdgcn_mfma_f32_16x16x32_bf16(__builtin_bit_cast(bf16x8v, S.fr0), hb0, z, 0, 0, 0);
    O = __builtin_amdgcn_mfma_f32_16x16x32_bf16(__builtin_bit_cast(bf16x8v, S.fr1), hb1, O, 0, 0, 0);
    O = __builtin_amdgcn_mfma_f32_16x16x32_bf16(__builtin_bit_cast(bf16x8v, S.fm), ub, O, 0, 0, 0);
    H[0] = __builtin_amdgcn_mfma_f32_16x16x32_bf16(__builtin_bit_cast(bf16x8v, S.fs0), ub, H[0] * S.g0, 0, 0, 0);
    H[1] = __builtin_amdgcn_mfma_f32_16x16x32_bf16(__builtin_bit_cast(bf16x8v, S.fs1), ub, H[1] * S.g1, 0, 0, 0);
    H[2] = __builtin_amdgcn_mfma_f32_16x16x32_bf16(__builtin_bit_cast(bf16x8v, S.fs2), ub, H[2] * S.g2, 0, 0, 0);
    H[3] = __builtin_amdgcn_mfma_f32_16x16x32_bf16(__builtin_bit_cast(bf16x8v, S.fs3), ub, H[3] * S.g3, 0, 0, 0);
    ob[0] = O[0]; ob[2048] = O[1]; ob[4096] = O[2]; ob[6144] = O[3];
}
__device__ __forceinline__ void rwkv_chunk_scan(int lane, int ws, const unsigned char* arr1, const unsigned char* arr2, int bh, float* Sout, float* OB) {
    const int r16 = lane & 15, q = lane >> 4, b = bh >> 5, h = bh & 31;
    f32x4 H[4];
#pragma unroll
    for (int i = 0; i < 4; ++i) H[i] = (f32x4){0.f, 0.f, 0.f, 0.f};
    const size_t uc0 = (size_t)bh * RW_NCH;
    float* ob = OB + (size_t)(b * SEQ + 4 * q) * 2048 + h * 64 + 16 * ws + r16;
    RwSet A, B, C; rw_load(A, arr1, arr2, uc0, lane, ws); rw_load(B, arr1, arr2, uc0 + 1, lane, ws);
    static_assert(RW_NCH % 3 == 2, "loop below: groups of three chunks, then two");
    for (int c = 0; c < RW_NCH - 2; c += 3) {
        rw_load(C, arr1, arr2, uc0 + c + 2, lane, ws);
        rw_step(A, H, ob + (size_t)c * 16 * 2048);
        rw_load(A, arr1, arr2, uc0 + c + 3, lane, ws);
        rw_step(B, H, ob + (size_t)(c + 1) * 16 * 2048);
        rw_load(B, arr1, arr2, uc0 + c + 4, lane, ws);
        rw_step(C, H, ob + (size_t)(c + 2) * 16 * 2048);
    }
    rw_step(A, H, ob + (size_t)(RW_NCH - 2) * 16 * 2048);
    rw_step(B, H, ob + (size_t)(RW_NCH - 1) * 16 * 2048);
#pragma unroll
    for (int kt = 0; kt < 4; ++kt) *(f32x4*)(Sout + (16 * ws + r16) * 64 + 16 * kt + 4 * q) = H[kt];
}

constexpr int RWL_PAIR = 13824, RWL_SLOT = 2 * RWL_PAIR, RWL_DUM = 4 * RWL_SLOT;
__device__ __forceinline__ void rwkv_chunk_scan_lds(Frame& F, const unsigned char* arr1, const unsigned char* arr2, int bh0, float* SoutBase, float* OB) {
    const int lane = F.lane, w = F.wave, ws = w & 3, pr = w >> 2, bh = bh0 + pr, r16 = lane & 15, q = lane >> 4, b = bh >> 5, h = bh & 31;
    LAS unsigned char* L = F.lds;
    f32x4 H[4];
#pragma unroll
    for (int i = 0; i < 4; ++i) H[i] = (f32x4){0.f, 0.f, 0.f, 0.f};
    const size_t uc0 = (size_t)bh * RW_NCH;
    float* ob = OB + (size_t)(b * SEQ + 4 * q) * 2048 + h * 64 + 16 * ws + r16;
    const unsigned char* gsrc[4]; int ldst[4];
#pragma unroll
    for (int i = 0; i < 4; ++i) { const int p = ws + 4 * i;
        if (p < 7) { gsrc[i] = arr1 + uc0 * RW_A1 + p * 1024 + lane * 16; ldst[i] = pr * RWL_PAIR + p * 1024; }
        else if (p < 11) { gsrc[i] = arr2 + uc0 * RW_A2 + (p - 7) * 1024 + lane * 16; ldst[i] = pr * RWL_PAIR + p * 1024; }
        else if (p < 13) { gsrc[i] = arr2 + uc0 * RW_A2 + 4352 + (p - 11) * 1024 + lane * 16; ldst[i] = pr * RWL_PAIR + 11520 + (p - 11) * 1024; }
        else if (p == 13) { gsrc[i] = arr2 + uc0 * RW_A2 + 4096 + lane * 4; ldst[i] = pr * RWL_PAIR + 11264; }
        else { gsrc[i] = arr1 + uc0 * RW_A1 + lane * 16; ldst[i] = RWL_DUM; } }
    const bool gc4 = ws == 1;
#define RWL_ISSUE(cc) do { const int c_ = (cc) < RW_NCH ? (cc) : RW_NCH - 1; const int so_ = ((cc) & 3) * RWL_SLOT; \
        _Pragma("unroll") for (int i = 0; i < 3; ++i) { const size_t st_ = (size_t)c_ * ((ws + 4 * i) < 7 ? RW_A1 : RW_A2); \
            __builtin_amdgcn_global_load_lds((const unsigned*)(gsrc[i] + st_), (LAS unsigned*)(L + (ldst[i] == RWL_DUM ? RWL_DUM : so_ + ldst[i])), 16, 0, 0); } \
        { const size_t st_ = (size_t)c_ * ((ws + 12) < 14 ? RW_A2 : RW_A1); \
          if (gc4) __builtin_amdgcn_global_load_lds((const unsigned*)(gsrc[3] + st_), (LAS unsigned*)(L + so_ + ldst[3]), 4, 0, 0); \
          else __builtin_amdgcn_global_load_lds((const unsigned*)(gsrc[3] + st_), (LAS unsigned*)(L + (ldst[3] == RWL_DUM ? RWL_DUM : so_ + ldst[3])), 16, 0, 0); } } while (0)
    __syncthreads();
    RWL_ISSUE(0); RWL_ISSUE(1); RWL_ISSUE(2);
#pragma unroll 1
    for (int c = 0; c < RW_NCH; ++c) {
        if (c < 3) asm volatile("s_waitcnt vmcnt(8)" ::: "memory"); else asm volatile("s_waitcnt vmcnt(20)" ::: "memory");
        __builtin_amdgcn_s_barrier(); asm volatile("" ::: "memory");
        RWL_ISSUE(c + 3);
        const LAS unsigned char* S_ = L + (c & 3) * RWL_SLOT + pr * RWL_PAIR;
        RwSet A;
        A.fa0 = *(const LAS v4u*)(S_ + lane * 16); A.fa1 = *(const LAS v4u*)(S_ + 1024 + lane * 16); A.fr0 = *(const LAS v4u*)(S_ + 2048 + lane * 16); A.fr1 = *(const LAS v4u*)(S_ + 3072 + lane * 16);
        A.fn = *(const LAS v4u*)(S_ + 4096 + lane * 16); A.fx = *(const LAS v4u*)(S_ + 5120 + lane * 16); A.fm = *(const LAS v4u*)(S_ + 6144 + lane * 16);
        A.fs0 = *(const LAS v4u*)(S_ + 7168 + lane * 16); A.fs1 = *(const LAS v4u*)(S_ + 8192 + lane * 16); A.fs2 = *(const LAS v4u*)(S_ + 9216 + lane * 16); A.fs3 = *(const LAS v4u*)(S_ + 10240 + lane * 16);
        A.g0 = *(const LAS f32x4*)(S_ + 11264 + 16 * q); A.g1 = *(const LAS f32x4*)(S_ + 11264 + 64 + 16 * q); A.g2 = *(const LAS f32x4*)(S_ + 11264 + 128 + 16 * q); A.g3 = *(const LAS f32x4*)(S_ + 11264 + 192 + 16 * q);
        A.vt = *(const LAS v2u*)(S_ + 11520 + (16 * ws + r16) * 32 + 8 * q);
        asm volatile("s_waitcnt lgkmcnt(0)" ::: "memory");
        rw_step(A, H, ob + (size_t)c * 16 * 2048);
    }
#undef RWL_ISSUE
    asm volatile("s_waitcnt vmcnt(0)" ::: "memory"); __builtin_amdgcn_s_barrier();
    float* Sout = SoutBase + (size_t)bh * 4096;
#pragma unroll
    for (int kt = 0; kt < 4; ++kt) *(f32x4*)(Sout + (16 * ws + r16) * 64 + 16 * kt + 4 * q) = H[kt];
}

__device__ __forceinline__ bf16x8v ldfrag(const bf16* p) { return *(const bf16x8v*)p; }
__device__ __forceinline__ void gla_prep_unit(Frame& F, const bf16* proj, const bf16* L1, const float* b_alpha, bf16* QD, bf16* KDDT, bf16* VT, bf16* ATT, float* EB, int ci, int h) {
    constexpr int LS = 264, VLS = 520;
    LAS bf16* qd_s = (LAS bf16*)F.lds; LAS bf16* kd_s = qd_s + 64 * LS; LAS bf16* kdd_s = kd_s + 64 * LS; LAS float* tot = (LAS float*)(kdd_s + 64 * LS);
    LAS bf16* v_s = (LAS bf16*)F.lds;
    int tid_ = F.tid; asm volatile("" : "+v"(tid_));
    const int tid = tid_, lane = tid & 63, w = F.wave, dg = tid & 31, ts = tid >> 5, m0 = (ci >> 5) * SEQ + (ci & 31) * 64, u = ci * 4 + h;
    v4u l1v[4], qv[4], kv[4], vv[8];
#pragma unroll
    for (int i = 0; i < 4; ++i) { const size_t m = (size_t)(m0 + 4 * ts + i); l1v[i] = *(const v4u*)(L1 + m * NL1 + h * 256 + 8 * dg);
        qv[i] = *(const v4u*)(proj + m * NPROJ + CQ + h * 256 + 8 * dg); kv[i] = *(const v4u*)(proj + m * NPROJ + CK + h * 256 + 8 * dg); }
    float ba[8]; { const f32x4 b0 = *(const f32x4*)(b_alpha + h * 256 + 8 * dg), b1 = *(const f32x4*)(b_alpha + h * 256 + 8 * dg + 4); ba[0] = b0.x; ba[1] = b0.y; ba[2] = b0.z; ba[3] = b0.w; ba[4] = b1.x; ba[5] = b1.y; ba[6] = b1.z; ba[7] = b1.w; }
    __syncthreads();
    float bt[4][8];
    { float run[8];
#pragma unroll
      for (int e = 0; e < 8; ++e) run[e] = 0.f;
#pragma unroll
      for (int i = 0; i < 4; ++i) { const unsigned xw[4] = {l1v[i].x, l1v[i].y, l1v[i].z, l1v[i].w};
#pragma unroll
          for (int e = 0; e < 8; ++e) { const float x = ((e & 1) ? bfhi(xw[e >> 1]) : bflo(xw[e >> 1])) + ba[e]; run[e] += -(fmaxf(-x, 0.f) + __logf(1.0f + __expf(-fabsf(x)))) * 0.0625f; bt[i][e] = run[e]; }
          __builtin_amdgcn_sched_barrier(0); }
      *(LAS f32x4*)(tot + ts * 256 + 8 * dg) = (f32x4){run[0], run[1], run[2], run[3]}; *(LAS f32x4*)(tot + ts * 256 + 8 * dg + 4) = (f32x4){run[4], run[5], run[6], run[7]}; }
    WG_BAR();
    float off[8], be[8];
#pragma unroll
    for (int e = 0; e < 8; ++e) { off[e] = 0.f; be[e] = 0.f; }
#pragma unroll
    for (int s = 0; s < 16; ++s) { const f32x4 a = *(const LAS f32x4*)(tot + s * 256 + 8 * dg), b = *(const LAS f32x4*)(tot + s * 256 + 8 * dg + 4); const float t8[8] = {a.x, a.y, a.z, a.w, b.x, b.y, b.z, b.w}; const bool pre = s < ts;
#pragma unroll
        for (int e = 0; e < 8; ++e) { be[e] += t8[e]; off[e] += pre ? t8[e] : 0.f; } }
    if (ts == 0) { *(f32x4*)(EB + (size_t)u * 256 + 8 * dg) = (f32x4){__expf(be[0]), __expf(be[1]), __expf(be[2]), __expf(be[3])}; *(f32x4*)(EB + (size_t)u * 256 + 8 * dg + 4) = (f32x4){__expf(be[4]), __expf(be[5]), __expf(be[6]), __expf(be[7])}; }
#pragma unroll
    for (int i = 0; i < 4; ++i) { const int t = 4 * ts + i; const unsigned qw[4] = {qv[i].x, qv[i].y, qv[i].z, qv[i].w}, kw[4] = {kv[i].x, kv[i].y, kv[i].z, kv[i].w};
        float qd[8], kd[8], kdd[8];
#pragma unroll
        for (int e = 0; e < 8; ++e) { const float b = bt[i][e] + off[e], q = (e & 1) ? bfhi(qw[e >> 1]) : bflo(qw[e >> 1]), k = (e & 1) ? bfhi(kw[e >> 1]) : bflo(kw[e >> 1]);
            qd[e] = q * 0.0625f * __expf(b); kd[e] = k * __expf(-b); kdd[e] = k * __expf(be[e] - b); }
        v4u oq, ok, okk; oq.x = pk2(qd[0], qd[1]); oq.y = pk2(qd[2], qd[3]); oq.z = pk2(qd[4], qd[5]); oq.w = pk2(qd[6], qd[7]);
        ok.x = pk2(kd[0], kd[1]); ok.y = pk2(kd[2], kd[3]); ok.z = pk2(kd[4], kd[5]); ok.w = pk2(kd[6], kd[7]);
        okk.x = pk2(kdd[0], kdd[1]); okk.y = pk2(kdd[2], kdd[3]); okk.z = pk2(kdd[4], kdd[5]); okk.w = pk2(kdd[6], kdd[7]);
        *(v4u*)(QD + (size_t)(m0 + t) * 1024 + h * 256 + 8 * dg) = oq;
        *(LAS v4u*)(qd_s + t * LS + 8 * dg) = oq; *(LAS v4u*)(kd_s + t * LS + 8 * dg) = ok; *(LAS v4u*)(kdd_s + t * LS + 8 * dg) = okk;
        __builtin_amdgcn_sched_barrier(0); }
    WG_BAR();
#pragma unroll
    for (int i = 0; i < 8; ++i) { const int p = tid + 512 * i; vv[i] = *(const v4u*)(proj + (size_t)(m0 + (p >> 6)) * NPROJ + CV + h * 512 + 8 * (p & 63)); }
    {
        const int d = tid & 255, half = tid >> 8; unsigned kp[16];
#pragma unroll
        for (int i = 0; i < 32; ++i) { const unsigned x = kdd_s[(32 * half + i) * LS + d]; if (i & 1) kp[i >> 1] |= x << 16; else kp[i >> 1] = x; }
        v4u* kd4 = (v4u*)(KDDT + ((size_t)u * 256 + d) * 64 + 32 * half);
#pragma unroll
        for (int i = 0; i < 4; ++i) { v4u o; o.x = kp[4 * i]; o.y = kp[4 * i + 1]; o.z = kp[4 * i + 2]; o.w = kp[4 * i + 3]; kd4[i] = o; } }
    {
        const int tt = w >> 1, r = lane & 15, q = lane >> 4;
#pragma unroll
        for (int si = 0; si < 2; ++si) { const int st = 2 * (w & 1) + si; f32x4 acc = {0.f, 0.f, 0.f, 0.f};
            if (st <= tt) {
#pragma unroll
                for (int ks = 0; ks < 8; ++ks) { const bf16x8v a = *(const LAS bf16x8v*)(kd_s + (16 * st + r) * LS + ks * 32 + 8 * q), b = *(const LAS bf16x8v*)(qd_s + (16 * tt + r) * LS + ks * 32 + 8 * q);
                    acc = __builtin_amdgcn_mfma_f32_16x16x32_bf16(a, b, acc, 0, 0, 0); }
            }
            const int t = 16 * tt + r, s0 = 16 * st + 4 * q; v2u o;
            o.x = pk2(t >= s0 ? acc[0] : 0.f, t >= s0 + 1 ? acc[1] : 0.f); o.y = pk2(t >= s0 + 2 ? acc[2] : 0.f, t >= s0 + 3 ? acc[3] : 0.f);
            *(v2u*)(ATT + ((size_t)u * 64 + t) * 64 + s0) = o; }
    }
    WG_BAR();
#pragma unroll
    for (int i = 0; i < 8; ++i) { const int p = tid + 512 * i; *(LAS v4u*)(v_s + (p >> 6) * VLS + 8 * (p & 63)) = vv[i]; }
    WG_BAR();
    {
        unsigned vp[32];
#pragma unroll
        for (int t = 0; t < 64; ++t) { const unsigned x = v_s[t * VLS + tid]; if (t & 1) vp[t >> 1] |= x << 16; else vp[t >> 1] = x; }
        v4u* v4 = (v4u*)(VT + ((size_t)u * 512 + tid) * 64);
#pragma unroll
        for (int i = 0; i < 8; ++i) { v4u o; o.x = vp[4 * i]; o.y = vp[4 * i + 1]; o.z = vp[4 * i + 2]; o.w = vp[4 * i + 3]; v4[i] = o; }
    }
}
__device__ __forceinline__ void gla_prompt_unit(Frame& F, const bf16* QD, const bf16* KDDT, const bf16* VT, const bf16* ATT, const float* EB, float* OA, float* gla_p, int b, int h, int vs) {
    constexpr int LS = 264, PS = 72;
    constexpr int O_QD = 64 * LS * 2, O_KD = O_QD + 64 * LS * 2, O_VT = O_KD + 256 * PS * 2, O_AT = O_VT + 64 * PS * 2, O_EB = O_AT + 64 * PS * 2, O_DUM = O_EB + 1024;
    LAS unsigned char* L = F.lds; LAS bf16* ST = (LAS bf16*)L;
    const int tid = F.tid, lane = F.lane, w = F.wave, r = lane & 15, q = lane >> 4, tt = w >> 1, vt0 = 2 * (w & 1);
    f32x4 Sacc[2][4];
#pragma unroll
    for (int a = 0; a < 2; ++a)
#pragma unroll
        for (int c = 0; c < 4; ++c) Sacc[a][c] = (f32x4){0.f, 0.f, 0.f, 0.f};
    const int gq = ((tid >> 5) * 1024 + (tid & 31) * 8) * 2, lq = O_QD + (tid >> 5) * (LS * 2) + (tid & 31) * 16;
    const int gk = ((tid >> 3) * 64 + (tid & 7) * 8) * 2, lk = (tid >> 3) * (PS * 2) + (tid & 7) * 16;
    const bool ebok = tid < 64; const int ge = ebok ? tid * 16 : 0, le = ebok ? O_EB + tid * 16 : O_DUM;
    const unsigned char* pQD = (const unsigned char*)(QD + (size_t)(b * SEQ) * 1024 + h * 256); const size_t sQD = (size_t)64 * 1024 * 2;
    const size_t u0 = (size_t)(b * 32) * 4 + h;
    const unsigned char* pKD = (const unsigned char*)(KDDT + u0 * 256 * 64); const size_t sKD = (size_t)4 * 256 * 64 * 2;
    const unsigned char* pVT = (const unsigned char*)(VT + (u0 * 512 + vs * 64) * 64); const size_t sVT = (size_t)4 * 512 * 64 * 2;
    const unsigned char* pAT = (const unsigned char*)(ATT + u0 * 64 * 64); const size_t sAT = (size_t)4 * 64 * 64 * 2;
    const unsigned char* pEB = (const unsigned char*)(EB + u0 * 256); const size_t sEB = (size_t)4 * 256 * 4;
#define GP_LOAD(P, cc) do { const size_t c_ = (size_t)((cc) < 32 ? (cc) : 31); \
        _Pragma("unroll") for (int i = 0; i < 4; ++i) P[i] = *(const v4u*)(pQD + c_ * sQD + gq + i * (16 * 1024 * 2)); \
        _Pragma("unroll") for (int i = 0; i < 4; ++i) P[4 + i] = *(const v4u*)(pKD + c_ * sKD + gk + i * (64 * 64 * 2)); \
        P[8] = *(const v4u*)(pVT + c_ * sVT + gk); P[9] = *(const v4u*)(pAT + c_ * sAT + gk); P[10] = *(const v4u*)(pEB + c_ * sEB + ge); } while (0)
#define GP_STAGE(P) do { _Pragma("unroll") for (int i = 0; i < 11; ++i) asm volatile("" : "+v"(P[i])); \
        _Pragma("unroll") for (int i = 0; i < 4; ++i) *(LAS v4u*)(L + lq + i * (16 * LS * 2)) = P[i]; \
        _Pragma("unroll") for (int i = 0; i < 4; ++i) *(LAS v4u*)(L + O_KD + lk + i * (64 * PS * 2)) = P[4 + i]; \
        *(LAS v4u*)(L + O_VT + lk) = P[8]; *(LAS v4u*)(L + O_AT + lk) = P[9]; *(LAS v4u*)(L + le) = P[10]; } while (0)
    v4u PA[11];
    GP_LOAD(PA, 0);
    __syncthreads();
    for (int i = tid; i < 64 * LS / 2; i += NT) ((LAS unsigned*)ST)[i] = 0u;
    GP_STAGE(PA);
    WG_BAR();
    const LAS bf16* QDs = (const LAS bf16*)(L + O_QD); const LAS bf16* KDs = (const LAS bf16*)(L + O_KD); const LAS bf16* VTs = (const LAS bf16*)(L + O_VT); const LAS bf16* ATs = (const LAS bf16*)(L + O_AT);
    const LAS float* EBs = (const LAS float*)(L + O_EB);
    for (int c = 0; c < 32; ++c) {
        GP_LOAD(PA, c + 1);
        const int m0 = b * SEQ + c * 64;
        bf16x8v Bv[4][2], Akd[2][2]; f32x4 ebv[2];
#pragma unroll
        for (int vt = 0; vt < 4; ++vt)
#pragma unroll
            for (int ks = 0; ks < 2; ++ks) Bv[vt][ks] = *(const LAS bf16x8v*)(VTs + (16 * vt + r) * PS + ks * 32 + 8 * q);
#pragma unroll
        for (int dt = 0; dt < 2; ++dt) {
#pragma unroll
            for (int ks = 0; ks < 2; ++ks) Akd[dt][ks] = *(const LAS bf16x8v*)(KDs + (32 * w + 16 * dt + r) * PS + ks * 32 + 8 * q);
            ebv[dt] = *(const LAS f32x4*)(EBs + 32 * w + 16 * dt + 4 * q); }
        bf16x8v Aatt[2], Bo[2][2];
#pragma unroll
        for (int ks = 0; ks < 2; ++ks) { Aatt[ks] = *(const LAS bf16x8v*)(ATs + (16 * tt + r) * PS + ks * 32 + 8 * q);
#pragma unroll
            for (int vi = 0; vi < 2; ++vi) Bo[vi][ks] = *(const LAS bf16x8v*)(VTs + (16 * (vt0 + vi) + r) * PS + ks * 32 + 8 * q); }
        f32x4 oacc[2];
#pragma unroll
        for (int vi = 0; vi < 2; ++vi) { const int vt = vt0 + vi; f32x4 acc = {0.f, 0.f, 0.f, 0.f};
#pragma unroll
            for (int ks = 0; ks < 2; ++ks) acc = __builtin_amdgcn_mfma_f32_16x16x32_bf16(Bo[vi][ks], Aatt[ks], acc, 0, 0, 0);
#pragma unroll
            for (int ks = 0; ks < 8; ++ks) { const bf16x8v sfr = *(const LAS bf16x8v*)(ST + (16 * vt + r) * LS + ks * 32 + 8 * q), aq = *(const LAS bf16x8v*)(QDs + (16 * tt + r) * LS + ks * 32 + 8 * q);
                acc = __builtin_amdgcn_mfma_f32_16x16x32_bf16(sfr, aq, acc, 0, 0, 0); }
            oacc[vi] = acc; }
#pragma unroll
        for (int vi = 0; vi < 2; ++vi) *(f32x4*)(OA + (size_t)(m0 + 16 * tt + r) * 2048 + h * 512 + vs * 64 + 16 * (vt0 + vi) + 4 * q) = oacc[vi];
        WG_BAR();
#pragma unroll
        for (int dt = 0; dt < 2; ++dt)
#pragma unroll
            for (int vt = 0; vt < 4; ++vt) { f32x4 a = Sacc[dt][vt] * ebv[dt];
#pragma unroll
                for (int ks = 0; ks < 2; ++ks) a = __builtin_amdgcn_mfma_f32_16x16x32_bf16(Akd[dt][ks], Bv[vt][ks], a, 0, 0, 0);
                Sacc[dt][vt] = a; v2u o; o.x = pk2(a[0], a[1]); o.y = pk2(a[2], a[3]);
                *(LAS v2u*)(ST + (16 * vt + r) * LS + 32 * w + 16 * dt + 4 * q) = o; }
        GP_STAGE(PA);
        WG_BAR();
    }
#undef GP_LOAD
#undef GP_STAGE
#pragma unroll
    for (int dt = 0; dt < 2; ++dt)
#pragma unroll
        for (int vt = 0; vt < 4; ++vt)
#pragma unroll
            for (int j = 0; j < 4; ++j) gla_p[((size_t)(b * 4 + h) * 256 + 32 * w + 16 * dt + 4 * q + j) * 512 + vs * 64 + 16 * vt + r] = Sacc[dt][vt][j];
}

__device__ __forceinline__ void gla_sample_unit(Frame& F, const bf16* proj, const float* LA, float* OA, const float* S0g, float* Sog, int b, int h) {
    LAS float* qdT = (LAS float*)F.lds; LAS float* kddT = qdT + 2048; LAS float* kd = kddT + 2048; LAS float* eb = kd + 2048; LAS float* att = eb + 256; LAS float* ored = att + 64;
    const int tid = F.tid, lane = F.lane, w = F.wave, m0 = TP + b * DSEQ;
    __syncthreads();
    if (tid < 256) { const int d = tid; float bt[8]; float bc = 0.f;
#pragma unroll
        for (int t = 0; t < 8; ++t) { bc += LA[(size_t)(m0 + t) * 1024 + h * 256 + d]; bt[t] = bc; }
#pragma unroll
        for (int t = 0; t < 8; ++t) { const bf16* pr = proj + (size_t)(m0 + t) * NPROJ + h * 256 + d; const float q = bf2f(pr[CQ]) * 0.0625f, k = bf2f(pr[CK]);
            qdT[d * 8 + t] = q * __expf(bt[t]); kd[t * 256 + d] = k * __expf(-bt[t]); kddT[d * 8 + t] = k * __expf(bc - bt[t]); }
        eb[d] = __expf(bc); }
    __syncthreads();
    {
#pragma unroll
        for (int s = 0; s < 8; ++s) { float p = 0.f;
#pragma unroll
            for (int i = 0; i < 4; ++i) { const int d = lane + 64 * i; p += qdT[d * 8 + w] * kd[s * 256 + d]; }
            p = wave_sum(p); if (lane == 0) att[w * 8 + s] = (s <= w) ? p : 0.f; }
    }
    __syncthreads();
    const int vq = tid & 127, dg = tid >> 7, v0 = 4 * vq;
    f32x4 vv[8], o[8];
#pragma unroll
    for (int t = 0; t < 8; ++t) { const v2u x = *(const v2u*)(proj + (size_t)(m0 + t) * NPROJ + CV + h * 512 + v0); vv[t] = (f32x4){bflo(x.x), bfhi(x.x), bflo(x.y), bfhi(x.y)}; }
#pragma unroll
    for (int t = 0; t < 8; ++t) { f32x4 s = {0.f, 0.f, 0.f, 0.f};
        if (dg == 0) {
#pragma unroll
            for (int uu = 0; uu < 8; ++uu) s += att[t * 8 + uu] * vv[uu]; }
        o[t] = s; }
    const float* S0 = S0g + ((size_t)(b * 4 + h) * 256 + 64 * dg) * 512 + v0; float* So = Sog + ((size_t)(b * 4 + h) * 256 + 64 * dg) * 512 + v0;
    f32x4 s0[8], s1[8];
#pragma unroll
    for (int i = 0; i < 8; ++i) s0[i] = *(const f32x4*)(S0 + (size_t)i * 512);
#pragma unroll 1
    for (int db = 0; db < 64; db += 8) {
        { const int dn = db + 8 < 64 ? db + 8 : db;
#pragma unroll
          for (int i = 0; i < 8; ++i) s1[i] = *(const f32x4*)(S0 + (size_t)(dn + i) * 512); }
#pragma unroll
        for (int i = 0; i < 8; ++i) { const int d = 64 * dg + db + i;
            const f32x4 q0 = *(const LAS f32x4*)(qdT + d * 8), q1 = *(const LAS f32x4*)(qdT + d * 8 + 4), k0 = *(const LAS f32x4*)(kddT + d * 8), k1 = *(const LAS f32x4*)(kddT + d * 8 + 4);
            o[0] += q0.x * s0[i]; o[1] += q0.y * s0[i]; o[2] += q0.z * s0[i]; o[3] += q0.w * s0[i]; o[4] += q1.x * s0[i]; o[5] += q1.y * s0[i]; o[6] += q1.z * s0[i]; o[7] += q1.w * s0[i];
            f32x4 sn = s0[i] * eb[d];
            sn += k0.x * vv[0]; sn += k0.y * vv[1]; sn += k0.z * vv[2]; sn += k0.w * vv[3]; sn += k1.x * vv[4]; sn += k1.y * vv[5]; sn += k1.z * vv[6]; sn += k1.w * vv[7];
            *(f32x4*)(So + (size_t)(db + i) * 512) = sn; }
#pragma unroll
        for (int i = 0; i < 8; ++i) s0[i] = s1[i];
    }
#pragma unroll
    for (int t = 0; t < 8; ++t) *(LAS f32x4*)(ored + (dg * 8 + t) * 512 + v0) = o[t];
    __syncthreads();
#pragma unroll
    for (int i = 0; i < 2; ++i) { const int idx = tid + 512 * i, t = idx >> 7, v4 = (idx & 127) * 4;
        const f32x4 s = (*(const LAS f32x4*)(ored + (0 * 8 + t) * 512 + v4) + *(const LAS f32x4*)(ored + (1 * 8 + t) * 512 + v4)) + (*(const LAS f32x4*)(ored + (2 * 8 + t) * 512 + v4) + *(const LAS f32x4*)(ored + (3 * 8 + t) * 512 + v4));
        *(f32x4*)(OA + (size_t)(m0 + t) * 2048 + h * 512 + v4) = s; }
}

__device__ __forceinline__ float sum16(float x) {
    x += dpp_f(x, 0); x += dpp_f(x, 1); x += dpp_f(x, 2);
    const int v = __builtin_bit_cast(int, x); x += __builtin_bit_cast(float, __builtin_amdgcn_update_dpp(v, v, 0x140, 0xF, 0xF, false));
    return x;
}
__device__ __forceinline__ f32x4 bf4(v2u w) { return (f32x4){bflo(w.x), bfhi(w.x), bflo(w.y), bfhi(w.y)}; }
struct P4In { v2u r, k, v, rp, kp, vp; f32x4 l1d, l1i, la; };
__device__ __forceinline__ P4In p4_load(const bf16* PROJ, const bf16* L1, int it, int lane) {
    const int m = it >> 3, hq = it & 7, c0 = hq * 256 + 4 * lane; const SeqPos sp = seqpos(m); const bf16* pr = PROJ + (size_t)m * NPROJ + c0;
    P4In x; x.r = *(const v2u*)(pr + CR); x.k = *(const v2u*)(pr + CKR); x.v = *(const v2u*)(pr + CVR);
    const bf16* pq = sp.t > 0 ? pr - NPROJ : pr;
    x.rp = *(const v2u*)(pq + CR); x.kp = *(const v2u*)(pq + CKR); x.vp = *(const v2u*)(pq + CVR);
    const bf16* l = L1 + (size_t)m * NL1 + c0; x.l1d = bf4(*(const v2u*)(l + 1024)); x.l1i = bf4(*(const v2u*)(l + 3072)); x.la = bf4(*(const v2u*)(l));
    return x;
}
struct P4Par { f32x4 mur, muk, muv, a0, w0, kk, ka, rk, ba; };
__device__ __forceinline__ void p4_compute(const P4In& x, const P4Par& P, const float* sshift, unsigned char* SCAN, float* BONUS, float* LA, int it, int lane) {
    const int m = it >> 3, hq = it & 7, c0 = hq * 256 + 4 * lane, h = 4 * hq + (lane >> 4), cl = lane & 15; const SeqPos sp = seqpos(m);
    f32x4 rp = bf4(x.rp), kp = bf4(x.kp), vp = bf4(x.vp);
    if (sp.t == 0) { if (sp.prm) { rp = (f32x4){0.f, 0.f, 0.f, 0.f}; kp = rp; vp = rp; }
        else { const float* sh = sshift + (size_t)sp.b * ZRC + c0; rp = *(const f32x4*)sh; kp = *(const f32x4*)(sh + 2144); vp = *(const f32x4*)(sh + 4192); } }
    const f32x4 z0 = bf4(x.r), z1 = bf4(x.k), z2 = bf4(x.v);
    const f32x4 r = z0 + (rp - z0) * P.mur, ksh = z1 + (kp - z1) * P.muk, vsh = z2 + (vp - z2) * P.muv;
    f32x4 a, dec, kk, k2; float ss = 0.f, bs = 0.f;
#pragma unroll
    for (int e = 0; e < 4; ++e) { a[e] = sigmoidf_(P.a0[e] + x.l1i[e]); const float wl = -softplusf_(-(P.w0[e] + x.l1d[e])) - 0.5f; dec[e] = __expf(-__expf(wl));
        kk[e] = ksh[e] * P.kk[e]; ss += kk[e] * kk[e]; k2[e] = ksh[e] * (1.0f + (a[e] - 1.0f) * P.ka[e]); bs += r[e] * k2[e] * P.rk[e]; }
    const float inv = 1.0f / fmaxf(sqrtf(sum16(ss)), 1e-12f); bs = sum16(bs);
    kk = kk * inv;
    unsigned char* rb = SCAN + ((size_t)m * 32 + h) * SCAN_REC; const f32x4 nk = -kk, ka = kk * a;
    *(f32x4*)(rb + 16 * cl) = dec;
    v2u t; t.x = pk2(r[0], r[1]); t.y = pk2(r[2], r[3]); *(v2u*)(rb + 256 + 8 * cl) = t;
    t.x = pk2(k2[0], k2[1]); t.y = pk2(k2[2], k2[3]); *(v2u*)(rb + 384 + 8 * cl) = t;
    t.x = pk2(nk[0], nk[1]); t.y = pk2(nk[2], nk[3]); *(v2u*)(rb + 512 + 8 * cl) = t;
    t.x = pk2(ka[0], ka[1]); t.y = pk2(ka[2], ka[3]); *(v2u*)(rb + 640 + 8 * cl) = t;
    t.x = pk2(vsh[0], vsh[1]); t.y = pk2(vsh[2], vsh[3]); *(v2u*)(rb + 768 + 8 * cl) = t;
    if (cl == 0) BONUS[m * 32 + h] = bs;
    if (hq < 4) { f32x4 la;
#pragma unroll
        for (int e = 0; e < 4; ++e) la[e] = -softplusf_(-(x.la[e] + P.ba[e])) * 0.0625f;
        *(f32x4*)(LA + (size_t)m * 1024 + c0) = la; }
}
struct P6In { f32x4 ob; v2u v, g; float bonus; };
__device__ __forceinline__ P6In p6_load(const float* OB, const unsigned char* SCAN, const float* BONUS, const bf16* Gb, int it, int lane) {
    const int m = it >> 3, hq = it & 7, c0 = hq * 256 + 4 * lane, h = 4 * hq + (lane >> 4), cl = lane & 15;
    P6In x; x.ob = *(const f32x4*)(OB + (size_t)m * 2048 + c0); x.v = *(const v2u*)(SCAN + ((size_t)m * 32 + h) * SCAN_REC + 768 + 8 * cl); x.g = *(const v2u*)(Gb + (size_t)m * 2048 + c0); x.bonus = BONUS[m * 32 + h];
    return x;
}
__device__ __forceinline__ void p6_compute(const P6In& x, f32x4 lnw, f32x4 lnb, bf16* OBP, int it, int lane) {
    const int m = it >> 3, hq = it & 7, c0 = hq * 256 + 4 * lane;
    const float mean = sum16((x.ob[0] + x.ob[1]) + (x.ob[2] + x.ob[3])) * (1.f / 64.f); const f32x4 dv = x.ob - mean;
    const float var = sum16((dv[0] * dv[0] + dv[1] * dv[1]) + (dv[2] * dv[2] + dv[3] * dv[3])) * (1.f / 64.f); const float rs = __builtin_amdgcn_rsqf(var + 64e-5f);
    const f32x4 y = (dv * rs * lnw + lnb + x.bonus * bf4(x.v)) * bf4(x.g);
    v2u o; o.x = pk2(y[0], y[1]); o.y = pk2(y[2], y[3]); *(v2u*)(OBP + (size_t)m * 2048 + c0) = o;
}

constexpr int LI1 = 64 * (NUP / 32), LI2 = (DFF / 64) * (D / 32), LI3 = 64 * 128, LI4 = 64 * 128, LI5 = 32 * 128, LI6 = 32 * 128, LI7 = 4 * 128;
constexpr int NLATE = LI1 + LI2 + LI3 + LI4 + LI5 + LI6 + LI7, NLATE_CHUNKS = NLATE / 64;
static_assert(NLATE % 64 == 0, "late items come in chunks of 64");
__device__ __forceinline__ TrDesc late_desc(KArgs& args, unsigned char* ws, int it) {
    int r = it;
    if (r < LI1) return TrDesc{args.in[I_WUP], (bf16*)(ws + WS_WT_UP), D, NUP, NUP / 32, r, false}; r -= LI1;
    if (r < LI2) return TrDesc{args.in[I_WDOWN], (bf16*)(ws + WS_WT_DOWN), DFF, D, D / 32, r, false}; r -= LI2;
    if (r < LI3) return TrDesc{args.in[I_WOUT], (bf16*)(ws + WS_WT_OUT), D, D, D / 32, r, false}; r -= LI3;
    if (r < LI4) return TrDesc{args.in[I_WPEG], (bf16*)(ws + WS_WT_PEG), D, D, D / 32, r, false}; r -= LI4;
    if (r < LI5) return TrDesc{args.in[I_WBRA], (bf16*)(ws + WS_WT_BRA), 2048, D, D / 32, r, false}; r -= LI5;
    if (r < LI6) return TrDesc{args.in[I_WBRB], (bf16*)(ws + WS_WT_BRB), 2048, D, D / 32, r, false}; r -= LI6;
    return TrDesc{args.in[I_WPE], (bf16*)(ws + WS_WT_PE), 256, D, D / 32, r, false};
}

__device__ __forceinline__ void late_chunk(Frame& F, KArgs& args, unsigned char* ws, int chunk) {
    LAS float* scr = (LAS float*)(F.lds + F.wave * 16384); const int base = chunk * 64 + F.wave * 8;
    float ta[32], tb[32];
    TrDesc da = late_desc(args, ws, base), db = da;
    tr_load(da, ta, F.lane);
#pragma unroll 1
    for (int i = 0; i < 8; i += 2) {
        db = late_desc(args, ws, base + i + 1); tr_load(db, tb, F.lane);
        tr_finish(da, ta, scr, F.lane);
        if (i + 2 < 8) { da = late_desc(args, ws, base + i + 2); tr_load(da, ta, F.lane); }
        tr_finish(db, tb, scr, F.lane);
    }
}
constexpr int TAILB = 192, NTB = 3, NT1 = 2, TAIL1 = NT1 * 120, PEG0 = 1160, PEG1 = 1288;
static_assert(NTB * TAILB + TAIL1 <= 1032, "tail chunks are w_up / w_down chunks (first needed after the branch GEMM)");
static_assert(NLATE_CHUNKS == 1424 && LI1 / 64 == 688 && (LI1 + LI2 + LI3) / 64 == PEG0 && (LI1 + LI2 + LI3 + LI4) / 64 == PEG1, "chunk map");

constexpr int N_PHASES = 15;
#ifndef REP0
#define REP0 1
#endif
#ifndef REP1
#define REP1 1
#endif
#ifndef REP5
#define REP5 1
#endif
#ifndef REP10
#define REP10 1
#endif
#ifndef REP12
#define REP12 1
#endif
__global__ void __launch_bounds__(NT, 2) fwd_kernel(Args args_unused) {
    extern __shared__ __attribute__((aligned(16))) unsigned char lds_[];
    KArgs& args = *(KArgs*)__builtin_amdgcn_kernarg_segment_ptr();
    Frame F;
    F.lds = (LAS unsigned char*)lds_;
    F.tid = threadIdx.x; F.lane = F.tid & 63; F.wave = __builtin_amdgcn_readfirstlane(F.tid >> 6);
    F.G = gridDim.x; { const int bx = blockIdx.x; F.vcu = (F.G % 8 == 0) ? (bx % 8) * (F.G / 8) + bx / 8 : bx; }
    F.gw = F.vcu * NWAVES + F.wave; F.NGW = F.G * NWAVES;
    unsigned char* ws = args.ws; float* out = args.out;
    unsigned* ctl = (unsigned*)(ws + WS_CTL);
    volatile LAS unsigned* MISC = (volatile LAS unsigned*)(F.lds + MISC_OFF);
    for (int u = F.tid; u < (LDS_BYTES - RING_BYTES) / 4; u += NT) ((LAS unsigned*)(F.lds + RING_BYTES))[u] = 0u;
    __syncthreads();
#if MK_ONE_LAUNCH
    XcdBarrier bar = xcd_barrier_post(ctl + CW_BAR, MISC + 8);
#define GRID_BAR() xcd_barrier(bar)
#else
#define GRID_BAR() do { } while (0)
#endif
    const int lo = args.ph_lo, hi = args.ph_hi;
#define IN(k) (lo <= (k) && (k) < hi)
#define SEAM(k) do { if (IN(k) && IN((k) + 1)) GRID_BAR(); } while (0)

    bf16* WT_IN = (bf16*)(ws + WS_WT_IN); bf16* WT_UP = (bf16*)(ws + WS_WT_UP); bf16* WT_DOWN = (bf16*)(ws + WS_WT_DOWN); bf16* WT_OUT = (bf16*)(ws + WS_WT_OUT);
    bf16* WT_PEG = (bf16*)(ws + WS_WT_PEG); bf16* WT_BRA = (bf16*)(ws + WS_WT_BRA); bf16* WT_BRB = (bf16*)(ws + WS_WT_BRB); bf16* WT_PE = (bf16*)(ws + WS_WT_PE);
    bf16* WL1 = (bf16*)(ws + WS_WL1); bf16* WG = (bf16*)(ws + WS_WG);
    bf16* H = (bf16*)(ws + WS_H); bf16* PROJ = (bf16*)(ws + WS_PROJ); bf16* UP = (bf16*)(ws + WS_PROJ);
    unsigned char* SCAN = ws + WS_SCAN; bf16* ACT = (bf16*)(ws + WS_SCAN); float* TMP = (float*)(ws + WS_SCAN);
    bf16* Gb = (bf16*)(ws + WS_G); float* LA = (float*)(ws + WS_LA); bf16* AL1 = (bf16*)(ws + WS_AL1); bf16* AG = (bf16*)(ws + WS_AG); bf16* PB = (bf16*)(ws + WS_PB);
    float* BONUS = (float*)(ws + WS_BONUS); bf16* PPb = (bf16*)(ws + WS_PP);
    bf16* QDg = (bf16*)(ws + WS_QD); bf16* KDDTg = (bf16*)(ws + WS_KDDT); bf16* VTg = (bf16*)(ws + WS_VT); bf16* ATTg = (bf16*)(ws + WS_ATT); float* EBg = (float*)(ws + WS_EB);
    float* MO = (float*)(ws + WS_PROJ); float* FF = (float*)(ws + WS_PROJ);
    float* MOS = (float*)(ws + WS_PROJ + 144 * MiB); float* FFS = (float*)(ws + WS_PROJ + 240 * MiB);
    bf16* L1 = (bf16*)(out + O_GLA_S);
    float* OA = out + O_Y; float* OB = out + O_Y + (size_t)T * 2048;
    bf16* OAP = H; bf16* OBP = H + (size_t)T * 2048;
    bf16* MIXED = (bf16*)(out + O_Y);
    float* Y = out + O_Y;

    if (IN(0)) {
        LAS float* scr = (LAS float*)(F.lds + F.wave * 16384);
        constexpr int I0 = 64 * (NPROJ / 32), I8 = 4 * 64;
#define P0_DESC(it_) ((it_) < I0 ? TrDesc{args.in[I_WIN], WT_IN, D, 20944, NPROJ / 32, (it_), true} : TrDesc{args.in[I_WGATE2], WG, 256, 2048, 2048 / 32, (it_) - I0, false})
        {   float ta[32], tb[32]; int it = F.gw;
            if (it < I0 + I8) { TrDesc da = P0_DESC(it), db = da; tr_load(da, ta, F.lane);
                for (; it < I0 + I8; it += 2 * F.NGW) {
                    const int i1 = it + F.NGW, i2 = it + 2 * F.NGW; const bool h1 = i1 < I0 + I8, h2 = i2 < I0 + I8;
                    if (h1) { db = P0_DESC(i1); tr_load(db, tb, F.lane); }
                    tr_finish(da, ta, scr, F.lane);
                    if (h2) { da = P0_DESC(i2); tr_load(da, ta, F.lane); }
                    if (h1) tr_finish(db, tb, scr, F.lane);
                } }
        }
#undef P0_DESC
        for (int e0 = F.vcu * NT + F.tid; e0 < NL1 * 256; e0 += 10 * F.G * NT) {
            float v[10];
#pragma unroll
            for (int j = 0; j < 10; ++j) { const int e = e0 + j * F.G * NT, k = e / NL1, n = e - k * NL1; const float* src = nullptr;
                if (e < NL1 * 256) {
                    if (n < 1024) { if (k < 16) src = args.in[I_WALPHA2] + k * 1024 + n; }
                    else if (n < 3072) { if (k >= 16 && k < 112) src = args.in[I_WDECAY2] + (k - 16) * 2048 + (n - 1024); }
                    else { if (k >= 112 && k < 208) src = args.in[I_WICLR2] + (k - 112) * 2048 + (n - 3072); } }
                v[j] = src ? *src : 0.f; }
#pragma unroll
            for (int j = 0; j < 10; ++j) { const int e = e0 + j * F.G * NT, k = e / NL1, n = e - k * NL1; if (e < NL1 * 256) WL1[n * 256 + k] = (bf16)f2bf(v[j]); }
        }
        for (int m = F.gw; m < T; m += F.NGW) {
            rms_row_bf16(xrow(args, m), args.in[I_GPREMIX], H + (size_t)m * D, F.lane);
            const float* pr = m < TP ? args.in[I_PP] + (size_t)m * 256 : args.in[I_PS] + (size_t)(m - TP) * 256;
            const f32x4 pv = *((const f32x4*)pr + F.lane); v2u w; w.x = pk2(pv.x, pv.y); w.y = pk2(pv.z, pv.w); *((v2u*)(PB + (size_t)m * 256) + F.lane) = w;
        }
    }
    SEAM(0);
    if (IN(1)) { run_gemm(F, H, WT_IN, T, NPROJ, D, FStoreBf16{PROJ, NPROJ});
        if (F.G == 256) { constexpr int rem = ((T / 256) * (NPROJ / 256)) % 256; const int c = (int)blockIdx.x;
            if (c >= rem) {
#pragma unroll 1
                for (int k = 0; k < NT1; ++k) late_chunk(F, args, ws, NTB * TAILB + k * 120 + c - rem); } }
    }
    SEAM(1);
    if (IN(2)) {
        const float* mu = args.in[I_MU];
        for (int m = F.gw; m < T; m += F.NGW) {
            const SeqPos sp = seqpos(m); const bf16* pr = PROJ + (size_t)m * NPROJ; const bf16* pp = pr - NPROJ;
            const float* sh = args.in[I_SSHIFT] + (size_t)sp.b * ZRC;
            for (int c = F.lane; c < 256; c += 64) {
                float val = 0.f;
                if (c < 16) val = bf2f(pr[CSM + c]);
                else if (c < 208) { const int oz = c < 112 ? 2048 + (c - 16) : 6240 + (c - 112); const float z = bf2f(pr[CSM + c]);
                    const float prev = sp.t > 0 ? bf2f(pp[CSM + c]) : (sp.prm ? 0.f : sh[oz]); const float zs = z + (prev - z) * mu[oz]; val = c < 112 ? tanhf(zs) : zs; }
                AL1[(size_t)m * 256 + c] = (bf16)f2bf(val);
                { const int oz = 6336 + c; const float z = bf2f(pr[CXG + c]); const float prev = sp.t > 0 ? bf2f(pp[CXG + c]) : (sp.prm ? 0.f : sh[oz]);
                  const float zs = z + (prev - z) * mu[oz]; AG[(size_t)m * 256 + c] = (bf16)f2bf(sigmoidf_(zs)); }
            }
            if (sp.t == sp.L - 1) { float* so = out + (sp.prm ? O_SHIFT_P : O_SHIFT_S) + (size_t)sp.b * ZRC;
                for (int oz = F.lane; oz < ZRC; oz += 64) so[oz] = bf2f(pr[zr_col(oz)]); }
        }
    }
    SEAM(2);
    if (IN(3)) {
        run_gemm(F, AL1, WL1, T, NL1, 256, FStoreBf16{L1, NL1});
        run_gemm(F, AG, WG, T, 2048, 256, FStoreBf16{Gb, 2048});
    }
    SEAM(3);
    if (IN(4)) {
        {
            const int hq = F.gw & 7, c0 = hq * 256 + 4 * F.lane; const float* mu = args.in[I_MU];
            P4Par P; P.mur = *(const f32x4*)(mu + c0); P.muk = *(const f32x4*)(mu + 2144 + c0); P.muv = *(const f32x4*)(mu + 4192 + c0);
            P.a0 = *(const f32x4*)(args.in[I_A0] + c0); P.w0 = *(const f32x4*)(args.in[I_W0] + c0); P.kk = *(const f32x4*)(args.in[I_KK] + c0); P.ka = *(const f32x4*)(args.in[I_KA] + c0);
            P.rk = *(const f32x4*)(args.in[I_RK] + c0); P.ba = *(const f32x4*)(args.in[I_BALPHA] + (c0 & 1023));
            if (F.G == 256) {
                const int g = F.vcu;
#pragma unroll 1
                for (int i = 0; i < 36; i += 2) { const int ma = i < 32 ? 32 * g + i : TP + 4 * g + (i - 32), ita = ma * 8 + hq, itb = ita + 8;
                    const P4In xa = p4_load(PROJ, L1, ita, F.lane), xb = p4_load(PROJ, L1, itb, F.lane);
                    p4_compute(xa, P, args.in[I_SSHIFT], SCAN, BONUS, LA, ita, F.lane);
                    p4_compute(xb, P, args.in[I_SSHIFT], SCAN, BONUS, LA, itb, F.lane); }
                asm volatile("s_waitcnt vmcnt(0)" ::: "memory");
                LAS unsigned char* wl = F.lds + F.wave * 16384;
                RwRec R; rw_prep_load<0, 8>(R, F.lane, SCAN, 32 * g, 4 * hq);
#pragma unroll 1
                for (int k = 0; k < 8; ++k) { const int h = 4 * hq + (k & 3), mb = 32 * g + 16 * (k >> 2), b = mb >> 11, c = (mb & 2047) >> 4; const size_t uc = (size_t)(b * 32 + h) * RW_NCH + c;
                    rw_prep_load<8, 16>(R, F.lane, SCAN, mb, h);
                    rw_prep_a(R, wl, F.lane, ws + WS_RW2 + uc * RW_A2);
                    { const int kn = k < 7 ? k + 1 : 7; rw_prep_load<0, 8>(R, F.lane, SCAN, 32 * g + 16 * (kn >> 2), 4 * hq + (kn & 3)); }
                    rw_prep_b(wl, F.lane, ws + WS_RW1 + uc * RW_A1); }
            } else
            for (int it = F.gw; it < T * 8; it += 2 * F.NGW) {
                const int it2 = it + F.NGW; const bool has2 = it2 < T * 8;
                const P4In xa = p4_load(PROJ, L1, it, F.lane), xb = p4_load(PROJ, L1, has2 ? it2 : it, F.lane);
                p4_compute(xa, P, args.in[I_SSHIFT], SCAN, BONUS, LA, it, F.lane);
                if (has2) p4_compute(xb, P, args.in[I_SSHIFT], SCAN, BONUS, LA, it2, F.lane);
            }
        }
        for (int uu = F.vcu; uu < 512; uu += F.G) gla_prep_unit(F, PROJ, L1, args.in[I_BALPHA], QDg, KDDTg, VTg, ATTg, EBg, uu >> 2, uu & 3);
    }
    SEAM(4);
    if (IN(5)) {
        const int g = F.vcu;
        if (g < 256) { const int u = g >> 1;
            if ((g & 1) == 0) {
                if (F.G == 256) { if ((g & 3) == 0)
                        rwkv_chunk_scan_lds(F, ws + WS_RW1, ws + WS_RW2, (g >> 2) * 2, out + O_RWKV_P, OB); }
                else { const int b = u >> 5, h = u & 31; rwkv_unit<0>(F, SCAN, b * SEQ, SEQ, h, nullptr, out + O_RWKV_P + (size_t)(b * 32 + h) * 4096, OB); } }
            else { const int b = u >> 5, h = (u >> 3) & 3, vs = u & 7; gla_prompt_unit(F, QDg, KDDTg, VTg, ATTg, EBg, OA, out + O_GLA_P, b, h, vs); } }
        for (;;) {
            __syncthreads();
            if (F.tid == 0) MISC[0] = atomicAdd(ctl + CW_QUEUE, 1u);
            __syncthreads();
            const unsigned q = MISC[0];
            const bool tails = F.G == 256; const unsigned nq = tails ? (unsigned)(NLATE_CHUNKS - NTB * TAILB - TAIL1) : (unsigned)NLATE_CHUNKS;
            if (q >= 512u + nq + 1024u) break;
            if (q < 512u) { gla_sample_unit(F, PROJ, LA, OA, args.in[I_SGLA], out + O_GLA_S, (int)(q >> 2), (int)(q & 3)); }
            else if (q < 512u + nq) { int ch = (int)q - 512; if (tails) ch += NTB * TAILB + TAIL1;
                late_chunk(F, args, ws, ch); }
            else { const int u4 = (int)(q - 512u - nq), u = u4 * 4, b = u >> 5, h = u & 31;
                rwkv_unit<4>(F, SCAN, TP + b * DSEQ, DSEQ, h, args.in[I_SRWKV] + (size_t)u * 4096, out + O_RWKV_S + (size_t)u * 4096, OB); }
        }
    }
    SEAM(5);
    if (IN(6)) {
        {   const int hq = F.gw & 7, c0 = hq * 256 + 4 * F.lane;
            const f32x4 lnw = *(const f32x4*)(args.in[I_LNXW] + c0), lnb = *(const f32x4*)(args.in[I_LNXB] + c0);
            for (int it = F.gw; it < T * 8; it += 2 * F.NGW) {
                const int it2 = it + F.NGW; const bool has2 = it2 < T * 8;
                const P6In xa = p6_load(OB, SCAN, BONUS, Gb, it, F.lane), xb = p6_load(OB, SCAN, BONUS, Gb, has2 ? it2 : it, F.lane);
                p6_compute(xa, lnw, lnb, OBP, it, F.lane);
                if (has2) p6_compute(xb, lnw, lnb, OBP, it2, F.lane);
            }
        }
        for (int idx = F.gw; idx < T * 4; idx += F.NGW) {
            const int m = idx >> 2, h = idx & 3; const float* op = OA + (size_t)m * 2048 + h * 512 + F.lane * 8;
            const f32x4 o0 = *(const f32x4*)op, o1 = *(const f32x4*)(op + 4);
            const float ss = wave_sum((o0.x * o0.x + o0.y * o0.y) + (o0.z * o0.z + o0.w * o0.w) + (o1.x * o1.x + o1.y * o1.y) + (o1.z * o1.z + o1.w * o1.w));
            const float rs = __builtin_amdgcn_rsqf(ss * (1.f / 512.f) + 1e-6f);
            const f32x4 g0 = *(const f32x4*)(args.in[I_GLANORM] + F.lane * 8), g1 = *(const f32x4*)(args.in[I_GLANORM] + F.lane * 8 + 4);
            const v4u zg = *(const v4u*)(PROJ + (size_t)m * NPROJ + CZG + h * 512 + F.lane * 8);
            const float z[8] = {bflo(zg.x), bfhi(zg.x), bflo(zg.y), bfhi(zg.y), bflo(zg.z), bfhi(zg.z), bflo(zg.w), bfhi(zg.w)};
            const float o[8] = {o0.x * g0.x, o0.y * g0.y, o0.z * g0.z, o0.w * g0.w, o1.x * g1.x, o1.y * g1.y, o1.z * g1.z, o1.w * g1.w};
            float y[8];
#pragma unroll
            for (int i = 0; i < 8; ++i) y[i] = o[i] * rs * z[i] * sigmoidf_(z[i]);
            v4u w; w.x = pk2(y[0], y[1]); w.y = pk2(y[2], y[3]); w.z = pk2(y[4], y[5]); w.w = pk2(y[6], y[7]);
            *(v4u*)(OAP + (size_t)m * 2048 + h * 512 + F.lane * 8) = w;
        }
    }
    SEAM(6);
    if (IN(7)) {
        const int cblk = (int)blockIdx.x; const bool tails = F.G == 256;
        run_gemm_chain(F, OAP, WT_BRA, OBP, WT_BRB, T, D, 2048, FBranch{PROJ, MIXED});
        if (tails && cblk >= 64) {
#pragma unroll 1
            for (int k = 0; k < NTB; ++k) late_chunk(F, args, ws, k * TAILB + cblk - 64); }
    }
    SEAM(7);
    if (IN(8)) { run_gemm_split(F, MIXED, WT_OUT, T, D, D, FStoreF32Split{MO, D, MOS, TP, (size_t)TS * D, (bf16*)MO}); }
    SEAM(8);
    if (IN(9)) { for (int m = F.gw; m < T; m += F.NGW) sandwich_row(MO + (size_t)m * D, m < TP ? (const bf16*)MO + (size_t)m * D : nullptr, MOS + (size_t)(m - TP) * D, (size_t)TS * D, m >= TP ? 3 : 0, xrow(args, m), args.in[I_GPOSTMIX], Y + (size_t)m * D, args.in[I_GPREFFN], H + (size_t)m * D, F.lane); }
    SEAM(9);
    if (IN(10)) {
        if (F.G == 256) {
            constexpr int NUPT = (T / 256) * (NUP / 256), FULL = (NUPT / 256) * 256, NQ = (NUPT - FULL) * 4;
            run_gemm_lim(F, H, WT_UP, T, NUP, D, FStoreBf16{UP, NUP}, FULL);
            const int c = (int)blockIdx.x;
            if (c < NQ) { const int cq = (c & 7) * (NQ / 8) + (c >> 3); pg8::StaticOrder S; S.init(T, NUP, D, 256, 0); pg8::Unit u; S.tile(FULL + (cq >> 2), u);
                pg8::gemm_quarter(F.lds, H, WT_UP, D, 2 * u.pm + ((cq >> 1) & 1), 2 * u.pn + (cq & 1), FStoreBf16{UP, NUP}); }
            else run_gemm_gc(F, PB, WT_PE, T, D, 256, FStoreBf16{PPb, D}, 256 - NQ, c - NQ);
        } else { run_gemm(F, H, WT_UP, T, NUP, D, FStoreBf16{UP, NUP});
        { const int nup = (T / 256) * (NUP / 256), rem = nup % F.G; const int c = (int)blockIdx.x;
          if (rem == 0) run_gemm(F, PB, WT_PE, T, D, 256, FStoreBf16{PPb, D});
          else if (c >= rem) run_gemm_gc(F, PB, WT_PE, T, D, 256, FStoreBf16{PPb, D}, F.G - rem, c - rem); } }
    }
    SEAM(10);
    if (IN(11)) {
        const float* cw = args.in[I_CONVW]; const float* cb = args.in[I_CONVB];
        const int rpw = (T + F.G - 1) / F.G, mlo = F.vcu * rpw, mhi = (mlo + rpw < T) ? mlo + rpw : T;
        for (int jc = F.tid; jc < DFF / 8; jc += NT) {
            const int j = jc * 8;
            f32x4 cbv[2], c0v[2], c1v[2], c2v[2];
#pragma unroll
            for (int e = 0; e < 2; ++e) { cbv[e] = *(const f32x4*)(cb + j + 4 * e); c0v[e] = *(const f32x4*)(cw + j + 4 * e); c1v[e] = *(const f32x4*)(cw + DFF + j + 4 * e); c2v[e] = *(const f32x4*)(cw + 2 * DFF + j + 4 * e); }
            f32x4 h1[2] = {{0.f, 0.f, 0.f, 0.f}, {0.f, 0.f, 0.f, 0.f}}, h2[2] = {{0.f, 0.f, 0.f, 0.f}, {0.f, 0.f, 0.f, 0.f}};
            if (mlo >= 1 && mlo < mhi) { const v4u x = *(const v4u*)(UP + (size_t)(mlo - 1) * NUP + j); h1[0] = (f32x4){bflo(x.x), bfhi(x.x), bflo(x.y), bfhi(x.y)}; h1[1] = (f32x4){bflo(x.z), bfhi(x.z), bflo(x.w), bfhi(x.w)}; }
            if (mlo >= 2 && mlo < mhi) { const v4u x = *(const v4u*)(UP + (size_t)(mlo - 2) * NUP + j); h2[0] = (f32x4){bflo(x.x), bfhi(x.x), bflo(x.y), bfhi(x.y)}; h2[1] = (f32x4){bflo(x.z), bfhi(x.z), bflo(x.w), bfhi(x.w)}; }
            v4u g2[4], uv[4], g2n[4], uvn[4];
#pragma unroll
            for (int i = 0; i < 4; ++i) { const int m = (mlo + i < mhi) ? mlo + i : (mhi > 0 ? mhi - 1 : 0); const bf16* ur = UP + (size_t)m * NUP + j; g2[i] = *(const v4u*)ur; uv[i] = *(const v4u*)(ur + DFF); }
            for (int mb = mlo; mb < mhi; mb += 4) {
#pragma unroll
                for (int i = 0; i < 4; ++i) { const int m = (mb + 4 + i < mhi) ? mb + 4 + i : mhi - 1; const bf16* ur = UP + (size_t)m * NUP + j; g2n[i] = *(const v4u*)ur; uvn[i] = *(const v4u*)(ur + DFF); }
#pragma unroll
                for (int i = 0; i < 4; ++i) { const int m = mb + i;
                    if (m < mhi) { const SeqPos sp = seqpos(m); const float* st = args.in[I_SCONV] + (size_t)sp.b * 2 * DFF + j;
                        f32x4 t0[2], t1[2];
                        if (sp.t >= 1) { t1[0] = h1[0]; t1[1] = h1[1]; }
                        else if (sp.prm) { t1[0] = (f32x4){0.f, 0.f, 0.f, 0.f}; t1[1] = t1[0]; } else { t1[0] = *(const f32x4*)(st + DFF); t1[1] = *(const f32x4*)(st + DFF + 4); }
                        if (sp.t >= 2) { t0[0] = h2[0]; t0[1] = h2[1]; }
                        else if (sp.prm) { t0[0] = (f32x4){0.f, 0.f, 0.f, 0.f}; t0[1] = t0[0]; } else { t0[0] = *(const f32x4*)(st + sp.t * DFF); t0[1] = *(const f32x4*)(st + sp.t * DFF + 4); }
                        const v4u g = g2[i], u = uv[i];
                        const f32x4 t2[2] = {{bflo(g.x), bfhi(g.x), bflo(g.y), bfhi(g.y)}, {bflo(g.z), bfhi(g.z), bflo(g.w), bfhi(g.w)}};
                        const f32x4 vv[2] = {{bflo(u.x), bfhi(u.x), bflo(u.y), bfhi(u.y)}, {bflo(u.z), bfhi(u.z), bflo(u.w), bfhi(u.w)}};
                        f32x4 a[2];
#pragma unroll
                        for (int e = 0; e < 2; ++e) { const f32x4 cv = cbv[e] + t0[e] * c0v[e] + t1[e] * c1v[e] + t2[e] * c2v[e];
                            const f32x4 tq = cv * ((cv * cv) * (-2.0f * 0.7978845608028654f * 0.044715f * 1.4426950408889634f) + (-2.0f * 0.7978845608028654f * 1.4426950408889634f));
#pragma unroll
                            for (int x = 0; x < 4; ++x) a[e][x] = cv[x] * vv[e][x] * __builtin_amdgcn_rcpf(1.0f + __builtin_amdgcn_exp2f(tq[x])); }
                        v4u w; w.x = cvt_pk_bf16(a[0][0], a[0][1]); w.y = cvt_pk_bf16(a[0][2], a[0][3]); w.z = cvt_pk_bf16(a[1][0], a[1][1]); w.w = cvt_pk_bf16(a[1][2], a[1][3]);
                        *(v4u*)(ACT + (size_t)m * DFF + j) = w;
                        if (sp.t >= sp.L - 2) { float* co = out + (sp.prm ? O_CONV_P : O_CONV_S) + ((size_t)sp.b * 2 + (sp.t - (sp.L - 2))) * DFF + j; *(f32x4*)co = t2[0]; *(f32x4*)(co + 4) = t2[1]; }
                        h2[0] = h1[0]; h2[1] = h1[1]; h1[0] = t2[0]; h1[1] = t2[1]; }
                }
#pragma unroll
                for (int i = 0; i < 4; ++i) { g2[i] = g2n[i]; uv[i] = uvn[i]; }
            }
        }
    }
    SEAM(11);
    if (IN(12)) { run_gemm_split(F, ACT, WT_DOWN, T, D, DFF, FStoreF32Split{FF, D, FFS, TP, (size_t)TS * D, (bf16*)FF});
    }
    SEAM(12);
    if (IN(13)) {
        for (int m = F.gw; m < T; m += F.NGW) sandwich_row(FF + (size_t)m * D, m < TP ? (const bf16*)FF + (size_t)m * D : nullptr, FFS + (size_t)(m - TP) * D, (size_t)TS * D, m >= TP ? 3 : 0, Y + (size_t)m * D, args.in[I_GPOSTFFN], Y + (size_t)m * D, args.in[I_GPE], H + (size_t)m * D, F.lane);
    }
    SEAM(13);
    if (IN(14)) {
        if (F.G == 256) {
            run_gemm(F, H, WT_PEG, TP, D, D, FPeg{Y, PPb});
            const int c = (int)blockIdx.x, x = c & 7, idx = c >> 3;
            pg8::gemm_quarter(F.lds, H, WT_PEG, D, TP / 128 + (idx & 7), 4 * x + (idx >> 3), FPeg{Y, PPb});
        } else run_gemm(F, H, WT_PEG, T, D, D, FPeg{Y, PPb});
    }
#undef IN
#undef SEAM
}

extern "C" void kernel_launch(void* const* d_in, const int* in_sizes, int n_in, void* d_out, int out_size, void* d_ws, size_t ws_size, hipStream_t stream) {
    static int grid = 0;
    if (grid == 0) {
        if (n_in != 37 || out_size != (int)O_END || ws_size < WS_END) { fprintf(stderr, "kernel_launch: unexpected shapes (n_in %d out %d ws %zu)\n", n_in, out_size, ws_size); grid = -1; return; }
        int dev = 0, cus = 0, per_cu = 0;
        if (hipGetDevice(&dev) != hipSuccess || hipDeviceGetAttribute(&cus, hipDeviceAttributeMultiprocessorCount, dev) != hipSuccess) { grid = -1; return; }
        if (hipFuncSetAttribute((const void*)fwd_kernel, hipFuncAttributeMaxDynamicSharedMemorySize, LDS_BYTES) != hipSuccess) { fprintf(stderr, "kernel_launch: hipFuncSetAttribute failed\n"); grid = -1; return; }
        if (hipOccupancyMaxActiveBlocksPerMultiprocessor(&per_cu, (const void*)fwd_kernel, NT, LDS_BYTES) != hipSuccess || per_cu < 1) { fprintf(stderr, "kernel_launch: occupancy query says %d\n", per_cu); (void)hipGetLastError(); grid = -1; return; }
        grid = cus;
    }
    if (grid < 0) return;
    (void)hipMemsetAsync((char*)d_ws + WS_CTL, 0, CTL_ZERO_BYTES, stream);
    Args a{};
    for (int i = 0; i < 37; ++i) a.in[i] = (const float*)d_in[i];
    a.out = (float*)d_out; a.ws = (unsigned char*)d_ws;
#if MK_ONE_LAUNCH
    a.ph_lo = 0; a.ph_hi = N_PHASES;
    hipLaunchKernelGGL(fwd_kernel, dim3(grid), dim3(NT), LDS_BYTES, stream, a);
#else
    for (int p = 0; p < N_PHASES; ++p) { a.ph_lo = p; a.ph_hi = p + 1; hipLaunchKernelGGL(fwd_kernel, dim3(grid), dim3(NT), LDS_BYTES, stream, a); }
#endif
}
```

```cpp
#include <hip/hip_runtime.h>
#include <cstdio>
#include <cstdint>
#ifndef MK_ONE_LAUNCH
#define MK_ONE_LAUNCH 1
#endif
namespace pg8 {
#define PG8_LAS __attribute__((address_space(3)))
typedef unsigned short bf16_t;
typedef short bf16x8 __attribute__((ext_vector_type(8)));
typedef float f32x4 __attribute__((ext_vector_type(4)));
typedef unsigned u32x4 __attribute__((ext_vector_type(4)));
constexpr int BM = 256, BK = 64, HALF = 128, HTB = HALF * BK * 2  , STAGE_BYTES = 8 * HTB, NXCD = 8, WGM = 8;

__host__ __device__ __forceinline__ int lds_byte(int r, int c) { const int st = (r >> 4) * 2 + (c >> 5), rr = r & 15, cc = c & 31, ob = rr * 64 + cc * 2; return st * 1024 + (ob ^ (((ob >> 9) & 1) << 5)); }
__host__ __device__ __forceinline__ void stage_rc(int b, int& R, int& C) { const int st = b / 1024, sb = b % 1024, swz = sb ^ (((sb >> 9) & 1) << 5); R = (st >> 1) * 16 + swz / 64; C = (st & 1) * 32 + (swz % 64) / 2; }
__host__ __device__ __forceinline__ int perm32(int rho) { const int n = rho >> 4, i = rho & 15; return 8 * (i >> 2) + 4 * n + (i & 3); }

struct Unit { int pm, pn, k0, nt, part; };
struct Gemm { const bf16_t* A; const bf16_t* Bt; int M, N, K; const bf16_t* A2; const bf16_t* Bt2; };

struct StaticOrder {
    int nM, nN, nwg, G, c, ntk, lim;
    __host__ __device__ __forceinline__ void init(int M, int N, int K, int G_, int c_) { nM = M / BM; nN = N / BM; nwg = nM * nN; G = G_; c = c_; ntk = K / BK; lim = nwg; }
    __host__ __device__ __forceinline__ bool next(int i, Unit& u) const { const long L = (long)i * G + c; if (L >= lim) return false; tile(L, u); return true; }
    __host__ __device__ __forceinline__ bool tile(long L, Unit& u) const {
        int wgid = (int)L; { const int q = nwg / NXCD, r = nwg % NXCD, xcd = wgid % NXCD, off = wgid / NXCD; wgid = (xcd < r ? xcd * (q + 1) : r * (q + 1) + (xcd - r) * q) + off; }
        const int nig = WGM * nN, gid = wgid / nig, fm = gid * WGM, gsz = (nM - fm) < WGM ? (nM - fm) : WGM;
        u.pm = fm + ((wgid % nig) % gsz); u.pn = (wgid % nig) / gsz; u.k0 = 0; u.nt = ntk; u.part = 0; return true;
    }
    __device__ __forceinline__ void a_ready(const Unit&) const {}
    __device__ __forceinline__ void done(const Unit&) const {}
};

struct SplitOrder {
    StaticOrder full; int G, c, rounds, R, parts, pm0, nN, ntk; bool split;
    __host__ __device__ __forceinline__ void init(int M, int N, int K, int G_, int c_) {
        const int nM = M / BM; nN = N / BM; G = G_; c = c_; ntk = K / BK; const int U = nM * nN; rounds = U / G; R = U - rounds * G;
        const int pr = R > 0 ? G / R : 1;
        split = R > 0 && (G % R) == 0 && (R % nN) == 0 && ((rounds * G) % nN) == 0 && pr <= 4 && (ntk / 2) >= pr && (G % NXCD) == 0 && (NXCD % pr) == 0 && (NXCD / pr) * (G / NXCD) == R;
        parts = split ? pr : 1; pm0 = split ? (rounds * G) / nN : nM; full.init(pm0 * BM, N, K, G, c);
    }
    __host__ __device__ __forceinline__ bool next(int i, Unit& u) const {
        Unit f; const bool okf = full.next(i, f);
        const int x = c % NXCD, idx = c / NXCD, npx = G / NXCD, p = x % parts, grp = x / parts, tile = grp * npx + idx;
        const int pairs = ntk / 2, q = pairs / parts, rem = pairs % parts;
        const bool isp = split && i == rounds;
        u.pm = isp ? pm0 + tile / nN : f.pm; u.pn = isp ? tile % nN : f.pn; u.part = isp ? p : 0;
        u.nt = isp ? 2 * (q + (p < rem ? 1 : 0)) : ntk; u.k0 = isp ? 2 * BK * (p * q + (p < rem ? p : rem)) : 0;
        return isp || ((!split || i < rounds) && okf);
    }
    __device__ __forceinline__ void a_ready(const Unit&) const {}
    __device__ __forceinline__ void done(const Unit&) const {}
};

struct ChainOrder {
    StaticOrder full;
    __host__ __device__ __forceinline__ void init(int M, int N, int K, int G_, int c_) { full.init(M, N, K, G_, c_); }
    __host__ __device__ __forceinline__ bool next(int i, Unit& u) const { const bool ok = full.next(i >> 1, u); u.part = i & 1; return ok; }
    __device__ __forceinline__ void a_ready(const Unit&) const {}
    __device__ __forceinline__ void done(const Unit&) const {}
};
__device__ __forceinline__ unsigned cvt_pk_bf16(float lo, float hi) { unsigned r; asm volatile("v_cvt_pk_bf16_f32 %0, %1, %2" : "=v"(r) : "v"(lo), "v"(hi)); return r; }
typedef float f32x2 __attribute__((ext_vector_type(2)));
template <class F> struct EpiRow8 {
    static constexpr bool PERM = true, AFTER_DRAIN = false, CHAIN = false;
    F f;
    __device__ __forceinline__ void operator()(const f32x4 (&acc)[2][2][4][2], const Unit& u, int wr, int wc, int fr, int fq) const {
        const int row0 = u.pm * BM + wr * 64 + fr, col0 = u.pn * BM + wc * 32 + 8 * fq;
#pragma unroll
        for (int ai = 0; ai < 2; ++ai)
#pragma unroll
            for (int m = 0; m < 4; ++m) {
#pragma unroll
                for (int bj = 0; bj < 2; ++bj) f(row0 + ai * HALF + m * 16, col0 + bj * HALF, acc[ai][bj][m][0], acc[ai][bj][m][1], u.part);
            }
    }
};

template <class F> struct EpiRow8Chain {
    static constexpr bool PERM = true, AFTER_DRAIN = false, CHAIN = true;
    F f;
    __device__ __forceinline__ void mid(f32x4 (&acc)[2][2][4][2], const Unit& u, int wr, int wc, int fr, int fq) const {
        const int row0 = u.pm * BM + wr * 64 + fr, col0 = u.pn * BM + wc * 32 + 8 * fq;
#pragma unroll
        for (int ai = 0; ai < 2; ++ai)
#pragma unroll
            for (int m = 0; m < 4; ++m) {
#pragma unroll
                for (int bj = 0; bj < 2; ++bj) f.mid(row0 + ai * HALF + m * 16, col0 + bj * HALF, acc[ai][bj][m][0], acc[ai][bj][m][1]);
            }
    }
    __device__ __forceinline__ void operator()(const f32x4 (&acc)[2][2][4][2], const Unit& u, int wr, int wc, int fr, int fq) const {
        const int row0 = u.pm * BM + wr * 64 + fr, col0 = u.pn * BM + wc * 32 + 8 * fq;
#pragma unroll
        for (int ai = 0; ai < 2; ++ai)
#pragma unroll
            for (int m = 0; m < 4; ++m) {
#pragma unroll
                for (int bj = 0; bj < 2; ++bj) f(row0 + ai * HALF + m * 16, col0 + bj * HALF, acc[ai][bj][m][0], acc[ai][bj][m][1], u.part);
            }
    }
};
template <class Epi, class Sched, bool ALIGN_EPI = false, bool SP2 = false>
__device__ __forceinline__ void gemm_phase(PG8_LAS unsigned char* lds, const Gemm g, const Sched& S, const Epi& E) {
    const int tid = threadIdx.x, wid = __builtin_amdgcn_readfirstlane(tid >> 6), lane = tid & 63, wr = wid >> 2, wc = wid & 3, fr = lane & 15, fq = lane >> 4;
    const int K = g.K;
    unsigned voffA[2], voffB[2];
#pragma unroll
    for (int i = 0; i < 2; ++i) { int R, C; stage_rc(tid * 16 + i * 8192, R, C); const int Rb = Epi::PERM ? ((R & ~31) + perm32(R & 31)) : R;
        voffA[i] = (unsigned)(R * K + C) * 2u; voffB[i] = (unsigned)(Rb * K + C) * 2u; }
    const size_t kstep = (size_t)(BK * 2);
    const size_t hstep = (size_t)HALF * K * 2;
    const size_t tstep = 2 * hstep;
    const unsigned ldsw = (unsigned)wid * 1024u;
    const int aoff = lds_byte(wr * 64 + fr, fq * 8), boff = lds_byte(wc * 32 + fr, fq * 8);
#define PG8_SA(b, h) (((b) * 2 + (h)) * HTB)
#define PG8_SB(b, h) ((4 + (b) * 2 + (h)) * HTB)
#define PG8_STAGE(bufoff, gbase, voff) do { _Pragma("unroll") for (int _i = 0; _i < 2; ++_i) \
        __builtin_amdgcn_global_load_lds((const unsigned*)((const char*)(gbase) + (voff)[_i]), (PG8_LAS unsigned*)(lds + (bufoff) + ldsw + _i * 8192), 16, 0, 0); } while (0)
#define PG8_LDA(dst, b, h) do { _Pragma("unroll") for (int m = 0; m < 4; ++m) _Pragma("unroll") for (int k = 0; k < 2; ++k) dst[m][k] = *(const PG8_LAS bf16x8*)(lds + PG8_SA(b, h) + aoff + m * 2048 + k * 1024); } while (0)
#define PG8_LDB(dst, b, h) do { _Pragma("unroll") for (int n = 0; n < 2; ++n) _Pragma("unroll") for (int k = 0; k < 2; ++k) dst[n][k] = *(const PG8_LAS bf16x8*)(lds + PG8_SB(b, h) + boff + n * 2048 + k * 1024); } while (0)
#define PG8_MMA(ai, bj, At, Bt) do { __builtin_amdgcn_s_setprio(1); _Pragma("unroll") for (int m = 0; m < 4; ++m) _Pragma("unroll") for (int n = 0; n < 2; ++n) _Pragma("unroll") for (int k = 0; k < 2; ++k) \
        acc[ai][bj][m][n] = __builtin_amdgcn_mfma_f32_16x16x32_bf16(Bt[n][k], At[m][k], acc[ai][bj][m][n], 0, 0, 0); __builtin_amdgcn_s_setprio(0); } while (0)
#define PG8_WAIT_V(n) asm volatile("s_waitcnt vmcnt(" #n ")" ::: "memory")
#define PG8_WAIT_L(n) asm volatile("s_waitcnt lgkmcnt(" #n ")" ::: "memory")
#define PG8_BAR __builtin_amdgcn_s_barrier()
#define PG8_SCHED __builtin_amdgcn_sched_barrier(0)
    Unit cur, nxt; int ui = 0;
    if (!S.next(0, cur)) return;
    f32x4 acc[2][2][4][2];
#pragma unroll
    for (int a = 0; a < 2; ++a)
#pragma unroll
        for (int b = 0; b < 2; ++b)
#pragma unroll
            for (int m = 0; m < 4; ++m)
#pragma unroll
                for (int n = 0; n < 2; ++n) acc[a][b][m][n] = (f32x4){0.f, 0.f, 0.f, 0.f};
    bf16x8 At[4][2], B0[2][2], B1[2][2];
    const char* cA = (const char*)((Epi::CHAIN && cur.part) ? g.A2 : g.A) + (size_t)cur.pm * tstep + (size_t)cur.k0 * 2; const char* cB = (const char*)((Epi::CHAIN && cur.part) ? g.Bt2 : g.Bt) + (size_t)cur.pn * tstep + (size_t)cur.k0 * 2;
    S.a_ready(cur);
    if constexpr (SP2) {
        PG8_STAGE(PG8_SB(0, 0), cB, voffB); PG8_STAGE(PG8_SB(0, 1), cB + hstep, voffB); PG8_STAGE(PG8_SA(0, 0), cA, voffA); PG8_STAGE(PG8_SA(0, 1), cA + hstep, voffA);
        if (wr == 1) PG8_BAR;
        PG8_WAIT_V(2); PG8_BAR;
        PG8_STAGE(PG8_SB(1, 0), cB + kstep, voffB); PG8_STAGE(PG8_SA(1, 0), cA + kstep, voffA); PG8_STAGE(PG8_SB(1, 1), cB + hstep + kstep, voffB);
        PG8_WAIT_V(6); PG8_BAR;
    } else {
        PG8_STAGE(PG8_SB(0, 0), cB, voffB); PG8_STAGE(PG8_SA(0, 0), cA, voffA); PG8_STAGE(PG8_SB(0, 1), cB + hstep, voffB); PG8_STAGE(PG8_SA(0, 1), cA + hstep, voffA);
        if (wr == 1) PG8_BAR;
        PG8_WAIT_V(4); PG8_BAR;
        PG8_STAGE(PG8_SB(1, 0), cB + kstep, voffB); PG8_STAGE(PG8_SA(1, 0), cA + kstep, voffA); PG8_STAGE(PG8_SB(1, 1), cB + hstep + kstep, voffB);
        PG8_WAIT_V(6); PG8_BAR;
    }
    for (;;) {
        const bool has_next = S.next(ui + 1, nxt);
        const char* nA = has_next ? (const char*)((Epi::CHAIN && nxt.part) ? g.A2 : g.A) + (size_t)nxt.pm * tstep + (size_t)nxt.k0 * 2 : cA; const char* nB = has_next ? (const char*)((Epi::CHAIN && nxt.part) ? g.Bt2 : g.Bt) + (size_t)nxt.pn * tstep + (size_t)nxt.k0 * 2 : cB;
        const int nt = cur.nt;
        for (int t = 0; t < nt; t += 2) {
            const bool last = (t == nt - 2);
            const char* a1 = cA + (size_t)(t + 1) * kstep;
            const char* a2 = last ? nA : cA + (size_t)(t + 2) * kstep; const char* b2 = last ? nB : cB + (size_t)(t + 2) * kstep;
            const char* a3 = a2 + kstep; const char* b3 = b2 + kstep;
            if (last && has_next) S.a_ready(nxt);
            if constexpr (SP2) {
            PG8_LDB(B0, 0, 0); PG8_LDB(B1, 0, 1); PG8_SCHED; PG8_LDA(At, 0, 0); PG8_STAGE(PG8_SA(1, 1), a1 + hstep, voffA);
            PG8_WAIT_V(8); PG8_WAIT_L(0); PG8_BAR; PG8_MMA(0, 0, At, B0); PG8_MMA(0, 1, At, B1); PG8_BAR; PG8_SCHED;
            PG8_LDA(At, 0, 1); PG8_STAGE(PG8_SB(0, 0), b2, voffB); PG8_STAGE(PG8_SB(0, 1), b2 + hstep, voffB); PG8_STAGE(PG8_SA(0, 0), a2, voffA);
            PG8_WAIT_V(8); PG8_WAIT_L(0); PG8_BAR; PG8_MMA(1, 0, At, B0); PG8_MMA(1, 1, At, B1); PG8_BAR; PG8_SCHED;
            PG8_LDB(B0, 1, 0); PG8_LDB(B1, 1, 1); PG8_SCHED; PG8_LDA(At, 1, 0); PG8_STAGE(PG8_SA(0, 1), a2 + hstep, voffA);
            PG8_WAIT_V(8); PG8_WAIT_L(0); PG8_BAR; PG8_MMA(0, 0, At, B0); PG8_MMA(0, 1, At, B1); PG8_BAR; PG8_SCHED;
            PG8_LDA(At, 1, 1); PG8_STAGE(PG8_SB(1, 0), b3, voffB); PG8_STAGE(PG8_SB(1, 1), b3 + hstep, voffB); PG8_STAGE(PG8_SA(1, 0), a3, voffA);
            PG8_WAIT_V(8); PG8_WAIT_L(0); PG8_BAR; PG8_MMA(1, 0, At, B0); PG8_MMA(1, 1, At, B1); PG8_BAR; PG8_SCHED;
            } else {
            PG8_LDB(B0, 0, 0); PG8_SCHED; PG8_LDA(At, 0, 0); PG8_STAGE(PG8_SA(1, 1), a1 + hstep, voffA);
            PG8_WAIT_L(8); PG8_BAR; PG8_WAIT_L(0); PG8_MMA(0, 0, At, B0); PG8_BAR; PG8_SCHED;
            PG8_LDB(B1, 0, 1); PG8_STAGE(PG8_SB(0, 0), b2, voffB);
            PG8_BAR; PG8_WAIT_L(0); PG8_MMA(0, 1, At, B1); PG8_BAR;
            PG8_LDA(At, 0, 1); PG8_STAGE(PG8_SA(0, 0), a2, voffA);
            PG8_BAR; PG8_WAIT_L(0); PG8_MMA(1, 0, At, B0); PG8_BAR; PG8_SCHED;
            PG8_STAGE(PG8_SB(0, 1), b2 + hstep, voffB);
            PG8_WAIT_V(6); PG8_BAR; PG8_MMA(1, 1, At, B1); PG8_BAR;
            PG8_LDB(B0, 1, 0); PG8_SCHED; PG8_LDA(At, 1, 0); PG8_STAGE(PG8_SA(0, 1), a2 + hstep, voffA);
            PG8_WAIT_L(8); PG8_BAR; PG8_WAIT_L(0); PG8_MMA(0, 0, At, B0); PG8_BAR; PG8_SCHED;
            PG8_LDB(B1, 1, 1); PG8_STAGE(PG8_SB(1, 0), b3, voffB);
            PG8_BAR; PG8_WAIT_L(0); PG8_MMA(0, 1, At, B1); PG8_BAR;
            PG8_LDA(At, 1, 1); PG8_STAGE(PG8_SA(1, 0), a3, voffA);
            PG8_BAR; PG8_WAIT_L(0); PG8_MMA(1, 0, At, B0); PG8_BAR; PG8_SCHED;
            PG8_STAGE(PG8_SB(1, 1), b3 + hstep, voffB);
            PG8_WAIT_V(6); PG8_BAR; PG8_MMA(1, 1, At, B1); PG8_BAR;
            }
        }
        if constexpr (ALIGN_EPI) { if (wr == 0) PG8_BAR; }
        const bool mid_unit = Epi::CHAIN && cur.part == 0;
        if constexpr (Epi::CHAIN) { if (mid_unit) E.mid(acc, cur, wr, wc, fr, fq); else { E(acc, cur, wr, wc, fr, fq); S.done(cur); } }
        else if constexpr (!Epi::AFTER_DRAIN) { E(acc, cur, wr, wc, fr, fq); S.done(cur); }
        if (!has_next) break;
        if (!mid_unit)
#pragma unroll
        for (int a = 0; a < 2; ++a)
#pragma unroll
            for (int b = 0; b < 2; ++b)
#pragma unroll
                for (int m = 0; m < 4; ++m)
#pragma unroll
                    for (int n = 0; n < 2; ++n) acc[a][b][m][n] = (f32x4){0.f, 0.f, 0.f, 0.f};
        cur = nxt; cA = nA; cB = nB; ++ui;
        if constexpr (ALIGN_EPI) { if (wr == 1) PG8_BAR; }
    }
    PG8_WAIT_V(0);
    if constexpr (!ALIGN_EPI) { if (wr == 0) PG8_BAR; }
    PG8_BAR;
    if constexpr (Epi::AFTER_DRAIN) { E.fused(acc, cur, wr, wc, fr, fq, lds, wid, lane); S.done(cur); }
#undef PG8_SA
#undef PG8_SB
#undef PG8_STAGE
#undef PG8_LDA
#undef PG8_LDB
#undef PG8_MMA
#undef PG8_WAIT_V
#undef PG8_WAIT_L
#undef PG8_BAR
#undef PG8_SCHED
}

template <class F>
__device__ __forceinline__ void gemm_quarter(PG8_LAS unsigned char* lds, const bf16_t* A, const bf16_t* Bt, int K, int qm, int qn, const F& f) {
    const int tid = threadIdx.x, wid = __builtin_amdgcn_readfirstlane(tid >> 6), lane = tid & 63, wr = wid >> 2, wc = wid & 3, fr = lane & 15, fq = lane >> 4;
    unsigned voffA[2], voffB[2];
#pragma unroll
    for (int i = 0; i < 2; ++i) { int R, C; stage_rc(tid * 16 + i * 8192, R, C); const int Rb = (R & ~31) + perm32(R & 31);
        voffA[i] = (unsigned)(R * K + C) * 2u; voffB[i] = (unsigned)(Rb * K + C) * 2u; }
    const size_t kstep = (size_t)(BK * 2);
    const unsigned ldsw = (unsigned)wid * 1024u;
    const int aoff = lds_byte(wr * 64 + fr, fq * 8), boff = lds_byte(wc * 32 + fr, fq * 8);
    const char* cA = (const char*)A + (size_t)qm * HALF * K * 2; const char* cB = (const char*)Bt + (size_t)qn * HALF * K * 2;
    const int nt = K / BK;
#define PG8_QSTAGE(slot, t_) do { const size_t go_ = (size_t)(t_) * kstep; _Pragma("unroll") for (int _i = 0; _i < 2; ++_i) { \
        __builtin_amdgcn_global_load_lds((const unsigned*)(cA + go_ + voffA[_i]), (PG8_LAS unsigned*)(lds + (slot) * HTB + ldsw + _i * 8192), 16, 0, 0); \
        __builtin_amdgcn_global_load_lds((const unsigned*)(cB + go_ + voffB[_i]), (PG8_LAS unsigned*)(lds + (4 + (slot)) * HTB + ldsw + _i * 8192), 16, 0, 0); } } while (0)
    f32x4 acc[4][2];
#pragma unroll
    for (int m = 0; m < 4; ++m)
#pragma unroll
        for (int n = 0; n < 2; ++n) acc[m][n] = (f32x4){0.f, 0.f, 0.f, 0.f};
    bf16x8 At[4][2], Bq[2][2];
    PG8_QSTAGE(0, 0); PG8_QSTAGE(1, 1); PG8_QSTAGE(2, 2);
    for (int t = 0; t < nt; t += 4) {
#pragma unroll
        for (int sl = 0; sl < 4; ++sl) {
            asm volatile("s_waitcnt vmcnt(8)" ::: "memory"); __builtin_amdgcn_s_barrier();
            { const int tn = t + sl + 3; PG8_QSTAGE((sl + 3) & 3, tn < nt ? tn : tn - nt); }
#pragma unroll
            for (int m = 0; m < 4; ++m)
#pragma unroll
                for (int k = 0; k < 2; ++k) At[m][k] = *(const PG8_LAS bf16x8*)(lds + sl * HTB + aoff + m * 2048 + k * 1024);
#pragma unroll
            for (int n = 0; n < 2; ++n)
#pragma unroll
                for (int k = 0; k < 2; ++k) Bq[n][k] = *(const PG8_LAS bf16x8*)(lds + (4 + sl) * HTB + boff + n * 2048 + k * 1024);
            asm volatile("s_waitcnt lgkmcnt(0)" ::: "memory");
            __builtin_amdgcn_s_setprio(1);
#pragma unroll
            for (int m = 0; m < 4; ++m)
#pragma unroll
                for (int n = 0; n < 2; ++n)
#pragma unroll
                    for (int k = 0; k < 2; ++k) acc[m][n] = __builtin_amdgcn_mfma_f32_16x16x32_bf16(Bq[n][k], At[m][k], acc[m][n], 0, 0, 0);
            __builtin_amdgcn_s_setprio(0);
            __builtin_amdgcn_sched_barrier(0);
        }
    }
    asm volatile("s_waitcnt vmcnt(0)" ::: "memory"); __builtin_amdgcn_s_barrier();
#undef PG8_QSTAGE
    const int row0 = qm * HALF + wr * 64 + fr, col0 = qn * HALF + wc * 32 + 8 * fq;
#pragma unroll
    for (int m = 0; m < 4; ++m) f(row0 + m * 16, col0, acc[m][0], acc[m][1], 0);
}
}

#ifndef PG8_SP2
#define PG8_SP2 true
#endif
#ifndef PG8_ALIGN
#define PG8_ALIGN true
#endif

constexpr int NWAVES = 8, NT = 512;
constexpr int TP = 8192, TS = 1024, T = TP + TS, D = 4096;
constexpr int SEQ = 2048, DSEQ = 8, NB = 4, NDB = 128;
constexpr int NPROJ = 20992;
constexpr int CQ = 0, CK = 1024, CV = 2048, CZG = 4096, CR = 6144, CKR = 8192, CVR = 10240, CXG = 12288, CSM = 12544, CGA = 12800, CGB = 16896;
constexpr int ZRC = 6592;
constexpr int DFF = 11008, NUP = 2 * DFF;
constexpr int NL1 = 5120;
constexpr int SCAN_REC = 896;
constexpr int SCAN_LREC = 1408;
constexpr size_t O_Y = 0, O_GLA_P = 37748736, O_RWKV_P = 39845888, O_SHIFT_P = 40370176, O_CONV_P = 40396544,
                 O_GLA_S = 40484608, O_RWKV_S = 107593472, O_SHIFT_S = 124370688, O_CONV_S = 125214464, O_END = 128032512;
constexpr size_t MiB = 1u << 20;
constexpr size_t WS_CTL = 0, CTL_ZERO_BYTES = 1 * MiB;
constexpr size_t WS_WT_IN = 1 * MiB, WS_WT_UP = 165 * MiB, WS_WT_DOWN = 337 * MiB, WS_WT_OUT = 423 * MiB, WS_WT_PEG = 455 * MiB, WS_WT_BRA = 487 * MiB,
                 WS_WT_BRB = 503 * MiB, WS_WT_PE = 519 * MiB, WS_WL1 = 521 * MiB, WS_WG = 524 * MiB, WS_H = 525 * MiB, WS_PROJ = 597 * MiB,
                 WS_SCAN = 984 * MiB, WS_G = 1380 * MiB, WS_LA = 1416 * MiB, WS_AL1 = 1452 * MiB, WS_AG = 1457 * MiB, WS_PB = 1462 * MiB,
                 WS_BONUS = 1467 * MiB, WS_END = 1469 * MiB;
constexpr size_t WS_QD = WS_H, WS_KDDT = WS_H + 16 * MiB, WS_VT = WS_H + 32 * MiB, WS_ATT = WS_H + 64 * MiB, WS_EB = WS_H + 68 * MiB;
constexpr size_t WS_RW1 = WS_WT_IN, WS_RW2 = WS_SCAN + 256 * MiB;
static_assert((size_t)NB * 32 * (SEQ / 16) * 7168 <= 164 * MiB && WS_RW2 + (size_t)NB * 32 * (SEQ / 16) * 6656 <= WS_G && (size_t)T * 32 * SCAN_REC <= 256 * MiB, "chunk operand arrays");
constexpr size_t WS_PP = WS_SCAN + 200 * MiB;
constexpr int CW_QUEUE = 64;
constexpr int CW_BAR = 4096;

constexpr int RING_BYTES = 131072, MISC_OFF = RING_BYTES + 320, LDS_BYTES = 147456;

#define LAS __attribute__((address_space(3)))
typedef unsigned short bf16;
typedef unsigned v4u __attribute__((ext_vector_type(4)));
typedef unsigned v2u __attribute__((ext_vector_type(2)));
typedef float f32x4 __attribute__((ext_vector_type(4)));
#define LDS_WAIT() asm volatile("s_waitcnt lgkmcnt(0)" ::: "memory")
#define VM_WAIT() asm volatile("s_waitcnt vmcnt(0)" ::: "memory")
#define WG_BAR() do { asm volatile("s_waitcnt lgkmcnt(0)" ::: "memory"); __builtin_amdgcn_s_barrier(); asm volatile("" ::: "memory"); } while (0)
__device__ __forceinline__ unsigned f2bf(float f) { unsigned u = __builtin_bit_cast(unsigned, f); return (u + 0x7fffu + ((u >> 16) & 1u)) >> 16; }
typedef __bf16 hw_bf2 __attribute__((ext_vector_type(2)));
typedef float hw_f2 __attribute__((ext_vector_type(2)));
__device__ __forceinline__ unsigned pk2(float lo, float hi) { const hw_f2 v = {lo, hi}; return __builtin_bit_cast(unsigned, __builtin_convertvector(v, hw_bf2)); }
__device__ __forceinline__ float bf2f(unsigned b) { return __builtin_bit_cast(float, b << 16); }
__device__ __forceinline__ float bflo(unsigned w) { return __builtin_bit_cast(float, w << 16); }
__device__ __forceinline__ float bfhi(unsigned w) { return __builtin_bit_cast(float, w & 0xffff0000u); }
__device__ __forceinline__ float sigmoidf_(float x) { return __builtin_amdgcn_rcpf(1.0f + __builtin_amdgcn_exp2f(x * -1.4426950408889634f)); }
__device__ __forceinline__ float softplusf_(float x) { return fmaxf(x, 0.f) + 0.6931471805599453f * __builtin_amdgcn_logf(1.0f + __builtin_amdgcn_exp2f(fabsf(x) * -1.4426950408889634f)); }
__device__ __forceinline__ float wave_sum(float v) {
#pragma unroll
    for (int o = 1; o < 64; o <<= 1) v += __shfl_xor(v, o);
    return v;
}

#define XB_TMO      128
#define XB_XCNT(j)  (256  + 64 * (j))
#define XB_XSUB(j)  (1280 + 64 * (j))
#define XB_XGEN(j)  (2304 + 64 * (j))
#define XB_TOP      3328
#define XB_TOPGEN   3392
#define XCD_BAR_WORDS 3456
#define XB_SPIN_CAP (1u << 23)
__device__ __forceinline__ unsigned xb_ld(unsigned* p)              { return __hip_atomic_load(p, __ATOMIC_RELAXED, __HIP_MEMORY_SCOPE_AGENT); }
__device__ __forceinline__ unsigned xb_add(unsigned* p, unsigned v) { return __hip_atomic_fetch_add(p, v, __ATOMIC_RELAXED, __HIP_MEMORY_SCOPE_AGENT); }
__device__ __forceinline__ unsigned xb_xcc_id() { return (unsigned)__builtin_amdgcn_s_getreg((3 << 11) | 20) & 0xFu; }
#define XB_SPIN(cond, bar) do { unsigned _sp = 0; while (cond) { __builtin_amdgcn_s_sleep(1); \
    if ((++_sp & 255u) == 0u) { if (xb_ld(&(bar)[XB_TMO])) break; if (_sp > XB_SPIN_CAP) { atomicAdd(&(bar)[XB_TMO], 1u); break; } } } } while (0)
struct XcdBarrier { unsigned* bar; unsigned x; volatile LAS unsigned* st; };
__device__ __forceinline__ XcdBarrier xcd_barrier_post(unsigned* bar, volatile LAS unsigned* st) {
    XcdBarrier b; b.bar = bar; b.x = xb_xcc_id(); b.st = st;
    if (threadIdx.x == 0) (void)xb_add(&bar[XB_XCNT(b.x)], 1u);
    return b;
}
__device__ __forceinline__ void xcd_barrier_complete(unsigned* bar, unsigned x, unsigned& nloc, unsigned& nx) {
    const unsigned G = gridDim.x * gridDim.y * gridDim.z;
    unsigned sum, cnt, mine, sp = 0u;
    for (;;) {
        sum = 0u; cnt = 0u; mine = 0u;
#pragma unroll
        for (unsigned j = 0; j < 16; ++j) { const unsigned c = xb_ld(&bar[XB_XCNT(j)]); sum += c; cnt += (c > 0u) ? 1u : 0u; mine = (j == x) ? c : mine; }
        if (sum == G) break;
        __builtin_amdgcn_s_sleep(1);
        if ((++sp & 255u) == 0u) { if (xb_ld(&bar[XB_TMO])) break; if (sp > XB_SPIN_CAP) { atomicAdd(&bar[XB_TMO], 1u); break; } }
    }
    nloc = mine > 0u ? mine : 1u; nx = cnt > 0u ? cnt : 1u;
}
__device__ __forceinline__ void xcd_barrier(const XcdBarrier& b) {
    asm volatile("s_waitcnt vmcnt(0)" ::: "memory");
    __syncthreads();
    if (threadIdx.x == 0) {
        unsigned* bar = b.bar;
        __builtin_amdgcn_s_waitcnt(0);
        unsigned nloc = b.st[0], nx = b.st[1];
        if (nloc == 0u) { xcd_barrier_complete(bar, b.x, nloc, nx); b.st[0] = nloc; b.st[1] = nx; }
        const unsigned old = xb_add(&bar[XB_XSUB(b.x)], 1u);
        const unsigned gen = old / nloc;
        if (old + 1u == (gen + 1u) * nloc) {
            __builtin_amdgcn_fence(__ATOMIC_RELEASE, "agent");
            asm volatile("s_waitcnt vmcnt(0)" ::: "memory");
            const unsigned og = xb_add(&bar[XB_TOP], 1u);
            const unsigned tg = og / nx;
            if (og + 1u == (tg + 1u) * nx) xb_add(&bar[XB_TOPGEN], 1u);
            else XB_SPIN(xb_ld(&bar[XB_TOPGEN]) == tg, bar);
            __builtin_amdgcn_fence(__ATOMIC_ACQUIRE, "agent");
            xb_add(&bar[XB_XGEN(b.x)], 1u);
            asm volatile("s_waitcnt vmcnt(0)" ::: "memory");
        } else {
            XB_SPIN(xb_ld(&bar[XB_XGEN(b.x)]) == gen, bar);
            __builtin_amdgcn_fence(__ATOMIC_ACQUIRE, "agent");
            asm volatile("s_waitcnt vmcnt(0)" ::: "memory");
        }
    }
    __syncthreads();
}

struct Args { const float* in[37]; float* out; unsigned char* ws; int ph_lo, ph_hi; };
typedef __attribute__((address_space(4))) const Args KArgs;
struct Frame { LAS unsigned char* lds; int tid, lane, wave, vcu, G, gw, NGW; };
enum { I_XP = 0, I_XS, I_SGLA, I_SRWKV, I_SSHIFT, I_SCONV, I_PP, I_PS, I_WIN, I_WALPHA2, I_BALPHA, I_GLANORM, I_WBRA, I_MU, I_W0, I_WDECAY2, I_A0, I_WICLR2,
       I_WGATE2, I_KK, I_KA, I_RK, I_LNXW, I_LNXB, I_WBRB, I_WOUT, I_GPREMIX, I_GPOSTMIX, I_GPREFFN, I_GPOSTFFN, I_WUP, I_CONVW, I_CONVB, I_WDOWN, I_GPE, I_WPEG, I_WPE };

struct SeqPos { int b, t, L; bool prm; };
__device__ __forceinline__ SeqPos seqpos(int m) { SeqPos s; s.prm = m < TP; if (s.prm) { s.b = m >> 11; s.t = m & 2047; s.L = SEQ; } else { s.b = (m - TP) >> 3; s.t = (m - TP) & 7; s.L = DSEQ; } return s; }
__device__ __forceinline__ const float* xrow(KArgs& a, int m) { return m < TP ? a.in[I_XP] + (size_t)m * D : a.in[I_XS] + (size_t)(m - TP) * D; }

__host__ __device__ __forceinline__ int win_src16(int g) {
    const int n = g * 16;
    if (n < 4096) return n;
    if (n < 6144) return 4112 + (n - 4096);
    if (n < 8192) return 6160 + (n - 6144);
    if (n < 10240) return 8304 + (n - 8192);
    if (n < 12288) return 10352 + (n - 10240);
    if (n < 12544) return 12496 + (n - 12288);
    if (n < 12560) return 4096;
    if (n < 12656) return 8208 + (n - 12560);
    if (n < 12752) return 12400 + (n - 12656);
    if (n < 12800) return -1;
    if (n < 16896) return 12752 + (n - 12800);
    return 16848 + (n - 16896);
}
__host__ __device__ __forceinline__ int zr_col(int oz) {
    if (oz < 2048) return CR + oz;
    if (oz < 2144) return CSM + 16 + (oz - 2048);
    if (oz < 4192) return CKR + (oz - 2144);
    if (oz < 6240) return CVR + (oz - 4192);
    if (oz < 6336) return CSM + 112 + (oz - 6240);
    return CXG + (oz - 6336);
}

struct TrDesc { const float* W; bf16* WT; int K, Nsrc, nblk, item; bool map; };
__device__ __forceinline__ void tr_load(const TrDesc& d, float (&tv)[32], int lane) {
    const int kb = d.item / d.nblk, nb = d.item - kb * d.nblk, k0 = 64 * kb, n0 = 32 * nb, nl = lane & 31;
    int sc = n0 + nl;
    if (d.map) { const int s = win_src16((n0 + nl) >> 4); sc = s < 0 ? -1 : s + (nl & 15); }
    const float* wp = d.W + (size_t)(k0 + (lane >> 5)) * d.Nsrc + (sc >= 0 ? sc : 0);
#pragma unroll
    for (int i = 0; i < 32; ++i) tv[i] = __builtin_nontemporal_load(wp + (size_t)(2 * i) * d.Nsrc);
}
__device__ __forceinline__ void tr_finish(const TrDesc& d, const float (&tv)[32], LAS float* scr, int lane) {
    const int kb = d.item / d.nblk, nb = d.item - kb * d.nblk, k0 = 64 * kb, n0 = 32 * nb, nl = lane & 31;
    bool pad = false;
    if (d.map) pad = win_src16((n0 + nl) >> 4) < 0;
#pragma unroll
    for (int i = 0; i < 32; ++i) scr[(2 * i + (lane >> 5)) * 33 + nl] = pad ? 0.f : tv[i];
    LDS_WAIT(); asm volatile("" ::: "memory");
    const int c = lane & 7;
#pragma unroll
    for (int j = 0; j < 4; ++j) { const int n = (lane >> 3) + 8 * j; const LAS float* s = scr + (8 * c) * 33 + n;
        v4u o; o.x = pk2(s[0 * 33], s[1 * 33]); o.y = pk2(s[2 * 33], s[3 * 33]); o.z = pk2(s[4 * 33], s[5 * 33]); o.w = pk2(s[6 * 33], s[7 * 33]);
        *(v4u*)(d.WT + (size_t)(n0 + n) * d.K + k0 + 8 * c) = o; }
    LDS_WAIT(); asm volatile("" ::: "memory");
}
__device__ __forceinline__ void rms_row_bf16(const float* xr_, const float* gain, bf16* orow, int lane) {
    const f32x4* xr = (const f32x4*)xr_ + lane; f32x4 v[16]; float ss = 0.f;
#pragma unroll
    for (int j = 0; j < 16; ++j) { v[j] = xr[64 * j]; ss += (v[j].x * v[j].x + v[j].y * v[j].y) + (v[j].z * v[j].z + v[j].w * v[j].w); }
    const float rs = __builtin_amdgcn_rsqf(wave_sum(ss) * (1.f / D) + 1e-6f);
    const f32x4* gr = (const f32x4*)gain + lane; v2u* o = (v2u*)orow + lane;
#pragma unroll
    for (int j = 0; j < 16; ++j) { const f32x4 g = gr[64 * j]; v2u w; w.x = pk2(v[j].x * rs * g.x, v[j].y * rs * g.y); w.y = pk2(v[j].z * rs * g.z, v[j].w * rs * g.w); o[64 * j] = w; }
}
__device__ __forceinline__ void sandwich_row(const float* srow, const bf16* brow, const float* slabrow, size_t slab_stride, int nslab, const float* xi, const float* g1, float* xo, const float* g2, bf16* ho, int lane) {
    f32x4 v[16]; float ss = 0.f;
    if (brow) { const v2u* br = (const v2u*)brow + lane;
#pragma unroll
        for (int j = 0; j < 16; ++j) { const v2u x = br[64 * j]; v[j] = (f32x4){bflo(x.x), bfhi(x.x), bflo(x.y), bfhi(x.y)}; } }
    else { const f32x4* sr = (const f32x4*)srow + lane;
#pragma unroll
        for (int j = 0; j < 16; ++j) v[j] = sr[64 * j]; }
    for (int p = 0; p < nslab; ++p) { const f32x4* pr = (const f32x4*)(slabrow + (size_t)p * slab_stride) + lane;
#pragma unroll
        for (int j = 0; j < 16; ++j) v[j] += pr[64 * j]; }
#pragma unroll
    for (int j = 0; j < 16; ++j) { ss += (v[j].x * v[j].x + v[j].y * v[j].y) + (v[j].z * v[j].z + v[j].w * v[j].w); }
    const float rs = __builtin_amdgcn_rsqf(wave_sum(ss) * (1.f / D) + 1e-6f);
    const f32x4* xr = (const f32x4*)xi + lane; const f32x4* gr = (const f32x4*)g1 + lane; f32x4* xw = (f32x4*)xo + lane; float s2 = 0.f;
#pragma unroll
    for (int j = 0; j < 16; ++j) { const f32x4 x = xr[64 * j], g = gr[64 * j]; v[j] = x + v[j] * rs * g; xw[64 * j] = v[j]; s2 += (v[j].x * v[j].x + v[j].y * v[j].y) + (v[j].z * v[j].z + v[j].w * v[j].w); }
    const float r2 = __builtin_amdgcn_rsqf(wave_sum(s2) * (1.f / D) + 1e-6f);
    const f32x4* g2r = (const f32x4*)g2 + lane; v2u* o = (v2u*)ho + lane;
#pragma unroll
    for (int j = 0; j < 16; ++j) { const f32x4 g = g2r[64 * j]; v2u w; w.x = pk2(v[j].x * r2 * g.x, v[j].y * r2 * g.y); w.y = pk2(v[j].z * r2 * g.z, v[j].w * r2 * g.w); o[64 * j] = w; }
}

struct FStoreBf16 { bf16* O; int ld;
    __device__ __forceinline__ void operator()(int row, int col, f32x4 v0, f32x4 v1, int) const {
        v4u w; w.x = pg8::cvt_pk_bf16(v0[0], v0[1]); w.y = pg8::cvt_pk_bf16(v0[2], v0[3]); w.z = pg8::cvt_pk_bf16(v1[0], v1[1]); w.w = pg8::cvt_pk_bf16(v1[2], v1[3]);
        __builtin_nontemporal_store(w, (v4u*)(O + (size_t)row * ld + col)); } };
struct FStoreF32Split { float* O; int ld; float* slab; int row0; size_t slab_stride; bf16* Ob;
    __device__ __forceinline__ void operator()(int row, int col, f32x4 v0, f32x4 v1, int part) const {
        if (row < row0) { v4u w; w.x = pg8::cvt_pk_bf16(v0[0], v0[1]); w.y = pg8::cvt_pk_bf16(v0[2], v0[3]); w.z = pg8::cvt_pk_bf16(v1[0], v1[1]); w.w = pg8::cvt_pk_bf16(v1[2], v1[3]); *(v4u*)(Ob + (size_t)row * ld + col) = w; return; }
        float* p = part == 0 ? O + (size_t)row * ld + col : slab + (size_t)(part - 1) * slab_stride + (size_t)(row - row0) * ld + col; *(f32x4*)p = v0; *(f32x4*)(p + 4) = v1; } };
struct FStoreF32 { float* O; int ld;
    __device__ __forceinline__ void operator()(int row, int col, f32x4 v0, f32x4 v1, int) const { float* p = O + (size_t)row * ld + col; *(f32x4*)p = v0; *(f32x4*)(p + 4) = v1; } };
struct FBrA { const bf16* proj; float* tmp;
    __device__ __forceinline__ void operator()(int row, int col, f32x4 v0, f32x4 v1, int) const {
        const v4u g = *(const v4u*)(proj + (size_t)row * NPROJ + CGA + col);
        f32x4 s0 = {sigmoidf_(bflo(g.x)), sigmoidf_(bfhi(g.x)), sigmoidf_(bflo(g.y)), sigmoidf_(bfhi(g.y))}, s1 = {sigmoidf_(bflo(g.z)), sigmoidf_(bfhi(g.z)), sigmoidf_(bflo(g.w)), sigmoidf_(bfhi(g.w))};
        float* p = tmp + (size_t)row * D + col; *(f32x4*)p = s0 * v0; *(f32x4*)(p + 4) = s1 * v1; } };
struct FBrB { const bf16* proj; const float* tmp; bf16* mixed;
    __device__ __forceinline__ void operator()(int row, int col, f32x4 v0, f32x4 v1, int) const {
        const v4u g = *(const v4u*)(proj + (size_t)row * NPROJ + CGB + col);
        f32x4 s0 = {sigmoidf_(bflo(g.x)), sigmoidf_(bfhi(g.x)), sigmoidf_(bflo(g.y)), sigmoidf_(bfhi(g.y))}, s1 = {sigmoidf_(bflo(g.z)), sigmoidf_(bfhi(g.z)), sigmoidf_(bflo(g.w)), sigmoidf_(bfhi(g.w))};
        const float* p = tmp + (size_t)row * D + col; const f32x4 a0 = *(const f32x4*)p + s0 * v0, a1 = *(const f32x4*)(p + 4) + s1 * v1;
        v4u w; w.x = pg8::cvt_pk_bf16(a0[0], a0[1]); w.y = pg8::cvt_pk_bf16(a0[2], a0[3]); w.z = pg8::cvt_pk_bf16(a1[0], a1[1]); w.w = pg8::cvt_pk_bf16(a1[2], a1[3]);
        *(v4u*)(mixed + (size_t)row * D + col) = w; } };
struct FPeg { float* y; const bf16* pp;
    __device__ __forceinline__ void operator()(int row, int col, f32x4 v0, f32x4 v1, int) const {
        const v4u g = *(const v4u*)(pp + (size_t)row * D + col); float* p = y + (size_t)row * D + col;
        const f32x4 p0 = {bflo(g.x), bfhi(g.x), bflo(g.y), bfhi(g.y)}, p1 = {bflo(g.z), bfhi(g.z), bflo(g.w), bfhi(g.w)};
        f32x4 s0 = {sigmoidf_(v0[0]), sigmoidf_(v0[1]), sigmoidf_(v0[2]), sigmoidf_(v0[3])}, s1 = {sigmoidf_(v1[0]), sigmoidf_(v1[1]), sigmoidf_(v1[2]), sigmoidf_(v1[3])};
        *(f32x4*)p = *(const f32x4*)p + s0 * p0; *(f32x4*)(p + 4) = *(const f32x4*)(p + 4) + s1 * p1; } };

template <class F> __device__ __forceinline__ void run_gemm(Frame& F_, const bf16* A, const bf16* Bt, int M, int N, int K, const F& f) {
    pg8::Gemm g{A, Bt, M, N, K, nullptr, nullptr}; pg8::StaticOrder S; S.init(M, N, K, F_.G, (int)blockIdx.x);
    pg8::EpiRow8<F> E{f};
    pg8::gemm_phase<pg8::EpiRow8<F>, pg8::StaticOrder, PG8_ALIGN, PG8_SP2>(F_.lds, g, S, E);
}

struct FBranch { const bf16* proj; bf16* mixed;
    __device__ __forceinline__ void mid(int row, int col, f32x4& v0, f32x4& v1) const {
        const v4u ga = *(const v4u*)(proj + (size_t)row * NPROJ + CGA + col), gb = *(const v4u*)(proj + (size_t)row * NPROJ + CGB + col);
        const float a[8] = {bflo(ga.x), bfhi(ga.x), bflo(ga.y), bfhi(ga.y), bflo(ga.z), bfhi(ga.z), bflo(ga.w), bfhi(ga.w)}, b[8] = {bflo(gb.x), bfhi(gb.x), bflo(gb.y), bfhi(gb.y), bflo(gb.z), bfhi(gb.z), bflo(gb.w), bfhi(gb.w)};
#pragma unroll
        for (int e = 0; e < 4; ++e) { v0[e] *= (1.0f + __expf(-b[e])) * __builtin_amdgcn_rcpf(1.0f + __expf(-a[e])); v1[e] *= (1.0f + __expf(-b[4 + e])) * __builtin_amdgcn_rcpf(1.0f + __expf(-a[4 + e])); } }
    __device__ __forceinline__ void operator()(int row, int col, f32x4 v0, f32x4 v1, int) const {
        const v4u g = *(const v4u*)(proj + (size_t)row * NPROJ + CGB + col);
        const f32x4 s0 = {sigmoidf_(bflo(g.x)), sigmoidf_(bfhi(g.x)), sigmoidf_(bflo(g.y)), sigmoidf_(bfhi(g.y))}, s1 = {sigmoidf_(bflo(g.z)), sigmoidf_(bfhi(g.z)), sigmoidf_(bflo(g.w)), sigmoidf_(bfhi(g.w))};
        const f32x4 a0 = s0 * v0, a1 = s1 * v1;
        v4u w; w.x = pg8::cvt_pk_bf16(a0[0], a0[1]); w.y = pg8::cvt_pk_bf16(a0[2], a0[3]); w.z = pg8::cvt_pk_bf16(a1[0], a1[1]); w.w = pg8::cvt_pk_bf16(a1[2], a1[3]);
        *(v4u*)(mixed + (size_t)row * D + col) = w; } };
template <class F> __device__ __forceinline__ void run_gemm_chain(Frame& F_, const bf16* A, const bf16* Bt, const bf16* A2, const bf16* Bt2, int M, int N, int K, const F& f) {
    pg8::Gemm g{A, Bt, M, N, K, A2, Bt2}; pg8::ChainOrder S; S.init(M, N, K, F_.G, (int)blockIdx.x);
    pg8::EpiRow8Chain<F> E{f};
    pg8::gemm_phase<pg8::EpiRow8Chain<F>, pg8::ChainOrder, PG8_ALIGN, PG8_SP2>(F_.lds, g, S, E);
}
template <class F> __device__ __forceinline__ void run_gemm_lim(Frame& F_, const bf16* A, const bf16* Bt, int M, int N, int K, const F& f, int lim) {
    pg8::Gemm g{A, Bt, M, N, K, nullptr, nullptr}; pg8::StaticOrder S; S.init(M, N, K, F_.G, (int)blockIdx.x); S.lim = lim;
    pg8::EpiRow8<F> E{f};
    pg8::gemm_phase<pg8::EpiRow8<F>, pg8::StaticOrder, PG8_ALIGN, PG8_SP2>(F_.lds, g, S, E);
}
template <class F> __device__ __forceinline__ void run_gemm_gc(Frame& F_, const bf16* A, const bf16* Bt, int M, int N, int K, const F& f, int G, int c) {
    pg8::Gemm g{A, Bt, M, N, K, nullptr, nullptr}; pg8::StaticOrder S; S.init(M, N, K, G, c);
    pg8::EpiRow8<F> E{f};
    pg8::gemm_phase<pg8::EpiRow8<F>, pg8::StaticOrder, PG8_ALIGN, PG8_SP2>(F_.lds, g, S, E);
}
template <class F> __device__ __forceinline__ void run_gemm_split(Frame& F_, const bf16* A, const bf16* Bt, int M, int N, int K, const F& f) {
    pg8::Gemm g{A, Bt, M, N, K, nullptr, nullptr}; pg8::SplitOrder S; S.init(M, N, K, F_.G, (int)blockIdx.x);
    pg8::EpiRow8<F> E{f};
    pg8::gemm_phase<pg8::EpiRow8<F>, pg8::SplitOrder, PG8_ALIGN, PG8_SP2>(F_.lds, g, S, E);
}

typedef float f32x2 __attribute__((ext_vector_type(2)));
__device__ __forceinline__ float dpp_f(float x, int ctrl_sel) {
    const int v = __builtin_bit_cast(int, x); int r;
    if (ctrl_sel == 0) r = __builtin_amdgcn_update_dpp(v, v, 0xB1, 0xF, 0xF, false);
    else if (ctrl_sel == 1) r = __builtin_amdgcn_update_dpp(v, v, 0x4E, 0xF, 0xF, false);
    else r = __builtin_amdgcn_update_dpp(v, v, 0x141, 0xF, 0xF, false);
    return __builtin_bit_cast(float, r);
}
__device__ __forceinline__ float sum8(float x) {
    float a, b, c;
    asm volatile("s_nop 1\n\tv_add_f32_dpp %0, %1, %1 quad_perm:[1,0,3,2] row_mask:0xf bank_mask:0xf" : "=v"(a) : "v"(x));
    asm volatile("s_nop 1\n\tv_add_f32_dpp %0, %1, %1 quad_perm:[2,3,0,1] row_mask:0xf bank_mask:0xf" : "=v"(b) : "v"(a));
    asm volatile("s_nop 1\n\tv_add_f32_dpp %0, %1, %1 row_half_mirror row_mask:0xf bank_mask:0xf" : "=v"(c) : "v"(b));
    return c;
}
template <int HEADS>
__device__ __forceinline__ void rwkv_unit(Frame& F, const unsigned char* scan, int m0, int L, int h, const float* S0, float* Sout, float* OB) {
    constexpr int TB = 16, RB = SCAN_LREC, RG = SCAN_REC, PCS = RG / 16, NPC = (TB * PCS + 511) / 512;
    LAS unsigned char* buf = F.lds;
    const int tid = F.tid, v = tid >> 3, j = tid & 7;
    f32x2 S[4];
    if (S0) { const f32x4 a = *(const f32x4*)(S0 + v * 64 + 8 * j), b = *(const f32x4*)(S0 + v * 64 + 8 * j + 4); S[0] = (f32x2){a.x, a.y}; S[1] = (f32x2){a.z, a.w}; S[2] = (f32x2){b.x, b.y}; S[3] = (f32x2){b.z, b.w}; }
    else {
#pragma unroll
        for (int i = 0; i < 4; ++i) S[i] = (f32x2){0.f, 0.f}; }
    const int nst = L < TB ? L : TB, nblk = HEADS ? HEADS : L / nst, nch = nst * PCS;
    constexpr int DUMMY = 2 * TB * RB;
    int goff[NPC], lo0[NPC], lo1[NPC]; bool cv[NPC];
#pragma unroll
    for (int i = 0; i < NPC; ++i) { const int c = tid + 512 * i; const bool valid = c < nch; const int cc = valid ? c : 0, st = cc / PCS, p = cc - st * PCS; goff[i] = st * 32 * RG + p * 16;
        const int lo = st * RB + (p < 16 ? p * 16 : (p < 48 ? 256 + (p - 16) * 32 : 1280 + (p - 48) * 16)); cv[i] = p >= 16 && p < 48;
        lo0[i] = valid ? lo : -1; lo1[i] = (valid && cv[i]) ? lo + 16 : -1; }
    const unsigned char* gsrc = scan + ((size_t)m0 * 32 + h) * RG;
    const size_t bstep = HEADS ? (size_t)RG : (size_t)nst * 32 * RG;
#define RW_PUT(bo_, i_) do { const v4u x_ = pre[i_]; const f32x4 c0_ = {bflo(x_.x), bfhi(x_.x), bflo(x_.y), bfhi(x_.y)}, c1_ = {bflo(x_.z), bfhi(x_.z), bflo(x_.w), bfhi(x_.w)}; \
        *(LAS v4u*)(buf + (lo0[i_] >= 0 ? (bo_) + lo0[i_] : DUMMY)) = cv[i_] ? __builtin_bit_cast(v4u, c0_) : x_; *(LAS f32x4*)(buf + (lo1[i_] >= 0 ? (bo_) + lo1[i_] : DUMMY + 16)) = c1_; } while (0)
    LAS float* obuf = (LAS float*)(buf + DUMMY + 64); float* obg = OB + (size_t)m0 * 2048 + h * 64;
    v4u pre[NPC], prf[NPC];
    __syncthreads();
#pragma unroll
    for (int i = 0; i < NPC; ++i) pre[i] = *(const v4u*)(gsrc + goff[i]);
#pragma unroll
    for (int i = 0; i < NPC; ++i) RW_PUT(0, i);
    { const unsigned char* g1 = gsrc + (nblk > 1 ? bstep : 0);
#pragma unroll
      for (int i = 0; i < NPC; ++i) prf[i] = *(const v4u*)(g1 + goff[i]); }
    WG_BAR();
#define RW_LD(dst, rec_) do { const LAS unsigned char* r_ = (rec_); dst[0] = *(const LAS f32x4*)(r_); dst[1] = *(const LAS f32x4*)(r_ + 16); dst[2] = *(const LAS f32x4*)(r_ + 256); dst[3] = *(const LAS f32x4*)(r_ + 272); \
            dst[4] = *(const LAS f32x4*)(r_ + 512); dst[5] = *(const LAS f32x4*)(r_ + 528); dst[6] = *(const LAS f32x4*)(r_ + 768); dst[7] = *(const LAS f32x4*)(r_ + 784); dst[8] = *(const LAS f32x4*)(r_ + 1024); dst[9] = *(const LAS f32x4*)(r_ + 1040); } while (0)
    auto do_block = [&](int blk, v4u (&ld)[NPC], v4u (&use)[NPC]) {
        { const int b2 = blk + 2 < nblk ? blk + 2 : nblk - 1; const unsigned char* g2 = gsrc + (size_t)b2 * bstep;
#pragma unroll
          for (int i = 0; i < NPC; ++i) ld[i] = *(const v4u*)(g2 + goff[i]); }
        f32x4 na = {0.f, 0.f, 0.f, 0.f}, nb = na;
        if (HEADS) { const float* sn = S0 + (size_t)(blk + 1 < nblk ? blk + 1 : blk) * 4096 + v * 64 + 8 * j; na = *(const f32x4*)sn; nb = *(const f32x4*)(sn + 4); }
        const LAS unsigned char* cb = buf + (blk & 1) * (TB * RB) + 32 * j;
        f32x4 X[10], Y[10]; unsigned xv, yv;
        RW_LD(X, cb); xv = *(const LAS bf16*)(cb - 32 * j + 1280 + 2 * v);
#pragma unroll 2
        for (int s = 0; s < nst; ++s) {
            const LAS unsigned char* rn = cb + (s + 1 < nst ? s + 1 : s) * RB;
            yv = *(const LAS bf16*)(rn - 32 * j + 1280 + 2 * v); RW_LD(Y, rn);
            const float vv = bf2f(xv);
            const f32x2 W[4] = {{X[0].x, X[0].y}, {X[0].z, X[0].w}, {X[1].x, X[1].y}, {X[1].z, X[1].w}}, R[4] = {{X[2].x, X[2].y}, {X[2].z, X[2].w}, {X[3].x, X[3].y}, {X[3].z, X[3].w}}, K[4] = {{X[4].x, X[4].y}, {X[4].z, X[4].w}, {X[5].x, X[5].y}, {X[5].z, X[5].w}},
                        N[4] = {{X[6].x, X[6].y}, {X[6].z, X[6].w}, {X[7].x, X[7].y}, {X[7].z, X[7].w}}, A[4] = {{X[8].x, X[8].y}, {X[8].z, X[8].w}, {X[9].x, X[9].y}, {X[9].z, X[9].w}};
            f32x2 p = (S[0] * N[0] + S[1] * N[1]) + (S[2] * N[2] + S[3] * N[3]);
            const float sa = sum8(p.x + p.y);
            const f32x2 sa2 = {sa, sa}, vv2 = {vv, vv};
#pragma unroll
            for (int i = 0; i < 4; ++i) S[i] = S[i] * W[i] + sa2 * A[i] + vv2 * K[i];
            f32x2 q = (S[0] * R[0] + S[1] * R[1]) + (S[2] * R[2] + S[3] * R[3]);
            const float o = sum8(q.x + q.y);
            obuf[(blk & 1) * (TB * 64) + s * 64 + v] = o;
#pragma unroll
            for (int i = 0; i < 10; ++i) X[i] = Y[i];
            xv = yv;
        }
        if (HEADS) { float* so = Sout + (size_t)blk * 4096 + v * 64 + 8 * j; *(f32x4*)so = (f32x4){S[0].x, S[0].y, S[1].x, S[1].y}; *(f32x4*)(so + 4) = (f32x4){S[2].x, S[2].y, S[3].x, S[3].y};
            S[0] = (f32x2){na.x, na.y}; S[1] = (f32x2){na.z, na.w}; S[2] = (f32x2){nb.x, nb.y}; S[3] = (f32x2){nb.z, nb.w}; }
        { const int nbo = ((blk + 1) & 1) * (TB * RB);
#pragma unroll
          for (int i = 0; i < NPC; ++i) asm volatile("" : "+v"(use[i]));
#pragma unroll
          for (int i = 0; i < NPC; ++i) { pre[i] = use[i]; RW_PUT(nbo, i); } }
        WG_BAR();
        if (tid < nst * 16) { const int s = tid >> 4, c4 = (tid & 15) * 4; *(f32x4*)(obg + (HEADS ? (size_t)s * 2048 + blk * 64 : (size_t)(blk * nst + s) * 2048) + c4) = *(const LAS f32x4*)(obuf + (blk & 1) * (TB * 64) + s * 64 + c4); }
    };
    v4u prg[NPC];
    for (int blk = 0; blk < nblk; blk += 2) {
        do_block(blk, prg, prf);
        if (blk + 1 < nblk) do_block(blk + 1, prf, prg);
    }
#undef RW_LD
    if (!HEADS) { f32x4 a = {S[0].x, S[0].y, S[1].x, S[1].y}, b = {S[2].x, S[2].y, S[3].x, S[3].y};
        *(f32x4*)(Sout + v * 64 + 8 * j) = a; *(f32x4*)(Sout + v * 64 + 8 * j + 4) = b; }
#undef RW_PUT
}

typedef short bf16x8v __attribute__((ext_vector_type(8)));
constexpr int RW_C = 16, RW_NCH = SEQ / RW_C, RW_A1 = 7168, RW_A2 = 6656, RW_LSTR = 72;
struct RwRec { float wv[16]; unsigned rr[16], kx[16], nn[16], aa[16], vx[16]; };
template <int T0, int T1>
__device__ __forceinline__ void rw_prep_load(RwRec& R, int lane, const unsigned char* scan, int m_base, int h) {
    const int key = lane; const unsigned char* rec0 = scan + ((size_t)m_base * 32 + h) * SCAN_REC;
    float (&wv)[16] = R.wv; unsigned (&rr)[16] = R.rr, (&kx)[16] = R.kx, (&nn)[16] = R.nn, (&aa)[16] = R.aa, (&vx)[16] = R.vx;
#pragma unroll
    for (int t = T0; t < T1; ++t) { const unsigned char* rec = rec0 + (size_t)t * 32 * SCAN_REC; wv[t] = *(const float*)(rec + 4 * key); rr[t] = *(const bf16*)(rec + 256 + 2 * key); kx[t] = *(const bf16*)(rec + 384 + 2 * key);
        nn[t] = *(const bf16*)(rec + 512 + 2 * key); aa[t] = *(const bf16*)(rec + 640 + 2 * key); vx[t] = *(const bf16*)(rec + 768 + 2 * key); }
}
__device__ __forceinline__ void rw_prep_a(const RwRec& R, LAS unsigned char* wl, int lane, unsigned char* a2) {
    LAS bf16* rowA = (LAS bf16*)wl; LAS bf16* rowR = rowA + 16 * RW_LSTR; LAS bf16* rowB = rowR + 16 * RW_LSTR; LAS bf16* rowK = rowB + 16 * RW_LSTR; LAS float* Ns = (LAS float*)(wl + 9216);
    const int key = lane, r16 = lane & 15, q = lane >> 4;
    (void)Ns; (void)r16; (void)q;
    const float (&wv)[16] = R.wv; const unsigned (&rr)[16] = R.rr, (&kx)[16] = R.kx, (&nn)[16] = R.nn, (&aa)[16] = R.aa, (&vx)[16] = R.vx;
    float cum[16]; float run = 0.f;
#pragma unroll
    for (int t = 0; t < 16; ++t) { const float cprev = run; run += __builtin_amdgcn_logf(wv[t]); cum[t] = run;
        const float g = __builtin_amdgcn_exp2f(run), gi = __builtin_amdgcn_exp2f(-run), gp = __builtin_amdgcn_exp2f(cprev);
        const unsigned ar = pk2(bf2f(nn[t]) * gp, bf2f(rr[t]) * g), bk = pk2(bf2f(aa[t]) * gi, bf2f(kx[t]) * gi);
        rowA[t * RW_LSTR + key] = (bf16)ar; rowR[t * RW_LSTR + key] = (bf16)(ar >> 16); rowB[t * RW_LSTR + key] = (bf16)bk; rowK[t * RW_LSTR + key] = (bf16)(bk >> 16); }
    {
        unsigned bgp[8], kgp[8], vp[8];
#pragma unroll
        for (int j = 0; j < 8; ++j) { const float e0 = __builtin_amdgcn_exp2f(run - cum[2 * j]), e1 = __builtin_amdgcn_exp2f(run - cum[2 * j + 1]);
            bgp[j] = pk2(bf2f(aa[2 * j]) * e0, bf2f(aa[2 * j + 1]) * e1); kgp[j] = pk2(bf2f(kx[2 * j]) * e0, bf2f(kx[2 * j + 1]) * e1); vp[j] = vx[2 * j] | (vx[2 * j + 1] << 16); }
        unsigned char* sb = a2 + (key >> 4) * 1024 + (key & 15) * 16;
#pragma unroll
        for (int kq = 0; kq < 4; ++kq) { v4u o; o.x = bgp[2 * kq]; o.y = bgp[2 * kq + 1]; o.z = kgp[2 * kq]; o.w = kgp[2 * kq + 1]; *(v4u*)(sb + kq * 256) = o; }
        *(float*)(a2 + 4096 + 4 * key) = __builtin_amdgcn_exp2f(run);
        v4u o0, o1; o0.x = vp[0]; o0.y = vp[1]; o0.z = vp[2]; o0.w = vp[3]; o1.x = vp[4]; o1.y = vp[5]; o1.z = vp[6]; o1.w = vp[7];
        *(v4u*)(a2 + 4352 + key * 32) = o0; *(v4u*)(a2 + 4352 + key * 32 + 16) = o1; }
}
__device__ __forceinline__ void rw_prep_b(LAS unsigned char* wl, int lane, unsigned char* a1) {
    LAS bf16* rowA = (LAS bf16*)wl; LAS bf16* rowR = rowA + 16 * RW_LSTR; LAS bf16* rowB = rowR + 16 * RW_LSTR; LAS bf16* rowK = rowB + 16 * RW_LSTR; LAS float* Ns = (LAS float*)(wl + 9216);
    const int key = lane, r16 = lane & 15, q = lane >> 4;
    (void)key;
    LDS_WAIT(); asm volatile("" ::: "memory");
    f32x4 nab = {0.f, 0.f, 0.f, 0.f}, mbr = nab, nak = nab, mkr = nab;
#pragma unroll
    for (int m = 0; m < 2; ++m) { const int o = r16 * RW_LSTR + 32 * m + 8 * q;
        const bf16x8v fb = *(const LAS bf16x8v*)(rowB + o), fk = *(const LAS bf16x8v*)(rowK + o), fa = *(const LAS bf16x8v*)(rowA + o), fr = *(const LAS bf16x8v*)(rowR + o);
        nab = __builtin_amdgcn_mfma_f32_16x16x32_bf16(fb, fa, nab, 0, 0, 0); mbr = __builtin_amdgcn_mfma_f32_16x16x32_bf16(fb, fr, mbr, 0, 0, 0);
        nak = __builtin_amdgcn_mfma_f32_16x16x32_bf16(fk, fa, nak, 0, 0, 0); mkr = __builtin_amdgcn_mfma_f32_16x16x32_bf16(fk, fr, mkr, 0, 0, 0); }
    {   const int t = r16, s0 = 4 * q; v4u fn, fm;
        fn.x = 0u; fn.y = 0u; fn.z = pk2(s0 < t ? nak[0] : 0.f, s0 + 1 < t ? nak[1] : 0.f); fn.w = pk2(s0 + 2 < t ? nak[2] : 0.f, s0 + 3 < t ? nak[3] : 0.f);
        fm.x = pk2(s0 <= t ? mbr[0] : 0.f, s0 + 1 <= t ? mbr[1] : 0.f); fm.y = pk2(s0 + 2 <= t ? mbr[2] : 0.f, s0 + 3 <= t ? mbr[3] : 0.f);
        fm.z = pk2(s0 <= t ? mkr[0] : 0.f, s0 + 1 <= t ? mkr[1] : 0.f); fm.w = pk2(s0 + 2 <= t ? mkr[2] : 0.f, s0 + 3 <= t ? mkr[3] : 0.f);
        *(v4u*)(a1 + 4096 + lane * 16) = fn; *(v4u*)(a1 + 6144 + lane * 16) = fm;
#pragma unroll
        for (int i = 0; i < 4; ++i) Ns[(s0 + i) * 16 + t] = (s0 + i < t) ? nab[i] : 0.f; }
#pragma unroll
    for (int m = 0; m < 2; ++m) { const int o = r16 * RW_LSTR + 32 * m + 4 * q;
        const v2u alo = *(const LAS v2u*)(rowA + o), ahi = *(const LAS v2u*)(rowA + o + 16), rlo = *(const LAS v2u*)(rowR + o), rhi = *(const LAS v2u*)(rowR + o + 16);
        v4u fa, fr; fa.x = alo.x; fa.y = alo.y; fa.z = ahi.x; fa.w = ahi.y; fr.x = rlo.x; fr.y = rlo.y; fr.z = rhi.x; fr.w = rhi.y;
        *(v4u*)(a1 + m * 1024 + lane * 16) = fa; *(v4u*)(a1 + 2048 + m * 1024 + lane * 16) = fr; }
    LDS_WAIT(); asm volatile("" ::: "memory");
    float x[16];
#pragma unroll
    for (int s_ = 15; s_ >= 0; --s_) { float acc = (s_ == r16) ? 1.f : 0.f;
        const f32x4 n0 = *(const LAS f32x4*)(Ns + s_ * 16), n1 = *(const LAS f32x4*)(Ns + s_ * 16 + 4), n2 = *(const LAS f32x4*)(Ns + s_ * 16 + 8), n3 = *(const LAS f32x4*)(Ns + s_ * 16 + 12);
        const float nr[16] = {n0.x, n0.y, n0.z, n0.w, n1.x, n1.y, n1.z, n1.w, n2.x, n2.y, n2.z, n2.w, n3.x, n3.y, n3.z, n3.w};
#pragma unroll
        for (int sp = s_ + 1; sp < 16; ++sp) acc += nr[sp] * x[sp];
        x[s_] = acc; }
    {   const float x0 = q == 0 ? x[0] : q == 1 ? x[4] : q == 2 ? x[8] : x[12], x1 = q == 0 ? x[1] : q == 1 ? x[5] : q == 2 ? x[9] : x[13];
        const float x2 = q == 0 ? x[2] : q == 1 ? x[6] : q == 2 ? x[10] : x[14], x3 = q == 0 ? x[3] : q == 1 ? x[7] : q == 2 ? x[11] : x[15];
        v4u fx; fx.x = pk2(x0, x1); fx.y = pk2(x2, x3); fx.z = 0u; fx.w = 0u; *(v4u*)(a1 + 5120 + lane * 16) = fx; }
    LDS_WAIT(); asm volatile("" ::: "memory");
}
struct RwSet { v4u fa0, fa1, fr0, fr1, fn, fx, fm, fs0, fs1, fs2, fs3; f32x4 g0, g1, g2, g3; v2u vt; };
__device__ __forceinline__ void rw_load(RwSet& S, const unsigned char* arr1, const unsigned char* arr2, size_t uc, int lane, int ws) {
    const unsigned char* p1 = arr1 + uc * RW_A1 + lane * 16; const unsigned char* p2 = arr2 + uc * RW_A2; const int r16 = lane & 15, q = lane >> 4;
    S.fa0 = *(const v4u*)p1; S.fa1 = *(const v4u*)(p1 + 1024); S.fr0 = *(const v4u*)(p1 + 2048); S.fr1 = *(const v4u*)(p1 + 3072); S.fn = *(const v4u*)(p1 + 4096); S.fx = *(const v4u*)(p1 + 5120); S.fm = *(const v4u*)(p1 + 6144);
    S.fs0 = *(const v4u*)(p2 + lane * 16); S.fs1 = *(const v4u*)(p2 + 1024 + lane * 16); S.fs2 = *(const v4u*)(p2 + 2048 + lane * 16); S.fs3 = *(const v4u*)(p2 + 3072 + lane * 16);
    const unsigned char* gp = p2 + 4096 + 16 * q; S.g0 = *(const f32x4*)gp; S.g1 = *(const f32x4*)(gp + 64); S.g2 = *(const f32x4*)(gp + 128); S.g3 = *(const f32x4*)(gp + 192);
    S.vt = *(const v2u*)(p2 + 4352 + (16 * ws + r16) * 32 + 8 * q);
}
__device__ __forceinline__ bf16x8v rw_bc(unsigned a, unsigned b, unsigned c, unsigned d) { v4u t; t.x = a; t.y = b; t.z = c; t.w = d; return __builtin_bit_cast(bf16x8v, t); }
typedef __bf16 rw_bf2 __attribute__((ext_vector_type(2)));
__device__ __forceinline__ unsigned cvt_pk_bf16(float lo, float hi) { const pg8::f32x2 v = {lo, hi}; return __builtin_bit_cast(unsigned, __builtin_convertvector(v, rw_bf2)); }
__device__ __forceinline__ void rw_step(const RwSet& S, f32x4 (&H)[4], float* ob) {
    const bf16x8v hb0 = rw_bc(cvt_pk_bf16(H[0][0], H[0][1]), cvt_pk_bf16(H[0][2], H[0][3]), cvt_pk_bf16(H[1][0], H[1][1]), cvt_pk_bf16(H[1][2], H[1][3]));
    const bf16x8v hb1 = rw_bc(cvt_pk_bf16(H[2][0], H[2][1]), cvt_pk_bf16(H[2][2], H[2][3]), cvt_pk_bf16(H[3][0], H[3][1]), cvt_pk_bf16(H[3][2], H[3][3]));
    const f32x4 z = {0.f, 0.f, 0.f, 0.f};
    f32x4 Y = __builtin_amdgcn_mfma_f32_16x16x32_bf16(__builtin_bit_cast(bf16x8v, S.fa0), hb0, z, 0, 0, 0);
    Y = __builtin_amdgcn_mfma_f32_16x16x32_bf16(__builtin_bit_cast(bf16x8v, S.fa1), hb1, Y, 0, 0, 0);
    Y = __builtin_amdgcn_mfma_f32_16x16x32_bf16(__builtin_bit_cast(bf16x8v, S.fn), rw_bc(0u, 0u, S.vt.x, S.vt.y), Y, 0, 0, 0);
    const f32x4 U = __builtin_amdgcn_mfma_f32_16x16x32_bf16(__builtin_bit_cast(bf16x8v, S.fx), rw_bc(cvt_pk_bf16(Y[0], Y[1]), cvt_pk_bf16(Y[2], Y[3]), 0u, 0u), z, 0, 0, 0);
    const bf16x8v ub = rw_bc(cvt_pk_bf16(U[0], U[1]), cvt_pk_bf16(U[2], U[3]), S.vt.x, S.vt.y);
    f32x4 O = __builtin_amdgcn_mfma_f32_16x16x32_bf16(__builtin_bit_cast(bf16x8v, S.fr0), hb0, z, 0, 0, 0);
    O = __builtin_amdgcn_mfma_f32_16x16x32_bf16(__builtin_bit_cast(bf16x8v, S.fr1), hb1, O, 0, 0, 0);
    O = __builtin_amdgcn_mfma_f32_16x16x32_bf16(__builtin_bit_cast(bf16x8v, S.fm), ub, O, 0, 0, 0);
    H[0] = __builtin_amdgcn_mfma_f32_16x16x32_bf16(__builtin_bit_cast(bf16x8v, S.fs0), ub, H[0] * S.g0, 0, 0, 0);
    H[1] = __builtin_amdgcn_mfma_f32_16x16x32_bf16(__builtin_bit_cast(bf16x8v, S.fs1), ub, H[1] * S.g1, 0, 0, 0);
    H[2] = __builtin_amdgcn_mfma_f32_16x16x32_bf16(__builtin_bit_cast(bf16x8v, S.fs2), ub, H[2] * S.g2, 0, 0, 0);
    H[3] = __builtin_amdgcn_mfma_f32_16x16x32_bf16(__builtin_bit_cast(bf16x8v, S.fs3), ub, H[3] * S.g3, 0, 0, 0);
    ob[0] = O[0]; ob[2048] = O[1]; ob[4096] = O[2]; ob[6144] = O[3];
}
__device__ __forceinline__ void rwkv_chunk_scan(int lane, int ws, const unsigned char* arr1, const unsigned char* arr2, int bh, float* Sout, float* OB) {
    const int r16 = lane & 15, q = lane >> 4, b = bh >> 5, h = bh & 31;
    f32x4 H[4];
#pragma unroll
    for (int i = 0; i < 4; ++i) H[i] = (f32x4){0.f, 0.f, 0.f, 0.f};
    const size_t uc0 = (size_t)bh * RW_NCH;
    float* ob = OB + (size_t)(b * SEQ + 4 * q) * 2048 + h * 64 + 16 * ws + r16;
    RwSet A, B, C; rw_load(A, arr1, arr2, uc0, lane, ws); rw_load(B, arr1, arr2, uc0 + 1, lane, ws);
    static_assert(RW_NCH % 3 == 2, "loop below: groups of three chunks, then two");
    for (int c = 0; c < RW_NCH - 2; c += 3) {
        rw_load(C, arr1, arr2, uc0 + c + 2, lane, ws);
        rw_step(A, H, ob + (size_t)c * 16 * 2048);
        rw_load(A, arr1, arr2, uc0 + c + 3, lane, ws);
        rw_step(B, H, ob + (size_t)(c + 1) * 16 * 2048);
        rw_load(B, arr1, arr2, uc0 + c + 4, lane, ws);
        rw_step(C, H, ob + (size_t)(c + 2) * 16 * 2048);
    }
    rw_step(A, H, ob + (size_t)(RW_NCH - 2) * 16 * 2048);
    rw_step(B, H, ob + (size_t)(RW_NCH - 1) * 16 * 2048);
#pragma unroll
    for (int kt = 0; kt < 4; ++kt) *(f32x4*)(Sout + (16 * ws + r16) * 64 + 16 * kt + 4 * q) = H[kt];
}

constexpr int RWL_PAIR = 13824, RWL_SLOT = 2 * RWL_PAIR, RWL_DUM = 4 * RWL_SLOT;
__device__ __forceinline__ void rwkv_chunk_scan_lds(Frame& F, const unsigned char* arr1, const unsigned char* arr2, int bh0, float* SoutBase, float* OB) {
    const int lane = F.lane, w = F.wave, ws = w & 3, pr = w >> 2, bh = bh0 + pr, r16 = lane & 15, q = lane >> 4, b = bh >> 5, h = bh & 31;
    LAS unsigned char* L = F.lds;
    f32x4 H[4];
#pragma unroll
    for (int i = 0; i < 4; ++i) H[i] = (f32x4){0.f, 0.f, 0.f, 0.f};
    const size_t uc0 = (size_t)bh * RW_NCH;
    float* ob = OB + (size_t)(b * SEQ + 4 * q) * 2048 + h * 64 + 16 * ws + r16;
    const unsigned char* gsrc[4]; int ldst[4];
#pragma unroll
    for (int i = 0; i < 4; ++i) { const int p = ws + 4 * i;
        if (p < 7) { gsrc[i] = arr1 + uc0 * RW_A1 + p * 1024 + lane * 16; ldst[i] = pr * RWL_PAIR + p * 1024; }
        else if (p < 11) { gsrc[i] = arr2 + uc0 * RW_A2 + (p - 7) * 1024 + lane * 16; ldst[i] = pr * RWL_PAIR + p * 1024; }
        else if (p < 13) { gsrc[i] = arr2 + uc0 * RW_A2 + 4352 + (p - 11) * 1024 + lane * 16; ldst[i] = pr * RWL_PAIR + 11520 + (p - 11) * 1024; }
        else if (p == 13) { gsrc[i] = arr2 + uc0 * RW_A2 + 4096 + lane * 4; ldst[i] = pr * RWL_PAIR + 11264; }
        else { gsrc[i] = arr1 + uc0 * RW_A1 + lane * 16; ldst[i] = RWL_DUM; } }
    const bool gc4 = ws == 1;
#define RWL_ISSUE(cc) do { const int c_ = (cc) < RW_NCH ? (cc) : RW_NCH - 1; const int so_ = ((cc) & 3) * RWL_SLOT; \
        _Pragma("unroll") for (int i = 0; i < 3; ++i) { const size_t st_ = (size_t)c_ * ((ws + 4 * i) < 7 ? RW_A1 : RW_A2); \
            __builtin_amdgcn_global_load_lds((const unsigned*)(gsrc[i] + st_), (LAS unsigned*)(L + (ldst[i] == RWL_DUM ? RWL_DUM : so_ + ldst[i])), 16, 0, 0); } \
        { const size_t st_ = (size_t)c_ * ((ws + 12) < 14 ? RW_A2 : RW_A1); \
          if (gc4) __builtin_amdgcn_global_load_lds((const unsigned*)(gsrc[3] + st_), (LAS unsigned*)(L + so_ + ldst[3]), 4, 0, 0); \
          else __builtin_amdgcn_global_load_lds((const unsigned*)(gsrc[3] + st_), (LAS unsigned*)(L + (ldst[3] == RWL_DUM ? RWL_DUM : so_ + ldst[3])), 16, 0, 0); } } while (0)
    __syncthreads();
    RWL_ISSUE(0); RWL_ISSUE(1); RWL_ISSUE(2);
#pragma unroll 1
    for (int c = 0; c < RW_NCH; ++c) {
        if (c < 3) asm volatile("s_waitcnt vmcnt(8)" ::: "memory"); else asm volatile("s_waitcnt vmcnt(20)" ::: "memory");
        __builtin_amdgcn_s_barrier(); asm volatile("" ::: "memory");
        RWL_ISSUE(c + 3);
        const LAS unsigned char* S_ = L + (c & 3) * RWL_SLOT + pr * RWL_PAIR;
        RwSet A;
        A.fa0 = *(const LAS v4u*)(S_ + lane * 16); A.fa1 = *(const LAS v4u*)(S_ + 1024 + lane * 16); A.fr0 = *(const LAS v4u*)(S_ + 2048 + lane * 16); A.fr1 = *(const LAS v4u*)(S_ + 3072 + lane * 16);
        A.fn = *(const LAS v4u*)(S_ + 4096 + lane * 16); A.fx = *(const LAS v4u*)(S_ + 5120 + lane * 16); A.fm = *(const LAS v4u*)(S_ + 6144 + lane * 16);
        A.fs0 = *(const LAS v4u*)(S_ + 7168 + lane * 16); A.fs1 = *(const LAS v4u*)(S_ + 8192 + lane * 16); A.fs2 = *(const LAS v4u*)(S_ + 9216 + lane * 16); A.fs3 = *(const LAS v4u*)(S_ + 10240 + lane * 16);
        A.g0 = *(const LAS f32x4*)(S_ + 11264 + 16 * q); A.g1 = *(const LAS f32x4*)(S_ + 11264 + 64 + 16 * q); A.g2 = *(const LAS f32x4*)(S_ + 11264 + 128 + 16 * q); A.g3 = *(const LAS f32x4*)(S_ + 11264 + 192 + 16 * q);
        A.vt = *(const LAS v2u*)(S_ + 11520 + (16 * ws + r16) * 32 + 8 * q);
        asm volatile("s_waitcnt lgkmcnt(0)" ::: "memory");
        rw_step(A, H, ob + (size_t)c * 16 * 2048);
    }
#undef RWL_ISSUE
    asm volatile("s_waitcnt vmcnt(0)" ::: "memory"); __builtin_amdgcn_s_barrier();
    float* Sout = SoutBase + (size_t)bh * 4096;
#pragma unroll
    for (int kt = 0; kt < 4; ++kt) *(f32x4*)(Sout + (16 * ws + r16) * 64 + 16 * kt + 4 * q) = H[kt];
}

__device__ __forceinline__ bf16x8v ldfrag(const bf16* p) { return *(const bf16x8v*)p; }
__device__ __forceinline__ void gla_prep_unit(Frame& F, const bf16* proj, const bf16* L1, const float* b_alpha, bf16* QD, bf16* KDDT, bf16* VT, bf16* ATT, float* EB, int ci, int h) {
    constexpr int LS = 264, VLS = 520;
    LAS bf16* qd_s = (LAS bf16*)F.lds; LAS bf16* kd_s = qd_s + 64 * LS; LAS bf16* kdd_s = kd_s + 64 * LS; LAS float* tot = (LAS float*)(kdd_s + 64 * LS);
    LAS bf16* v_s = (LAS bf16*)F.lds;
    int tid_ = F.tid; asm volatile("" : "+v"(tid_));
    const int tid = tid_, lane = tid & 63, w = F.wave, dg = tid & 31, ts = tid >> 5, m0 = (ci >> 5) * SEQ + (ci & 31) * 64, u = ci * 4 + h;
    v4u l1v[4], qv[4], kv[4], vv[8];
#pragma unroll
    for (int i = 0; i < 4; ++i) { const size_t m = (size_t)(m0 + 4 * ts + i); l1v[i] = *(const v4u*)(L1 + m * NL1 + h * 256 + 8 * dg);
        qv[i] = *(const v4u*)(proj + m * NPROJ + CQ + h * 256 + 8 * dg); kv[i] = *(const v4u*)(proj + m * NPROJ + CK + h * 256 + 8 * dg); }
    float ba[8]; { const f32x4 b0 = *(const f32x4*)(b_alpha + h * 256 + 8 * dg), b1 = *(const f32x4*)(b_alpha + h * 256 + 8 * dg + 4); ba[0] = b0.x; ba[1] = b0.y; ba[2] = b0.z; ba[3] = b0.w; ba[4] = b1.x; ba[5] = b1.y; ba[6] = b1.z; ba[7] = b1.w; }
    __syncthreads();
    float bt[4][8];
    { float run[8];
#pragma unroll
      for (int e = 0; e < 8; ++e) run[e] = 0.f;
#pragma unroll
      for (int i = 0; i < 4; ++i) { const unsigned xw[4] = {l1v[i].x, l1v[i].y, l1v[i].z, l1v[i].w};
#pragma unroll
          for (int e = 0; e < 8; ++e) { const float x = ((e & 1) ? bfhi(xw[e >> 1]) : bflo(xw[e >> 1])) + ba[e]; run[e] += -(fmaxf(-x, 0.f) + __logf(1.0f + __expf(-fabsf(x)))) * 0.0625f; bt[i][e] = run[e]; }
          __builtin_amdgcn_sched_barrier(0); }
      *(LAS f32x4*)(tot + ts * 256 + 8 * dg) = (f32x4){run[0], run[1], run[2], run[3]}; *(LAS f32x4*)(tot + ts * 256 + 8 * dg + 4) = (f32x4){run[4], run[5], run[6], run[7]}; }
    WG_BAR();
    float off[8], be[8];
#pragma unroll
    for (int e = 0; e < 8; ++e) { off[e] = 0.f; be[e] = 0.f; }
#pragma unroll
    for (int s = 0; s < 16; ++s) { const f32x4 a = *(const LAS f32x4*)(tot + s * 256 + 8 * dg), b = *(const LAS f32x4*)(tot + s * 256 + 8 * dg + 4); const float t8[8] = {a.x, a.y, a.z, a.w, b.x, b.y, b.z, b.w}; const bool pre = s < ts;
#pragma unroll
        for (int e = 0; e < 8; ++e) { be[e] += t8[e]; off[e] += pre ? t8[e] : 0.f; } }
    if (ts == 0) { *(f32x4*)(EB + (size_t)u * 256 + 8 * dg) = (f32x4){__expf(be[0]), __expf(be[1]), __expf(be[2]), __expf(be[3])}; *(f32x4*)(EB + (size_t)u * 256 + 8 * dg + 4) = (f32x4){__expf(be[4]), __expf(be[5]), __expf(be[6]), __expf(be[7])}; }
#pragma unroll
    for (int i = 0; i < 4; ++i) { const int t = 4 * ts + i; const unsigned qw[4] = {qv[i].x, qv[i].y, qv[i].z, qv[i].w}, kw[4] = {kv[i].x, kv[i].y, kv[i].z, kv[i].w};
        float qd[8], kd[8], kdd[8];
#pragma unroll
        for (int e = 0; e < 8; ++e) { const float b = bt[i][e] + off[e], q = (e & 1) ? bfhi(qw[e >> 1]) : bflo(qw[e >> 1]), k = (e & 1) ? bfhi(kw[e >> 1]) : bflo(kw[e >> 1]);
            qd[e] = q * 0.0625f * __expf(b); kd[e] = k * __expf(-b); kdd[e] = k * __expf(be[e] - b); }
        v4u oq, ok, okk; oq.x = pk2(qd[0], qd[1]); oq.y = pk2(qd[2], qd[3]); oq.z = pk2(qd[4], qd[5]); oq.w = pk2(qd[6], qd[7]);
        ok.x = pk2(kd[0], kd[1]); ok.y = pk2(kd[2], kd[3]); ok.z = pk2(kd[4], kd[5]); ok.w = pk2(kd[6], kd[7]);
        okk.x = pk2(kdd[0], kdd[1]); okk.y = pk2(kdd[2], kdd[3]); okk.z = pk2(kdd[4], kdd[5]); okk.w = pk2(kdd[6], kdd[7]);
        *(v4u*)(QD + (size_t)(m0 + t) * 1024 + h * 256 + 8 * dg) = oq;
        *(LAS v4u*)(qd_s + t * LS + 8 * dg) = oq; *(LAS v4u*)(kd_s + t * LS + 8 * dg) = ok; *(LAS v4u*)(kdd_s + t * LS + 8 * dg) = okk;
        __builtin_amdgcn_sched_barrier(0); }
    WG_BAR();
#pragma unroll
    for (int i = 0; i < 8; ++i) { const int p = tid + 512 * i; vv[i] = *(const v4u*)(proj + (size_t)(m0 + (p >> 6)) * NPROJ + CV + h * 512 + 8 * (p & 63)); }
    {
        const int d = tid & 255, half = tid >> 8; unsigned kp[16];
#pragma unroll
        for (int i = 0; i < 32; ++i) { const unsigned x = kdd_s[(32 * half + i) * LS + d]; if (i & 1) kp[i >> 1] |= x << 16; else kp[i >> 1] = x; }
        v4u* kd4 = (v4u*)(KDDT + ((size_t)u * 256 + d) * 64 + 32 * half);
#pragma unroll
        for (int i = 0; i < 4; ++i) { v4u o; o.x = kp[4 * i]; o.y = kp[4 * i + 1]; o.z = kp[4 * i + 2]; o.w = kp[4 * i + 3]; kd4[i] = o; } }
    {
        const int tt = w >> 1, r = lane & 15, q = lane >> 4;
#pragma unroll
        for (int si = 0; si < 2; ++si) { const int st = 2 * (w & 1) + si; f32x4 acc = {0.f, 0.f, 0.f, 0.f};
            if (st <= tt) {
#pragma unroll
                for (int ks = 0; ks < 8; ++ks) { const bf16x8v a = *(const LAS bf16x8v*)(kd_s + (16 * st + r) * LS + ks * 32 + 8 * q), b = *(const LAS bf16x8v*)(qd_s + (16 * tt + r) * LS + ks * 32 + 8 * q);
                    acc = __builtin_amdgcn_mfma_f32_16x16x32_bf16(a, b, acc, 0, 0, 0); }
            }
            const int t = 16 * tt + r, s0 = 16 * st + 4 * q; v2u o;
            o.x = pk2(t >= s0 ? acc[0] : 0.f, t >= s0 + 1 ? acc[1] : 0.f); o.y = pk2(t >= s0 + 2 ? acc[2] : 0.f, t >= s0 + 3 ? acc[3] : 0.f);
            *(v2u*)(ATT + ((size_t)u * 64 + t) * 64 + s0) = o; }
    }
    WG_BAR();
#pragma unroll
    for (int i = 0; i < 8; ++i) { const int p = tid + 512 * i; *(LAS v4u*)(v_s + (p >> 6) * VLS + 8 * (p & 63)) = vv[i]; }
    WG_BAR();
    {
        unsigned vp[32];
#pragma unroll
        for (int t = 0; t < 64; ++t) { const unsigned x = v_s[t * VLS + tid]; if (t & 1) vp[t >> 1] |= x << 16; else vp[t >> 1] = x; }
        v4u* v4 = (v4u*)(VT + ((size_t)u * 512 + tid) * 64);
#pragma unroll
        for (int i = 0; i < 8; ++i) { v4u o; o.x = vp[4 * i]; o.y = vp[4 * i + 1]; o.z = vp[4 * i + 2]; o.w = vp[4 * i + 3]; v4[i] = o; }
    }
}
__device__ __forceinline__ void gla_prompt_unit(Frame& F, const bf16* QD, const bf16* KDDT, const bf16* VT, const bf16* ATT, const float* EB, float* OA, float* gla_p, int b, int h, int vs) {
    constexpr int LS = 264, PS = 72;
    constexpr int O_QD = 64 * LS * 2, O_KD = O_QD + 64 * LS * 2, O_VT = O_KD + 256 * PS * 2, O_AT = O_VT + 64 * PS * 2, O_EB = O_AT + 64 * PS * 2, O_DUM = O_EB + 1024;
    LAS unsigned char* L = F.lds; LAS bf16* ST = (LAS bf16*)L;
    const int tid = F.tid, lane = F.lane, w = F.wave, r = lane & 15, q = lane >> 4, tt = w >> 1, vt0 = 2 * (w & 1);
    f32x4 Sacc[2][4];
#pragma unroll
    for (int a = 0; a < 2; ++a)
#pragma unroll
        for (int c = 0; c < 4; ++c) Sacc[a][c] = (f32x4){0.f, 0.f, 0.f, 0.f};
    const int gq = ((tid >> 5) * 1024 + (tid & 31) * 8) * 2, lq = O_QD + (tid >> 5) * (LS * 2) + (tid & 31) * 16;
    const int gk = ((tid >> 3) * 64 + (tid & 7) * 8) * 2, lk = (tid >> 3) * (PS * 2) + (tid & 7) * 16;
    const bool ebok = tid < 64; const int ge = ebok ? tid * 16 : 0, le = ebok ? O_EB + tid * 16 : O_DUM;
    const unsigned char* pQD = (const unsigned char*)(QD + (size_t)(b * SEQ) * 1024 + h * 256); const size_t sQD = (size_t)64 * 1024 * 2;
    const size_t u0 = (size_t)(b * 32) * 4 + h;
    const unsigned char* pKD = (const unsigned char*)(KDDT + u0 * 256 * 64); const size_t sKD = (size_t)4 * 256 * 64 * 2;
    const unsigned char* pVT = (const unsigned char*)(VT + (u0 * 512 + vs * 64) * 64); const size_t sVT = (size_t)4 * 512 * 64 * 2;
    const unsigned char* pAT = (const unsigned char*)(ATT + u0 * 64 * 64); const size_t sAT = (size_t)4 * 64 * 64 * 2;
    const unsigned char* pEB = (const unsigned char*)(EB + u0 * 256); const size_t sEB = (size_t)4 * 256 * 4;
#define GP_LOAD(P, cc) do { const size_t c_ = (size_t)((cc) < 32 ? (cc) : 31); \
        _Pragma("unroll") for (int i = 0; i < 4; ++i) P[i] = *(const v4u*)(pQD + c_ * sQD + gq + i * (16 * 1024 * 2)); \
        _Pragma("unroll") for (int i = 0; i < 4; ++i) P[4 + i] = *(const v4u*)(pKD + c_ * sKD + gk + i * (64 * 64 * 2)); \
        P[8] = *(const v4u*)(pVT + c_ * sVT + gk); P[9] = *(const v4u*)(pAT + c_ * sAT + gk); P[10] = *(const v4u*)(pEB + c_ * sEB + ge); } while (0)
#define GP_STAGE(P) do { _Pragma("unroll") for (int i = 0; i < 11; ++i) asm volatile("" : "+v"(P[i])); \
        _Pragma("unroll") for (int i = 0; i < 4; ++i) *(LAS v4u*)(L + lq + i * (16 * LS * 2)) = P[i]; \
        _Pragma("unroll") for (int i = 0; i < 4; ++i) *(LAS v4u*)(L + O_KD + lk + i * (64 * PS * 2)) = P[4 + i]; \
        *(LAS v4u*)(L + O_VT + lk) = P[8]; *(LAS v4u*)(L + O_AT + lk) = P[9]; *(LAS v4u*)(L + le) = P[10]; } while (0)
    v4u PA[11];
    GP_LOAD(PA, 0);
    __syncthreads();
    for (int i = tid; i < 64 * LS / 2; i += NT) ((LAS unsigned*)ST)[i] = 0u;
    GP_STAGE(PA);
    WG_BAR();
    const LAS bf16* QDs = (const LAS bf16*)(L + O_QD); const LAS bf16* KDs = (const LAS bf16*)(L + O_KD); const LAS bf16* VTs = (const LAS bf16*)(L + O_VT); const LAS bf16* ATs = (const LAS bf16*)(L + O_AT);
    const LAS float* EBs = (const LAS float*)(L + O_EB);
    for (int c = 0; c < 32; ++c) {
        GP_LOAD(PA, c + 1);
        const int m0 = b * SEQ + c * 64;
        bf16x8v Bv[4][2], Akd[2][2]; f32x4 ebv[2];
#pragma unroll
        for (int vt = 0; vt < 4; ++vt)
#pragma unroll
            for (int ks = 0; ks < 2; ++ks) Bv[vt][ks] = *(const LAS bf16x8v*)(VTs + (16 * vt + r) * PS + ks * 32 + 8 * q);
#pragma unroll
        for (int dt = 0; dt < 2; ++dt) {
#pragma unroll
            for (int ks = 0; ks < 2; ++ks) Akd[dt][ks] = *(const LAS bf16x8v*)(KDs + (32 * w + 16 * dt + r) * PS + ks * 32 + 8 * q);
            ebv[dt] = *(const LAS f32x4*)(EBs + 32 * w + 16 * dt + 4 * q); }
        bf16x8v Aatt[2], Bo[2][2];
#pragma unroll
        for (int ks = 0; ks < 2; ++ks) { Aatt[ks] = *(const LAS bf16x8v*)(ATs + (16 * tt + r) * PS + ks * 32 + 8 * q);
#pragma unroll
            for (int vi = 0; vi < 2; ++vi) Bo[vi][ks] = *(const LAS bf16x8v*)(VTs + (16 * (vt0 + vi) + r) * PS + ks * 32 + 8 * q); }
        f32x4 oacc[2];
#pragma unroll
        for (int vi = 0; vi < 2; ++vi) { const int vt = vt0 + vi; f32x4 acc = {0.f, 0.f, 0.f, 0.f};
#pragma unroll
            for (int ks = 0; ks < 2; ++ks) acc = __builtin_amdgcn_mfma_f32_16x16x32_bf16(Bo[vi][ks], Aatt[ks], acc, 0, 0, 0);
#pragma unroll
            for (int ks = 0; ks < 8; ++ks) { const bf16x8v sfr = *(const LAS bf16x8v*)(ST + (16 * vt + r) * LS + ks * 32 + 8 * q), aq = *(const LAS bf16x8v*)(QDs + (16 * tt + r) * LS + ks * 32 + 8 * q);
                acc = __builtin_amdgcn_mfma_f32_16x16x32_bf16(sfr, aq, acc, 0, 0, 0); }
            oacc[vi] = acc; }
#pragma unroll
        for (int vi = 0; vi < 2; ++vi) *(f32x4*)(OA + (size_t)(m0 + 16 * tt + r) * 2048 + h * 512 + vs * 64 + 16 * (vt0 + vi) + 4 * q) = oacc[vi];
        WG_BAR();
#pragma unroll
        for (int dt = 0; dt < 2; ++dt)
#pragma unroll
            for (int vt = 0; vt < 4; ++vt) { f32x4 a = Sacc[dt][vt] * ebv[dt];
#pragma unroll
                for (int ks = 0; ks < 2; ++ks) a = __builtin_amdgcn_mfma_f32_16x16x32_bf16(Akd[dt][ks], Bv[vt][ks], a, 0, 0, 0);
                Sacc[dt][vt] = a; v2u o; o.x = pk2(a[0], a[1]); o.y = pk2(a[2], a[3]);
                *(LAS v2u*)(ST + (16 * vt + r) * LS + 32 * w + 16 * dt + 4 * q) = o; }
        GP_STAGE(PA);
        WG_BAR();
    }
#undef GP_LOAD
#undef GP_STAGE
#pragma unroll
    for (int dt = 0; dt < 2; ++dt)
#pragma unroll
        for (int vt = 0; vt < 4; ++vt)
#pragma unroll
            for (int j = 0; j < 4; ++j) gla_p[((size_t)(b * 4 + h) * 256 + 32 * w + 16 * dt + 4 * q + j) * 512 + vs * 64 + 16 * vt + r] = Sacc[dt][vt][j];
}

__device__ __forceinline__ void gla_sample_unit(Frame& F, const bf16* proj, const float* LA, float* OA, const float* S0g, float* Sog, int b, int h) {
    LAS float* qdT = (LAS float*)F.lds; LAS float* kddT = qdT + 2048; LAS float* kd = kddT + 2048; LAS float* eb = kd + 2048; LAS float* att = eb + 256; LAS float* ored = att + 64;
    const int tid = F.tid, lane = F.lane, w = F.wave, m0 = TP + b * DSEQ;
    __syncthreads();
    if (tid < 256) { const int d = tid; float bt[8]; float bc = 0.f;
#pragma unroll
        for (int t = 0; t < 8; ++t) { bc += LA[(size_t)(m0 + t) * 1024 + h * 256 + d]; bt[t] = bc; }
#pragma unroll
        for (int t = 0; t < 8; ++t) { const bf16* pr = proj + (size_t)(m0 + t) * NPROJ + h * 256 + d; const float q = bf2f(pr[CQ]) * 0.0625f, k = bf2f(pr[CK]);
            qdT[d * 8 + t] = q * __expf(bt[t]); kd[t * 256 + d] = k * __expf(-bt[t]); kddT[d * 8 + t] = k * __expf(bc - bt[t]); }
        eb[d] = __expf(bc); }
    __syncthreads();
    {
#pragma unroll
        for (int s = 0; s < 8; ++s) { float p = 0.f;
#pragma unroll
            for (int i = 0; i < 4; ++i) { const int d = lane + 64 * i; p += qdT[d * 8 + w] * kd[s * 256 + d]; }
            p = wave_sum(p); if (lane == 0) att[w * 8 + s] = (s <= w) ? p : 0.f; }
    }
    __syncthreads();
    const int vq = tid & 127, dg = tid >> 7, v0 = 4 * vq;
    f32x4 vv[8], o[8];
#pragma unroll
    for (int t = 0; t < 8; ++t) { const v2u x = *(const v2u*)(proj + (size_t)(m0 + t) * NPROJ + CV + h * 512 + v0); vv[t] = (f32x4){bflo(x.x), bfhi(x.x), bflo(x.y), bfhi(x.y)}; }
#pragma unroll
    for (int t = 0; t < 8; ++t) { f32x4 s = {0.f, 0.f, 0.f, 0.f};
        if (dg == 0) {
#pragma unroll
            for (int uu = 0; uu < 8; ++uu) s += att[t * 8 + uu] * vv[uu]; }
        o[t] = s; }
    const float* S0 = S0g + ((size_t)(b * 4 + h) * 256 + 64 * dg) * 512 + v0; float* So = Sog + ((size_t)(b * 4 + h) * 256 + 64 * dg) * 512 + v0;
    f32x4 s0[8], s1[8];
#pragma unroll
    for (int i = 0; i < 8; ++i) s0[i] = *(const f32x4*)(S0 + (size_t)i * 512);
#pragma unroll 1
    for (int db = 0; db < 64; db += 8) {
        { const int dn = db + 8 < 64 ? db + 8 : db;
#pragma unroll
          for (int i = 0; i < 8; ++i) s1[i] = *(const f32x4*)(S0 + (size_t)(dn + i) * 512); }
#pragma unroll
        for (int i = 0; i < 8; ++i) { const int d = 64 * dg + db + i;
            const f32x4 q0 = *(const LAS f32x4*)(qdT + d * 8), q1 = *(const LAS f32x4*)(qdT + d * 8 + 4), k0 = *(const LAS f32x4*)(kddT + d * 8), k1 = *(const LAS f32x4*)(kddT + d * 8 + 4);
            o[0] += q0.x * s0[i]; o[1] += q0.y * s0[i]; o[2] += q0.z * s0[i]; o[3] += q0.w * s0[i]; o[4] += q1.x * s0[i]; o[5] += q1.y * s0[i]; o[6] += q1.z * s0[i]; o[7] += q1.w * s0[i];
            f32x4 sn = s0[i] * eb[d];
            sn += k0.x * vv[0]; sn += k0.y * vv[1]; sn += k0.z * vv[2]; sn += k0.w * vv[3]; sn += k1.x * vv[4]; sn += k1.y * vv[5]; sn += k1.z * vv[6]; sn += k1.w * vv[7];
            *(f32x4*)(So + (size_t)(db + i) * 512) = sn; }
#pragma unroll
        for (int i = 0; i < 8; ++i) s0[i] = s1[i];
    }
#pragma unroll
    for (int t = 0; t < 8; ++t) *(LAS f32x4*)(ored + (dg * 8 + t) * 512 + v0) = o[t];
    __syncthreads();
#pragma unroll
    for (int i = 0; i < 2; ++i) { const int idx = tid + 512 * i, t = idx >> 7, v4 = (idx & 127) * 4;
        const f32x4 s = (*(const LAS f32x4*)(ored + (0 * 8 + t) * 512 + v4) + *(const LAS f32x4*)(ored + (1 * 8 + t) * 512 + v4)) + (*(const LAS f32x4*)(ored + (2 * 8 + t) * 512 + v4) + *(const LAS f32x4*)(ored + (3 * 8 + t) * 512 + v4));
        *(f32x4*)(OA + (size_t)(m0 + t) * 2048 + h * 512 + v4) = s; }
}

__device__ __forceinline__ float sum16(float x) {
    x += dpp_f(x, 0); x += dpp_f(x, 1); x += dpp_f(x, 2);
    const int v = __builtin_bit_cast(int, x); x += __builtin_bit_cast(float, __builtin_amdgcn_update_dpp(v, v, 0x140, 0xF, 0xF, false));
    return x;
}
__device__ __forceinline__ f32x4 bf4(v2u w) { return (f32x4){bflo(w.x), bfhi(w.x), bflo(w.y), bfhi(w.y)}; }
struct P4In { v2u r, k, v, rp, kp, vp; f32x4 l1d, l1i, la; };
__device__ __forceinline__ P4In p4_load(const bf16* PROJ, const bf16* L1, int it, int lane) {
    const int m = it >> 3, hq = it & 7, c0 = hq * 256 + 4 * lane; const SeqPos sp = seqpos(m); const bf16* pr = PROJ + (size_t)m * NPROJ + c0;
    P4In x; x.r = *(const v2u*)(pr + CR); x.k = *(const v2u*)(pr + CKR); x.v = *(const v2u*)(pr + CVR);
    const bf16* pq = sp.t > 0 ? pr - NPROJ : pr;
    x.rp = *(const v2u*)(pq + CR); x.kp = *(const v2u*)(pq + CKR); x.vp = *(const v2u*)(pq + CVR);
    const bf16* l = L1 + (size_t)m * NL1 + c0; x.l1d = bf4(*(const v2u*)(l + 1024)); x.l1i = bf4(*(const v2u*)(l + 3072)); x.la = bf4(*(const v2u*)(l));
    return x;
}
struct P4Par { f32x4 mur, muk, muv, a0, w0, kk, ka, rk, ba; };
__device__ __forceinline__ void p4_compute(const P4In& x, const P4Par& P, const float* sshift, unsigned char* SCAN, float* BONUS, float* LA, int it, int lane) {
    const int m = it >> 3, hq = it & 7, c0 = hq * 256 + 4 * lane, h = 4 * hq + (lane >> 4), cl = lane & 15; const SeqPos sp = seqpos(m);
    f32x4 rp = bf4(x.rp), kp = bf4(x.kp), vp = bf4(x.vp);
    if (sp.t == 0) { if (sp.prm) { rp = (f32x4){0.f, 0.f, 0.f, 0.f}; kp = rp; vp = rp; }
        else { const float* sh = sshift + (size_t)sp.b * ZRC + c0; rp = *(const f32x4*)sh; kp = *(const f32x4*)(sh + 2144); vp = *(const f32x4*)(sh + 4192); } }
    const f32x4 z0 = bf4(x.r), z1 = bf4(x.k), z2 = bf4(x.v);
    const f32x4 r = z0 + (rp - z0) * P.mur, ksh = z1 + (kp - z1) * P.muk, vsh = z2 + (vp - z2) * P.muv;
    f32x4 a, dec, kk, k2; float ss = 0.f, bs = 0.f;
#pragma unroll
    for (int e = 0; e < 4; ++e) { a[e] = sigmoidf_(P.a0[e] + x.l1i[e]); const float wl = -softplusf_(-(P.w0[e] + x.l1d[e])) - 0.5f; dec[e] = __expf(-__expf(wl));
        kk[e] = ksh[e] * P.kk[e]; ss += kk[e] * kk[e]; k2[e] = ksh[e] * (1.0f + (a[e] - 1.0f) * P.ka[e]); bs += r[e] * k2[e] * P.rk[e]; }
    const float inv = 1.0f / fmaxf(sqrtf(sum16(ss)), 1e-12f); bs = sum16(bs);
    kk = kk * inv;
    unsigned char* rb = SCAN + ((size_t)m * 32 + h) * SCAN_REC; const f32x4 nk = -kk, ka = kk * a;
    *(f32x4*)(rb + 16 * cl) = dec;
    v2u t; t.x = pk2(r[0], r[1]); t.y = pk2(r[2], r[3]); *(v2u*)(rb + 256 + 8 * cl) = t;
    t.x = pk2(k2[0], k2[1]); t.y = pk2(k2[2], k2[3]); *(v2u*)(rb + 384 + 8 * cl) = t;
    t.x = pk2(nk[0], nk[1]); t.y = pk2(nk[2], nk[3]); *(v2u*)(rb + 512 + 8 * cl) = t;
    t.x = pk2(ka[0], ka[1]); t.y = pk2(ka[2], ka[3]); *(v2u*)(rb + 640 + 8 * cl) = t;
    t.x = pk2(vsh[0], vsh[1]); t.y = pk2(vsh[2], vsh[3]); *(v2u*)(rb + 768 + 8 * cl) = t;
    if (cl == 0) BONUS[m * 32 + h] = bs;
    if (hq < 4) { f32x4 la;
#pragma unroll
        for (int e = 0; e < 4; ++e) la[e] = -softplusf_(-(x.la[e] + P.ba[e])) * 0.0625f;
        *(f32x4*)(LA + (size_t)m * 1024 + c0) = la; }
}
struct P6In { f32x4 ob; v2u v, g; float bonus; };
__device__ __forceinline__ P6In p6_load(const float* OB, const unsigned char* SCAN, const float* BONUS, const bf16* Gb, int it, int lane) {
    const int m = it >> 3, hq = it & 7, c0 = hq * 256 + 4 * lane, h = 4 * hq + (lane >> 4), cl = lane & 15;
    P6In x; x.ob = *(const f32x4*)(OB + (size_t)m * 2048 + c0); x.v = *(const v2u*)(SCAN + ((size_t)m * 32 + h) * SCAN_REC + 768 + 8 * cl); x.g = *(const v2u*)(Gb + (size_t)m * 2048 + c0); x.bonus = BONUS[m * 32 + h];
    return x;
}
__device__ __forceinline__ void p6_compute(const P6In& x, f32x4 lnw, f32x4 lnb, bf16* OBP, int it, int lane) {
    const int m = it >> 3, hq = it & 7, c0 = hq * 256 + 4 * lane;
    const float mean = sum16((x.ob[0] + x.ob[1]) + (x.ob[2] + x.ob[3])) * (1.f / 64.f); const f32x4 dv = x.ob - mean;
    const float var = sum16((dv[0] * dv[0] + dv[1] * dv[1]) + (dv[2] * dv[2] + dv[3] * dv[3])) * (1.f / 64.f); const float rs = __builtin_amdgcn_rsqf(var + 64e-5f);
    const f32x4 y = (dv * rs * lnw + lnb + x.bonus * bf4(x.v)) * bf4(x.g);
    v2u o; o.x = pk2(y[0], y[1]); o.y = pk2(y[2], y[3]); *(v2u*)(OBP + (size_t)m * 2048 + c0) = o;
}

constexpr int LI1 = 64 * (NUP / 32), LI2 = (DFF / 64) * (D / 32), LI3 = 64 * 128, LI4 = 64 * 128, LI5 = 32 * 128, LI6 = 32 * 128, LI7 = 4 * 128;
constexpr int NLATE = LI1 + LI2 + LI3 + LI4 + LI5 + LI6 + LI7, NLATE_CHUNKS = NLATE / 64;
static_assert(NLATE % 64 == 0, "late items come in chunks of 64");
__device__ __forceinline__ TrDesc late_desc(KArgs& args, unsigned char* ws, int it) {
    int r = it;
    if (r < LI1) return TrDesc{args.in[I_WUP], (bf16*)(ws + WS_WT_UP), D, NUP, NUP / 32, r, false}; r -= LI1;
    if (r < LI2) return TrDesc{args.in[I_WDOWN], (bf16*)(ws + WS_WT_DOWN), DFF, D, D / 32, r, false}; r -= LI2;
    if (r < LI3) return TrDesc{args.in[I_WOUT], (bf16*)(ws + WS_WT_OUT), D, D, D / 32, r, false}; r -= LI3;
    if (r < LI4) return TrDesc{args.in[I_WPEG], (bf16*)(ws + WS_WT_PEG), D, D, D / 32, r, false}; r -= LI4;
    if (r < LI5) return TrDesc{args.in[I_WBRA], (bf16*)(ws + WS_WT_BRA), 2048, D, D / 32, r, false}; r -= LI5;
    if (r < LI6) return TrDesc{args.in[I_WBRB], (bf16*)(ws + WS_WT_BRB), 2048, D, D / 32, r, false}; r -= LI6;
    return TrDesc{args.in[I_WPE], (bf16*)(ws + WS_WT_PE), 256, D, D / 32, r, false};
}

__device__ __forceinline__ void late_chunk(Frame& F, KArgs& args, unsigned char* ws, int chunk) {
    LAS float* scr = (LAS float*)(F.lds + F.wave * 16384); const int base = chunk * 64 + F.wave * 8;
    float ta[32], tb[32];
    TrDesc da = late_desc(args, ws, base), db = da;
    tr_load(da, ta, F.lane);
#pragma unroll 1
    for (int i = 0; i < 8; i += 2) {
        db = late_desc(args, ws, base + i + 1); tr_load(db, tb, F.lane);
        tr_finish(da, ta, scr, F.lane);
        if (i + 2 < 8) { da = late_desc(args, ws, base + i + 2); tr_load(da, ta, F.lane); }
        tr_finish(db, tb, scr, F.lane);
    }
}
constexpr int TAILB = 192, NTB = 3, NT1 = 2, TAIL1 = NT1 * 120, PEG0 = 1160, PEG1 = 1288;
static_assert(NTB * TAILB + TAIL1 <= 1032, "tail chunks are w_up / w_down chunks (first needed after the branch GEMM)");
static_assert(NLATE_CHUNKS == 1424 && LI1 / 64 == 688 && (LI1 + LI2 + LI3) / 64 == PEG0 && (LI1 + LI2 + LI3 + LI4) / 64 == PEG1, "chunk map");

constexpr int N_PHASES = 15;
#ifndef REP0
#define REP0 1
#endif
#ifndef REP1
#define REP1 1
#endif
#ifndef REP5
#define REP5 1
#endif
#ifndef REP10
#define REP10 1
#endif
#ifndef REP12
#define REP12 1
#endif
__global__ void __launch_bounds__(NT, 2) fwd_kernel(Args args_unused) {
    extern __shared__ __attribute__((aligned(16))) unsigned char lds_[];
    KArgs& args = *(KArgs*)__builtin_amdgcn_kernarg_segment_ptr();
    Frame F;
    F.lds = (LAS unsigned char*)lds_;
    F.tid = threadIdx.x; F.lane = F.tid & 63; F.wave = __builtin_amdgcn_readfirstlane(F.tid >> 6);
    F.G = gridDim.x; { const int bx = blockIdx.x; F.vcu = (F.G % 8 == 0) ? (bx % 8) * (F.G / 8) + bx / 8 : bx; }
    F.gw = F.vcu * NWAVES + F.wave; F.NGW = F.G * NWAVES;
    unsigned char* ws = args.ws; float* out = args.out;
    unsigned* ctl = (unsigned*)(ws + WS_CTL);
    volatile LAS unsigned* MISC = (volatile LAS unsigned*)(F.lds + MISC_OFF);
    for (int u = F.tid; u < (LDS_BYTES - RING_BYTES) / 4; u += NT) ((LAS unsigned*)(F.lds + RING_BYTES))[u] = 0u;
    __syncthreads();
#if MK_ONE_LAUNCH
    XcdBarrier bar = xcd_barrier_post(ctl + CW_BAR, MISC + 8);
#define GRID_BAR() xcd_barrier(bar)
#else
#define GRID_BAR() do { } while (0)
#endif
    const int lo = args.ph_lo, hi = args.ph_hi;
#define IN(k) (lo <= (k) && (k) < hi)
#define SEAM(k) do { if (IN(k) && IN((k) + 1)) GRID_BAR(); } while (0)

    bf16* WT_IN = (bf16*)(ws + WS_WT_IN); bf16* WT_UP = (bf16*)(ws + WS_WT_UP); bf16* WT_DOWN = (bf16*)(ws + WS_WT_DOWN); bf16* WT_OUT = (bf16*)(ws + WS_WT_OUT);
    bf16* WT_PEG = (bf16*)(ws + WS_WT_PEG); bf16* WT_BRA = (bf16*)(ws + WS_WT_BRA); bf16* WT_BRB = (bf16*)(ws + WS_WT_BRB); bf16* WT_PE = (bf16*)(ws + WS_WT_PE);
    bf16* WL1 = (bf16*)(ws + WS_WL1); bf16* WG = (bf16*)(ws + WS_WG);
    bf16* H = (bf16*)(ws + WS_H); bf16* PROJ = (bf16*)(ws + WS_PROJ); bf16* UP = (bf16*)(ws + WS_PROJ);
    unsigned char* SCAN = ws + WS_SCAN; bf16* ACT = (bf16*)(ws + WS_SCAN); float* TMP = (float*)(ws + WS_SCAN);
    bf16* Gb = (bf16*)(ws + WS_G); float* LA = (float*)(ws + WS_LA); bf16* AL1 = (bf16*)(ws + WS_AL1); bf16* AG = (bf16*)(ws + WS_AG); bf16* PB = (bf16*)(ws + WS_PB);
    float* BONUS = (float*)(ws + WS_BONUS); bf16* PPb = (bf16*)(ws + WS_PP);
    bf16* QDg = (bf16*)(ws + WS_QD); bf16* KDDTg = (bf16*)(ws + WS_KDDT); bf16* VTg = (bf16*)(ws + WS_VT); bf16* ATTg = (bf16*)(ws + WS_ATT); float* EBg = (float*)(ws + WS_EB);
    float* MO = (float*)(ws + WS_PROJ); float* FF = (float*)(ws + WS_PROJ);
    float* MOS = (float*)(ws + WS_PROJ + 144 * MiB); float* FFS = (float*)(ws + WS_PROJ + 240 * MiB);
    bf16* L1 = (bf16*)(out + O_GLA_S);
    float* OA = out + O_Y; float* OB = out + O_Y + (size_t)T * 2048;
    bf16* OAP = H; bf16* OBP = H + (size_t)T * 2048;
    bf16* MIXED = (bf16*)(out + O_Y);
    float* Y = out + O_Y;

    if (IN(0)) {
        LAS float* scr = (LAS float*)(F.lds + F.wave * 16384);
        constexpr int I0 = 64 * (NPROJ / 32), I8 = 4 * 64;
#define P0_DESC(it_) ((it_) < I0 ? TrDesc{args.in[I_WIN], WT_IN, D, 20944, NPROJ / 32, (it_), true} : TrDesc{args.in[I_WGATE2], WG, 256, 2048, 2048 / 32, (it_) - I0, false})
        {   float ta[32], tb[32]; int it = F.gw;
            if (it < I0 + I8) { TrDesc da = P0_DESC(it), db = da; tr_load(da, ta, F.lane);
                for (; it < I0 + I8; it += 2 * F.NGW) {
                    const int i1 = it + F.NGW, i2 = it + 2 * F.NGW; const bool h1 = i1 < I0 + I8, h2 = i2 < I0 + I8;
                    if (h1) { db = P0_DESC(i1); tr_load(db, tb, F.lane); }
                    tr_finish(da, ta, scr, F.lane);
                    if (h2) { da = P0_DESC(i2); tr_load(da, ta, F.lane); }
                    if (h1) tr_finish(db, tb, scr, F.lane);
                } }
        }
#undef P0_DESC
        for (int e0 = F.vcu * NT + F.tid; e0 < NL1 * 256; e0 += 10 * F.G * NT) {
            float v[10];
#pragma unroll
            for (int j = 0; j < 10; ++j) { const int e = e0 + j * F.G * NT, k = e / NL1, n = e - k * NL1; const float* src = nullptr;
                if (e < NL1 * 256) {
                    if (n < 1024) { if (k < 16) src = args.in[I_WALPHA2] + k * 1024 + n; }
                    else if (n < 3072) { if (k >= 16 && k < 112) src = args.in[I_WDECAY2] + (k - 16) * 2048 + (n - 1024); }
                    else { if (k >= 112 && k < 208) src = args.in[I_WICLR2] + (k - 112) * 2048 + (n - 3072); } }
                v[j] = src ? *src : 0.f; }
#pragma unroll
            for (int j = 0; j < 10; ++j) { const int e = e0 + j * F.G * NT, k = e / NL1, n = e - k * NL1; if (e < NL1 * 256) WL1[n * 256 + k] = (bf16)f2bf(v[j]); }
        }
        for (int m = F.gw; m < T; m += F.NGW) {
            rms_row_bf16(xrow(args, m), args.in[I_GPREMIX], H + (size_t)m * D, F.lane);
            const float* pr = m < TP ? args.in[I_PP] + (size_t)m * 256 : args.in[I_PS] + (size_t)(m - TP) * 256;
            const f32x4 pv = *((const f32x4*)pr + F.lane); v2u w; w.x = pk2(pv.x, pv.y); w.y = pk2(pv.z, pv.w); *((v2u*)(PB + (size_t)m * 256) + F.lane) = w;
        }
    }
    SEAM(0);
    if (IN(1)) { run_gemm(F, H, WT_IN, T, NPROJ, D, FStoreBf16{PROJ, NPROJ});
        if (F.G == 256) { constexpr int rem = ((T / 256) * (NPROJ / 256)) % 256; const int c = (int)blockIdx.x;
            if (c >= rem) {
#pragma unroll 1
                for (int k = 0; k < NT1; ++k) late_chunk(F, args, ws, NTB * TAILB + k * 120 + c - rem); } }
    }
    SEAM(1);
    if (IN(2)) {
        const float* mu = args.in[I_MU];
        for (int m = F.gw; m < T; m += F.NGW) {
            const SeqPos sp = seqpos(m); const bf16* pr = PROJ + (size_t)m * NPROJ; const bf16* pp = pr - NPROJ;
            const float* sh = args.in[I_SSHIFT] + (size_t)sp.b * ZRC;
            for (int c = F.lane; c < 256; c += 64) {
                float val = 0.f;
                if (c < 16) val = bf2f(pr[CSM + c]);
                else if (c < 208) { const int oz = c < 112 ? 2048 + (c - 16) : 6240 + (c - 112); const float z = bf2f(pr[CSM + c]);
                    const float prev = sp.t > 0 ? bf2f(pp[CSM + c]) : (sp.prm ? 0.f : sh[oz]); const float zs = z + (prev - z) * mu[oz]; val = c < 112 ? tanhf(zs) : zs; }
                AL1[(size_t)m * 256 + c] = (bf16)f2bf(val);
                { const int oz = 6336 + c; const float z = bf2f(pr[CXG + c]); const float prev = sp.t > 0 ? bf2f(pp[CXG + c]) : (sp.prm ? 0.f : sh[oz]);
                  const float zs = z + (prev - z) * mu[oz]; AG[(size_t)m * 256 + c] = (bf16)f2bf(sigmoidf_(zs)); }
            }
            if (sp.t == sp.L - 1) { float* so = out + (sp.prm ? O_SHIFT_P : O_SHIFT_S) + (size_t)sp.b * ZRC;
                for (int oz = F.lane; oz < ZRC; oz += 64) so[oz] = bf2f(pr[zr_col(oz)]); }
        }
    }
    SEAM(2);
    if (IN(3)) {
        run_gemm(F, AL1, WL1, T, NL1, 256, FStoreBf16{L1, NL1});
        run_gemm(F, AG, WG, T, 2048, 256, FStoreBf16{Gb, 2048});
    }
    SEAM(3);
    if (IN(4)) {
        {
            const int hq = F.gw & 7, c0 = hq * 256 + 4 * F.lane; const float* mu = args.in[I_MU];
            P4Par P; P.mur = *(const f32x4*)(mu + c0); P.muk = *(const f32x4*)(mu + 2144 + c0); P.muv = *(const f32x4*)(mu + 4192 + c0);
            P.a0 = *(const f32x4*)(args.in[I_A0] + c0); P.w0 = *(const f32x4*)(args.in[I_W0] + c0); P.kk = *(const f32x4*)(args.in[I_KK] + c0); P.ka = *(const f32x4*)(args.in[I_KA] + c0);
            P.rk = *(const f32x4*)(args.in[I_RK] + c0); P.ba = *(const f32x4*)(args.in[I_BALPHA] + (c0 & 1023));
            if (F.G == 256) {
                const int g = F.vcu;
#pragma unroll 1
                for (int i = 0; i < 36; i += 2) { const int ma = i < 32 ? 32 * g + i : TP + 4 * g + (i - 32), ita = ma * 8 + hq, itb = ita + 8;
                    const P4In xa = p4_load(PROJ, L1, ita, F.lane), xb = p4_load(PROJ, L1, itb, F.lane);
                    p4_compute(xa, P, args.in[I_SSHIFT], SCAN, BONUS, LA, ita, F.lane);
                    p4_compute(xb, P, args.in[I_SSHIFT], SCAN, BONUS, LA, itb, F.lane); }
                asm volatile("s_waitcnt vmcnt(0)" ::: "memory");
                LAS unsigned char* wl = F.lds + F.wave * 16384;
                RwRec R; rw_prep_load<0, 8>(R, F.lane, SCAN, 32 * g, 4 * hq);
#pragma unroll 1
                for (int k = 0; k < 8; ++k) { const int h = 4 * hq + (k & 3), mb = 32 * g + 16 * (k >> 2), b = mb >> 11, c = (mb & 2047) >> 4; const size_t uc = (size_t)(b * 32 + h) * RW_NCH + c;
                    rw_prep_load<8, 16>(R, F.lane, SCAN, mb, h);
                    rw_prep_a(R, wl, F.lane, ws + WS_RW2 + uc * RW_A2);
                    { const int kn = k < 7 ? k + 1 : 7; rw_prep_load<0, 8>(R, F.lane, SCAN, 32 * g + 16 * (kn >> 2), 4 * hq + (kn & 3)); }
                    rw_prep_b(wl, F.lane, ws + WS_RW1 + uc * RW_A1); }
            } else
            for (int it = F.gw; it < T * 8; it += 2 * F.NGW) {
                const int it2 = it + F.NGW; const bool has2 = it2 < T * 8;
                const P4In xa = p4_load(PROJ, L1, it, F.lane), xb = p4_load(PROJ, L1, has2 ? it2 : it, F.lane);
                p4_compute(xa, P, args.in[I_SSHIFT], SCAN, BONUS, LA, it, F.lane);
                if (has2) p4_compute(xb, P, args.in[I_SSHIFT], SCAN, BONUS, LA, it2, F.lane);
            }
        }
        for (int uu = F.vcu; uu < 512; uu += F.G) gla_prep_unit(F, PROJ, L1, args.in[I_BALPHA], QDg, KDDTg, VTg, ATTg, EBg, uu >> 2, uu & 3);
    }
    SEAM(4);
    if (IN(5)) {
        const int g = F.vcu;
        if (g < 256) { const int u = g >> 1;
            if ((g & 1) == 0) {
                if (F.G == 256) { if ((g & 3) == 0)
                        rwkv_chunk_scan_lds(F, ws + WS_RW1, ws + WS_RW2, (g >> 2) * 2, out + O_RWKV_P, OB); }
                else { const int b = u >> 5, h = u & 31; rwkv_unit<0>(F, SCAN, b * SEQ, SEQ, h, nullptr, out + O_RWKV_P + (size_t)(b * 32 + h) * 4096, OB); } }
            else { const int b = u >> 5, h = (u >> 3) & 3, vs = u & 7; gla_prompt_unit(F, QDg, KDDTg, VTg, ATTg, EBg, OA, out + O_GLA_P, b, h, vs); } }
        for (;;) {
            __syncthreads();
            if (F.tid == 0) MISC[0] = atomicAdd(ctl + CW_QUEUE, 1u);
            __syncthreads();
            const unsigned q = MISC[0];
            const bool tails = F.G == 256; const unsigned nq = tails ? (unsigned)(NLATE_CHUNKS - NTB * TAILB - TAIL1) : (unsigned)NLATE_CHUNKS;
            if (q >= 512u + nq + 1024u) break;
            if (q < 512u) { gla_sample_unit(F, PROJ, LA, OA, args.in[I_SGLA], out + O_GLA_S, (int)(q >> 2), (int)(q & 3)); }
            else if (q < 512u + nq) { int ch = (int)q - 512; if (tails) ch += NTB * TAILB + TAIL1;
                late_chunk(F, args, ws, ch); }
            else { const int u4 = (int)(q - 512u - nq), u = u4 * 4, b = u >> 5, h = u & 31;
                rwkv_unit<4>(F, SCAN, TP + b * DSEQ, DSEQ, h, args.in[I_SRWKV] + (size_t)u * 4096, out + O_RWKV_S + (size_t)u * 4096, OB); }
        }
    }
    SEAM(5);
    if (IN(6)) {
        {   const int hq = F.gw & 7, c0 = hq * 256 + 4 * F.lane;
            const f32x4 lnw = *(const f32x4*)(args.in[I_LNXW] + c0), lnb = *(const f32x4*)(args.in[I_LNXB] + c0);
            for (int it = F.gw; it < T * 8; it += 2 * F.NGW) {
                const int it2 = it + F.NGW; const bool has2 = it2 < T * 8;
                const P6In xa = p6_load(OB, SCAN, BONUS, Gb, it, F.lane), xb = p6_load(OB, SCAN, BONUS, Gb, has2 ? it2 : it, F.lane);
                p6_compute(xa, lnw, lnb, OBP, it, F.lane);
                if (has2) p6_compute(xb, lnw, lnb, OBP, it2, F.lane);
            }
        }
        const f32x4 gn0 = *(const f32x4*)(args.in[I_GLANORM] + F.lane * 8), gn1 = *(const f32x4*)(args.in[I_GLANORM] + F.lane * 8 + 4);
#define P6G_LOAD(o0_, o1_, zg_, idx_) do { const int i_ = (idx_) < T * 4 ? (idx_) : F.gw; const int m_ = i_ >> 2, h_ = i_ & 3; const float* op_ = OA + (size_t)m_ * 2048 + h_ * 512 + F.lane * 8; \
            o0_ = *(const f32x4*)op_; o1_ = *(const f32x4*)(op_ + 4); zg_ = *(const v4u*)(PROJ + (size_t)m_ * NPROJ + CZG + h_ * 512 + F.lane * 8); } while (0)
        f32x4 pa0, pa1, pb0, pb1, pc0, pc1; v4u pza, pzb, pzc;
        P6G_LOAD(pa0, pa1, pza, F.gw); P6G_LOAD(pb0, pb1, pzb, F.gw + F.NGW);
        for (int idx = F.gw; idx < T * 4; idx += F.NGW) {
            P6G_LOAD(pc0, pc1, pzc, idx + 2 * F.NGW);
            const int m = idx >> 2, h = idx & 3;
            const f32x4 o0 = pa0, o1 = pa1;
            const float ss = wave_sum((o0.x * o0.x + o0.y * o0.y) + (o0.z * o0.z + o0.w * o0.w) + (o1.x * o1.x + o1.y * o1.y) + (o1.z * o1.z + o1.w * o1.w));
            const float rs = __builtin_amdgcn_rsqf(ss * (1.f / 512.f) + 1e-6f);
            const f32x4 g0 = gn0, g1 = gn1;
            const v4u zg = pza;
            const float z[8] = {bflo(zg.x), bfhi(zg.x), bflo(zg.y), bfhi(zg.y), bflo(zg.z), bfhi(zg.z), bflo(zg.w), bfhi(zg.w)};
            const float o[8] = {o0.x * g0.x, o0.y * g0.y, o0.z * g0.z, o0.w * g0.w, o1.x * g1.x, o1.y * g1.y, o1.z * g1.z, o1.w * g1.w};
            float y[8];
#pragma unroll
            for (int i = 0; i < 8; ++i) y[i] = o[i] * rs * z[i] * sigmoidf_(z[i]);
            v4u w; w.x = pk2(y[0], y[1]); w.y = pk2(y[2], y[3]); w.z = pk2(y[4], y[5]); w.w = pk2(y[6], y[7]);
            *(v4u*)(OAP + (size_t)m * 2048 + h * 512 + F.lane * 8) = w;
            pa0 = pb0; pa1 = pb1; pza = pzb; pb0 = pc0; pb1 = pc1; pzb = pzc;
        }
#undef P6G_LOAD
    }
    SEAM(6);
    if (IN(7)) {
        const int cblk = (int)blockIdx.x; const bool tails = F.G == 256;
        run_gemm_chain(F, OAP, WT_BRA, OBP, WT_BRB, T, D, 2048, FBranch{PROJ, MIXED});
        if (tails && cblk >= 64) {
#pragma unroll 1
            for (int k = 0; k < NTB; ++k) late_chunk(F, args, ws, k * TAILB + cblk - 64); }
    }
    SEAM(7);
    if (IN(8)) { run_gemm_split(F, MIXED, WT_OUT, T, D, D, FStoreF32Split{MO, D, MOS, TP, (size_t)TS * D, (bf16*)MO}); }
    SEAM(8);
    if (IN(9)) { for (int m = F.gw; m < T; m += F.NGW) sandwich_row(MO + (size_t)m * D, m < TP ? (const bf16*)MO + (size_t)m * D : nullptr, MOS + (size_t)(m - TP) * D, (size_t)TS * D, m >= TP ? 3 : 0, xrow(args, m), args.in[I_GPOSTMIX], Y + (size_t)m * D, args.in[I_GPREFFN], H + (size_t)m * D, F.lane); }
    SEAM(9);
    if (IN(10)) {
        if (F.G == 256) {
            constexpr int NUPT = (T / 256) * (NUP / 256), FULL = (NUPT / 256) * 256, NQ = (NUPT - FULL) * 4;
            run_gemm_lim(F, H, WT_UP, T, NUP, D, FStoreBf16{UP, NUP}, FULL);
            const int c = (int)blockIdx.x;
            if (c < NQ) { const int cq = (c & 7) * (NQ / 8) + (c >> 3); pg8::StaticOrder S; S.init(T, NUP, D, 256, 0); pg8::Unit u; S.tile(FULL + (cq >> 2), u);
                pg8::gemm_quarter(F.lds, H, WT_UP, D, 2 * u.pm + ((cq >> 1) & 1), 2 * u.pn + (cq & 1), FStoreBf16{UP, NUP}); }
            else run_gemm_gc(F, PB, WT_PE, T, D, 256, FStoreBf16{PPb, D}, 256 - NQ, c - NQ);
        } else { run_gemm(F, H, WT_UP, T, NUP, D, FStoreBf16{UP, NUP});
        { const int nup = (T / 256) * (NUP / 256), rem = nup % F.G; const int c = (int)blockIdx.x;
          if (rem == 0) run_gemm(F, PB, WT_PE, T, D, 256, FStoreBf16{PPb, D});
          else if (c >= rem) run_gemm_gc(F, PB, WT_PE, T, D, 256, FStoreBf16{PPb, D}, F.G - rem, c - rem); } }
    }
    SEAM(10);
    if (IN(11)) {
        const float* cw = args.in[I_CONVW]; const float* cb = args.in[I_CONVB];
        const int rpw = (T + F.G - 1) / F.G, mlo = F.vcu * rpw, mhi = (mlo + rpw < T) ? mlo + rpw : T;
        for (int jc = F.tid; jc < DFF / 8; jc += NT) {
            const int j = jc * 8;
            f32x4 cbv[2], c0v[2], c1v[2], c2v[2];
#pragma unroll
            for (int e = 0; e < 2; ++e) { cbv[e] = *(const f32x4*)(cb + j + 4 * e); c0v[e] = *(const f32x4*)(cw + j + 4 * e); c1v[e] = *(const f32x4*)(cw + DFF + j + 4 * e); c2v[e] = *(const f32x4*)(cw + 2 * DFF + j + 4 * e); }
            f32x4 h1[2] = {{0.f, 0.f, 0.f, 0.f}, {0.f, 0.f, 0.f, 0.f}}, h2[2] = {{0.f, 0.f, 0.f, 0.f}, {0.f, 0.f, 0.f, 0.f}};
            if (mlo >= 1 && mlo < mhi) { const v4u x = *(const v4u*)(UP + (size_t)(mlo - 1) * NUP + j); h1[0] = (f32x4){bflo(x.x), bfhi(x.x), bflo(x.y), bfhi(x.y)}; h1[1] = (f32x4){bflo(x.z), bfhi(x.z), bflo(x.w), bfhi(x.w)}; }
            if (mlo >= 2 && mlo < mhi) { const v4u x = *(const v4u*)(UP + (size_t)(mlo - 2) * NUP + j); h2[0] = (f32x4){bflo(x.x), bfhi(x.x), bflo(x.y), bfhi(x.y)}; h2[1] = (f32x4){bflo(x.z), bfhi(x.z), bflo(x.w), bfhi(x.w)}; }
            v4u g2[4], uv[4], g2n[4], uvn[4];
#pragma unroll
            for (int i = 0; i < 4; ++i) { const int m = (mlo + i < mhi) ? mlo + i : (mhi > 0 ? mhi - 1 : 0); const bf16* ur = UP + (size_t)m * NUP + j; g2[i] = *(const v4u*)ur; uv[i] = *(const v4u*)(ur + DFF); }
            for (int mb = mlo; mb < mhi; mb += 4) {
#pragma unroll
                for (int i = 0; i < 4; ++i) { const int m = (mb + 4 + i < mhi) ? mb + 4 + i : mhi - 1; const bf16* ur = UP + (size_t)m * NUP + j; g2n[i] = *(const v4u*)ur; uvn[i] = *(const v4u*)(ur + DFF); }
#pragma unroll
                for (int i = 0; i < 4; ++i) { const int m = mb + i;
                    if (m < mhi) { const SeqPos sp = seqpos(m); const float* st = args.in[I_SCONV] + (size_t)sp.b * 2 * DFF + j;
                        f32x4 t0[2], t1[2];
                        if (sp.t >= 1) { t1[0] = h1[0]; t1[1] = h1[1]; }
                        else if (sp.prm) { t1[0] = (f32x4){0.f, 0.f, 0.f, 0.f}; t1[1] = t1[0]; } else { t1[0] = *(const f32x4*)(st + DFF); t1[1] = *(const f32x4*)(st + DFF + 4); }
                        if (sp.t >= 2) { t0[0] = h2[0]; t0[1] = h2[1]; }
                        else if (sp.prm) { t0[0] = (f32x4){0.f, 0.f, 0.f, 0.f}; t0[1] = t0[0]; } else { t0[0] = *(const f32x4*)(st + sp.t * DFF); t0[1] = *(const f32x4*)(st + sp.t * DFF + 4); }
                        const v4u g = g2[i], u = uv[i];
                        const f32x4 t2[2] = {{bflo(g.x), bfhi(g.x), bflo(g.y), bfhi(g.y)}, {bflo(g.z), bfhi(g.z), bflo(g.w), bfhi(g.w)}};
                        const f32x4 vv[2] = {{bflo(u.x), bfhi(u.x), bflo(u.y), bfhi(u.y)}, {bflo(u.z), bfhi(u.z), bflo(u.w), bfhi(u.w)}};
                        f32x4 a[2];
#pragma unroll
                        for (int e = 0; e < 2; ++e) { const f32x4 cv = cbv[e] + t0[e] * c0v[e] + t1[e] * c1v[e] + t2[e] * c2v[e];
                            const f32x4 tq = cv * ((cv * cv) * (-2.0f * 0.7978845608028654f * 0.044715f * 1.4426950408889634f) + (-2.0f * 0.7978845608028654f * 1.4426950408889634f));
#pragma unroll
                            for (int x = 0; x < 4; ++x) a[e][x] = cv[x] * vv[e][x] * __builtin_amdgcn_rcpf(1.0f + __builtin_amdgcn_exp2f(tq[x])); }
                        v4u w; w.x = cvt_pk_bf16(a[0][0], a[0][1]); w.y = cvt_pk_bf16(a[0][2], a[0][3]); w.z = cvt_pk_bf16(a[1][0], a[1][1]); w.w = cvt_pk_bf16(a[1][2], a[1][3]);
                        *(v4u*)(ACT + (size_t)m * DFF + j) = w;
                        if (sp.t >= sp.L - 2) { float* co = out + (sp.prm ? O_CONV_P : O_CONV_S) + ((size_t)sp.b * 2 + (sp.t - (sp.L - 2))) * DFF + j; *(f32x4*)co = t2[0]; *(f32x4*)(co + 4) = t2[1]; }
                        h2[0] = h1[0]; h2[1] = h1[1]; h1[0] = t2[0]; h1[1] = t2[1]; }
                }
#pragma unroll
                for (int i = 0; i < 4; ++i) { g2[i] = g2n[i]; uv[i] = uvn[i]; }
            }
        }
    }
    SEAM(11);
    if (IN(12)) { run_gemm_split(F, ACT, WT_DOWN, T, D, DFF, FStoreF32Split{FF, D, FFS, TP, (size_t)TS * D, (bf16*)FF});
    }
    SEAM(12);
    if (IN(13)) {
        for (int m = F.gw; m < T; m += F.NGW) sandwich_row(FF + (size_t)m * D, m < TP ? (const bf16*)FF + (size_t)m * D : nullptr, FFS + (size_t)(m - TP) * D, (size_t)TS * D, m >= TP ? 3 : 0, Y + (size_t)m * D, args.in[I_GPOSTFFN], Y + (size_t)m * D, args.in[I_GPE], H + (size_t)m * D, F.lane);
    }
    SEAM(13);
    if (IN(14)) {
        if (F.G == 256) {
            run_gemm(F, H, WT_PEG, TP, D, D, FPeg{Y, PPb});
            const int c = (int)blockIdx.x, x = c & 7, idx = c >> 3;
            pg8::gemm_quarter(F.lds, H, WT_PEG, D, TP / 128 + (idx & 7), 4 * x + (idx >> 3), FPeg{Y, PPb});
        } else run_gemm(F, H, WT_PEG, T, D, D, FPeg{Y, PPb});
    }
#undef IN
#undef SEAM
}

extern "C" void kernel_launch(void* const* d_in, const int* in_sizes, int n_in, void* d_out, int out_size, void* d_ws, size_t ws_size, hipStream_t stream) {
    static int grid = 0;
    if (grid == 0) {
        if (n_in != 37 || out_size != (int)O_END || ws_size < WS_END) { fprintf(stderr, "kernel_launch: unexpected shapes (n_in %d out %d ws %zu)\n", n_in, out_size, ws_size); grid = -1; return; }
        int dev = 0, cus = 0, per_cu = 0;
        if (hipGetDevice(&dev) != hipSuccess || hipDeviceGetAttribute(&cus, hipDeviceAttributeMultiprocessorCount, dev) != hipSuccess) { grid = -1; return; }
        if (hipFuncSetAttribute((const void*)fwd_kernel, hipFuncAttributeMaxDynamicSharedMemorySize, LDS_BYTES) != hipSuccess) { fprintf(stderr, "kernel_launch: hipFuncSetAttribute failed\n"); grid = -1; return; }
        if (hipOccupancyMaxActiveBlocksPerMultiprocessor(&per_cu, (const void*)fwd_kernel, NT, LDS_BYTES) != hipSuccess || per_cu < 1) { fprintf(stderr, "kernel_launch: occupancy query says %d\n", per_cu); (void)hipGetLastError(); grid = -1; return; }
        grid = cus;
    }
    if (grid < 0) return;
    (void)hipMemsetAsync((char*)d_ws + WS_CTL, 0, CTL_ZERO_BYTES, stream);
    Args a{};
    for (int i = 0; i < 37; ++i) a.in[i] = (const float*)d_in[i];
    a.out = (float*)d_out; a.ws = (unsigned char*)d_ws;
#if MK_ONE_LAUNCH
    a.ph_lo = 0; a.ph_hi = N_PHASES;
    hipLaunchKernelGGL(fwd_kernel, dim3(grid), dim3(NT), LDS_BYTES, stream, a);
#else
    for (int p = 0; p < N_PHASES; ++p) { a.ph_lo = p; a.ph_hi = p + 1; hipLaunchKernelGGL(fwd_kernel, dim3(grid), dim3(NT), LDS_BYTES, stream, a); }
#endif
}
```
